# Optimizing an MI355X kernel written in HIP

```python
import jax, jax.numpy as jnp
from jax import lax
import numpy as np

D_MODEL = 2048
BATCH = 4
SEQ = 4096
DEPTH = 2

N_META = 16
POOL_WINDOWS = (2, 4, 8, 16)
POOL_WIDTH = D_MODEL // 2
POOL_GROUP = POOL_WIDTH // len(POOL_WINDOWS)
N_HEADS = 16
N_KV_HEADS = 4
HEAD_DIM = 64
Q_PER_KV = N_HEADS // N_KV_HEADS
WINDOW = 128
BLOCK = 128
NEG = -1e30
LRU_WIDTH = D_MODEL // 2
LRU_BLOCKS = 4
LRU_BLOCK = LRU_WIDTH // LRU_BLOCKS
CONV_WIDTH = 4
LRU_C = 8.0
N_GROUPS = 4
EXPERTS_PER_GROUP = 8
N_EXPERTS = N_GROUPS * EXPERTS_PER_GROUP
TOP_K = 2
D_EXPERT = D_MODEL // 4
MOE_BLOCK = 128
LN_EPS = 1e-5
IN_SIZES = (POOL_WIDTH, N_HEADS * HEAD_DIM, N_KV_HEADS * HEAD_DIM, N_KV_HEADS * HEAD_DIM,
            LRU_WIDTH, LRU_WIDTH, 3 * D_MODEL)
IN_COLS = int(sum(IN_SIZES))
IN_OFFSETS = tuple(int(o) for o in np.cumsum(IN_SIZES)[:-1])

kernel_name = 'hybrid_pool_swa_rglru_hmoe_deepnorm'


def layer_norm(x, g, b):
    xf = x.astype(jnp.float32)
    mu = xf.mean(-1, keepdims=True)
    var = jnp.square(xf - mu).mean(-1, keepdims=True)
    y = (xf - mu) * lax.rsqrt(var + LN_EPS) * g.astype(jnp.float32) + b.astype(jnp.float32)
    return y.astype(x.dtype)


def pool_mixer(u, pool_w, pool_scale):
    B, L, _ = u.shape
    uf = u.astype(jnp.float32).reshape(B, L, len(POOL_WINDOWS), POOL_GROUP)
    maxw = max(POOL_WINDOWS)
    cs = jnp.pad(jnp.cumsum(uf, axis=1), ((0, 0), (maxw, 0), (0, 0), (0, 0)))
    t = jnp.arange(L)
    outs = []
    for gi, w in enumerate(POOL_WINDOWS):
        win_sum = cs[:, maxw:, gi] - cs[:, maxw - w:maxw - w + L, gi]
        cnt = jnp.minimum(t + 1, w).astype(jnp.float32)
        outs.append(win_sum / cnt[None, :, None])
    delta = (jnp.stack(outs, axis=2) - uf).astype(u.dtype)
    mixed = jnp.einsum('blgc,gce->blge', delta, pool_w).reshape(B, L, POOL_WIDTH)
    return mixed * pool_scale


def swa_attention(q, k, v, sink):
    B, L = q.shape[:2]
    pad = BLOCK - N_META
    Lp = L + pad
    nb = Lp // BLOCK
    f32 = jnp.float32
    qb = jnp.pad(q.astype(f32), ((0, 0), (pad, 0), (0, 0), (0, 0))).reshape(
        B, nb, BLOCK, N_KV_HEADS, Q_PER_KV, HEAD_DIM)
    kb = jnp.pad(k.astype(f32), ((0, 0), (pad + BLOCK, 0), (0, 0), (0, 0))).reshape(
        B, nb + 1, BLOCK, N_KV_HEADS, HEAD_DIM)
    vb = jnp.pad(v.astype(f32), ((0, 0), (pad + BLOCK, 0), (0, 0), (0, 0))).reshape(
        B, nb + 1, BLOCK, N_KV_HEADS, HEAD_DIM)
    kw = jnp.concatenate([kb[:, :-1], kb[:, 1:]], axis=2)
    vw = jnp.concatenate([vb[:, :-1], vb[:, 1:]], axis=2)
    dist = BLOCK + jnp.arange(BLOCK)[:, None] - jnp.arange(2 * BLOCK)[None, :]
    in_window = (dist >= 0) & (dist < WINDOW)
    k_pos = (jnp.arange(nb)[:, None] - 1) * BLOCK + jnp.arange(2 * BLOCK)[None, :]
    mask = in_window[None] & (k_pos >= pad)[:, None, :]
    slopes = 2.0 ** (-8.0 * jnp.arange(1, N_HEADS + 1, dtype=f32) / N_HEADS)
    alibi = -slopes.reshape(N_KV_HEADS, Q_PER_KV, 1, 1) * dist.astype(f32)
    s = jnp.einsum('bnqkgd,bnskd->bnkgqs', qb, kw) * (HEAD_DIM ** -0.5) + alibi
    s = jnp.where(mask[None, :, None, None], s, NEG)
    sk = sink.astype(f32).reshape(N_KV_HEADS, Q_PER_KV, 1)
    m = jnp.maximum(s.max(-1), sk)
    p = jnp.exp(s - m[..., None])
    den = p.sum(-1) + jnp.exp(sk - m)
    o = jnp.einsum('bnkgqs,bnskd->bnkgqd', p, vw) / den[..., None]
    o = o.transpose(0, 1, 4, 2, 3, 5).reshape(B, Lp, N_HEADS * HEAD_DIM)[:, pad:]
    return o.astype(q.dtype)


def rglru_branch(xr, yr, conv_w, conv_b, wa, ba, wx, bx, lam):
    B, L, C = xr.shape
    xc = lax.conv_general_dilated(xr, conv_w[:, None, :], window_strides=(1,),
                                  padding=[(CONV_WIDTH - 1, 0)],
                                  dimension_numbers=('NWC', 'WIO', 'NWC'),
                                  feature_group_count=C) + conv_b
    xblk = xc.reshape(B, L, LRU_BLOCKS, LRU_BLOCK)
    gate_a = jax.nn.sigmoid(jnp.einsum('blhc,hce->blhe', xblk, wa).reshape(B, L, C) + ba)
    gate_x = jax.nn.sigmoid(jnp.einsum('blhc,hce->blhe', xblk, wx).reshape(B, L, C) + bx)
    log_a = -LRU_C * gate_a.astype(jnp.float32) * jax.nn.softplus(-lam.astype(jnp.float32))
    a = jnp.exp(log_a)
    b_in = jnp.sqrt(-jnp.expm1(2.0 * log_a)) * gate_x.astype(jnp.float32) * xc.astype(jnp.float32)

    def combine(left, right):
        return (left[0] * right[0], right[0] * left[1] + right[1])

    _, h = lax.associative_scan(combine, (a, b_in), axis=1)
    return (h * jax.nn.gelu(yr.astype(jnp.float32))).astype(xr.dtype)


def hier_moe(u, wg, bg, we, be, w_gate, w_up, w_down):
    B, L, D = u.shape
    N = B * L
    f32 = jnp.float32
    xf = u.reshape(N, D)
    grp_logits = (xf @ wg).astype(f32) + bg.astype(f32)
    p_grp = jax.nn.softmax(grp_logits, axis=-1)
    g = jnp.argmax(grp_logits, axis=-1)
    p_g = jnp.take_along_axis(p_grp, g[:, None], axis=1)
    exp_logits = ((xf @ we).astype(f32) + be.astype(f32)).reshape(N, N_GROUPS, EXPERTS_PER_GROUP)
    sel = jnp.take_along_axis(exp_logits, g[:, None, None], axis=1)[:, 0]
    top_p, top_i = lax.top_k(jax.nn.softmax(sel, axis=-1), TOP_K)
    wts = p_g * top_p / top_p.sum(-1, keepdims=True)
    eid = g[:, None] * EXPERTS_PER_GROUP + top_i
    A = N * TOP_K
    flat_e = eid.reshape(A).astype(jnp.int32)
    flat_w = wts.reshape(A)
    order = jnp.argsort(flat_e)
    se = flat_e[order]
    counts = jnp.bincount(flat_e, length=N_EXPERTS)
    start = jnp.cumsum(counts) - counts
    padded = (counts + MOE_BLOCK - 1) // MOE_BLOCK * MOE_BLOCK
    pad_end = jnp.cumsum(padded)
    pad_start = pad_end - padded
    dest = pad_start[se] + jnp.arange(A) - start[se]
    n_blocks = -(-A // MOE_BLOCK) + N_EXPERTS
    cap = n_blocks * MOE_BLOCK
    slot_tok = jnp.full((cap,), N, jnp.int32).at[dest].set((order // TOP_K).astype(jnp.int32))
    slot_w = jnp.zeros((cap,), f32).at[dest].set(flat_w[order])
    block_e = jnp.minimum(jnp.searchsorted(pad_end, jnp.arange(n_blocks) * MOE_BLOCK, side='right'),
                          N_EXPERTS - 1)
    x_pad = jnp.concatenate([xf, jnp.zeros((1, D), xf.dtype)], axis=0)

    def run_block(args):
        tok, wt, e = args
        xb = x_pad[tok]
        hdn = jax.nn.silu(xb @ w_gate[e]) * (xb @ w_up[e])
        return (hdn @ w_down[e]) * wt[:, None].astype(xb.dtype)

    yb = lax.map(run_block, (slot_tok.reshape(n_blocks, MOE_BLOCK),
                             slot_w.reshape(n_blocks, MOE_BLOCK), block_e))
    y = jnp.zeros((N + 1, D), u.dtype).at[slot_tok].add(yb.reshape(cap, D).astype(u.dtype))
    return y[:N].reshape(B, L, D)


def setup_inputs(seed: int = 0) -> dict:
    key = jax.random.key(seed)
    ks = iter(jax.random.split(key, 40))
    f32 = jnp.float32
    D = D_MODEL
    beta = (8.0 * DEPTH) ** -0.25

    def nrm(shape, scale):
        return jax.random.normal(next(ks), shape, f32) * scale

    u = jax.random.uniform(next(ks), (DEPTH, LRU_WIDTH), f32, 0.9, 0.999)
    a0 = u ** (1.0 / LRU_C)
    lru_lambda = jnp.log(a0) - jnp.log1p(-a0)
    return {
        'x': nrm((BATCH, SEQ, D), 1.0),
        'meta': nrm((N_META, D), 1.0),
        'ln_emb_g': 1.0 + nrm((D,), 0.02),
        'ln_emb_b': nrm((D,), 0.02),
        'w_in': nrm((DEPTH, D, IN_COLS), D ** -0.5),
        'pool_w': nrm((DEPTH, len(POOL_WINDOWS), POOL_GROUP, POOL_GROUP), POOL_GROUP ** -0.5),
        'pool_scale': 1.0 + nrm((DEPTH, POOL_WIDTH), 0.1),
        'attn_sink': nrm((DEPTH, N_HEADS), 1.0),
        'conv_w': nrm((DEPTH, CONV_WIDTH, LRU_WIDTH), CONV_WIDTH ** -0.5),
        'conv_b': nrm((DEPTH, LRU_WIDTH), 0.02),
        'lru_wa': nrm((DEPTH, LRU_BLOCKS, LRU_BLOCK, LRU_BLOCK), LRU_BLOCK ** -0.5),
        'lru_ba': nrm((DEPTH, LRU_WIDTH), 0.02),
        'lru_wx': nrm((DEPTH, LRU_BLOCKS, LRU_BLOCK, LRU_BLOCK), LRU_BLOCK ** -0.5),
        'lru_bx': nrm((DEPTH, LRU_WIDTH), 0.02),
        'lru_lambda': lru_lambda,
        'proj_pool': nrm((DEPTH, POOL_WIDTH, D), beta * POOL_WIDTH ** -0.5),
        'proj_attn': nrm((DEPTH, N_HEADS * HEAD_DIM, D), beta * (N_HEADS * HEAD_DIM) ** -0.5),
        'proj_lru': nrm((DEPTH, LRU_WIDTH, D), beta * LRU_WIDTH ** -0.5),
        'w_out': nrm((DEPTH, D, D), beta * D ** -0.5),
        'ln1_g': 1.0 + nrm((DEPTH, D), 0.02),
        'ln1_b': nrm((DEPTH, D), 0.02),
        'router_grp_w': nrm((DEPTH, D, N_GROUPS), D ** -0.5),
        'router_grp_b': nrm((DEPTH, N_GROUPS), 0.01),
        'router_exp_w': nrm((DEPTH, D, N_EXPERTS), D ** -0.5),
        'router_exp_b': nrm((DEPTH, N_EXPERTS), 0.01),
        'exp_w_gate': nrm((DEPTH, N_EXPERTS, D, D_EXPERT), D ** -0.5),
        'exp_w_up': nrm((DEPTH, N_EXPERTS, D, D_EXPERT), beta * D ** -0.5),
        'exp_w_down': nrm((DEPTH, N_EXPERTS, D_EXPERT, D), beta * D_EXPERT ** -0.5),
        'ln2_g': 1.0 + nrm((DEPTH, D), 0.02),
        'ln2_b': nrm((DEPTH, D), 0.02),
    }


def reference(x, meta, ln_emb_g, ln_emb_b, w_in, pool_w, pool_scale, attn_sink, conv_w, conv_b,
              lru_wa, lru_ba, lru_wx, lru_bx, lru_lambda, proj_pool, proj_attn, proj_lru, w_out,
              ln1_g, ln1_b, router_grp_w, router_grp_b, router_exp_w, router_exp_b,
              exp_w_gate, exp_w_up, exp_w_down, ln2_g, ln2_b):
    B = x.shape[0]
    alpha = (2.0 * DEPTH) ** 0.25
    h = jnp.concatenate([jnp.broadcast_to(meta[None].astype(x.dtype), (B, N_META, D_MODEL)), x], axis=1)
    h = layer_norm(h, ln_emb_g, ln_emb_b)
    L = h.shape[1]
    for l in range(DEPTH):
        cols = h @ w_in[l]
        pool_in, q, k, v, lru_x, lru_y, gate_cols = jnp.split(cols, IN_OFFSETS, axis=-1)
        pool_o = pool_mixer(pool_in, pool_w[l], pool_scale[l])
        attn_o = swa_attention(q.reshape(B, L, N_HEADS, HEAD_DIM),
                               k.reshape(B, L, N_KV_HEADS, HEAD_DIM),
                               v.reshape(B, L, N_KV_HEADS, HEAD_DIM), attn_sink[l])
        lru_o = rglru_branch(lru_x, lru_y, conv_w[l], conv_b[l], lru_wa[l], lru_ba[l],
                             lru_wx[l], lru_bx[l], lru_lambda[l])
        gts = jax.nn.sigmoid(gate_cols).reshape(B, L, 3, D_MODEL)
        merged = (gts[:, :, 0] * (pool_o @ proj_pool[l])
                  + gts[:, :, 1] * (attn_o @ proj_attn[l])
                  + gts[:, :, 2] * (lru_o @ proj_lru[l]))
        h = layer_norm(alpha * h + merged @ w_out[l], ln1_g[l], ln1_b[l])
        ffn = hier_moe(h, router_grp_w[l], router_grp_b[l], router_exp_w[l], router_exp_b[l],
                       exp_w_gate[l], exp_w_up[l], exp_w_down[l])
        h = layer_norm(alpha * h + ffn, ln2_g[l], ln2_b[l])
    return h[:, N_META:]
```

```cpp
#include <hip/hip_runtime.h>
#include <cstdio>
#include <cstdint>

#define PROBE_MASK 0
#define PROBE_K2 0
#define PROBE_G2 0
#define PREP(k) for (int rep_ = 0; rep_ < (((PROBE_MASK) >> (k)) & 1) + 1; ++rep_)
#ifndef MK_ONE_LAUNCH
#define MK_ONE_LAUNCH 1
#endif

#define LAS __attribute__((address_space(3)))
#define GAS __attribute__((address_space(1)))
typedef unsigned short bf16;
typedef short bf16x8 __attribute__((ext_vector_type(8)));
typedef float f32x4 __attribute__((ext_vector_type(4)));
typedef float f32x2 __attribute__((ext_vector_type(2)));
typedef unsigned u32x4 __attribute__((ext_vector_type(4)));
typedef unsigned u32x2 __attribute__((ext_vector_type(2)));
typedef __bf16 bf16x2_t __attribute__((ext_vector_type(2)));
typedef int i32x4 __attribute__((ext_vector_type(4)));
typedef int i32x8 __attribute__((ext_vector_type(8)));
typedef GAS unsigned gu32;
#define RLX_AGENT __ATOMIC_RELAXED, __HIP_MEMORY_SCOPE_AGENT
#define LDS_WAIT() asm volatile("s_waitcnt lgkmcnt(0)" ::: "memory")
#define VM_WAIT() asm volatile("s_waitcnt vmcnt(0)" ::: "memory")

constexpr int D = 2048, NB = 4, SEQ = 4096, NMETA = 16, LSEQ = SEQ + NMETA, NTOK = NB * LSEQ  , MP = 16640  , NPANEL = 65, DEPTH = 2;
constexpr int CW = 4608  , GW = 6144, INC = CW + GW;
#ifndef A8_MASK
#define A8_MASK 0x3FE00u
#endif
constexpr int C_POOL = 0, C_Q = 1024, C_K = 2048, C_V = 2304, C_LX = 2560, C_LY = 3584;
constexpr int NEXP = 32, DE = 512, CAPT = 161, CAP = CAPT * 256, NCHUNK = (NTOK + 63) / 64  ;
constexpr float LN_EPS = 1e-5f, ALPHA = 1.41421356237f;

constexpr size_t MiB = 1u << 20;
constexpr size_t WS_CTL = 0, CTL_ZERO_BYTES = 1 * MiB;
constexpr size_t WS_SP8 = 1 * MiB;
constexpr size_t WS_TOKINFO = 2 * MiB;
constexpr size_t WS_ELIST = 3 * MiB;
constexpr size_t WS_SUMM = 6 * MiB;
constexpr size_t WS_WSMALL = 9 * MiB;
constexpr size_t WL_WIN8 = (size_t)CW * 2048 * 2;
constexpr size_t WL_BYTES = 66584576, WL_WIN = 0, WL_PROJ = 44040192, WL_WOUT = 56623104, WL_POOL = 65011712, WL_LRU = 65536000;
constexpr size_t WS_H = 136 * MiB;
constexpr size_t WS_HB = 266 * MiB;
constexpr size_t WS_R1 = 331 * MiB;
constexpr size_t WS_R2 = 526 * MiB;
constexpr size_t WS_R6 = 673 * MiB;
constexpr size_t WS_R3 = 803 * MiB;
constexpr size_t WS_R45 = 901 * MiB;
constexpr size_t WS_STATS = 966 * MiB;
constexpr size_t WS_WRT = 972 * MiB;
constexpr size_t WS_HB8 = 974 * MiB;
constexpr size_t WS_WSC = 1008 * MiB;
constexpr size_t WS_WCT = 1010 * MiB;
constexpr size_t WS_END = 1018 * MiB;
constexpr size_t EXPW_GU = 0, EXPW_WD = 67108864;
constexpr float W8_SCALE = 64.0f, HDN_SCALE = 8.0f, YD_SCALE = 16.0f;
static_assert(WS_WSMALL + 2 * WL_BYTES <= WS_H && WS_R2 + 201326592 <= WS_R3 && WS_R6 + 2ull * MP * 1024 * 4 <= WS_R3 && WS_R3 + (size_t)MP * 3072 * 2 <= WS_R45 && WS_R45 + (size_t)MP * 2048 * 2 <= WS_END, "ws map");
static_assert(WS_R1 + (size_t)MP * GW * 2 <= WS_R2 && (size_t)CAP * 2048 * 2 <= (size_t)MP * GW * 2 && WS_R2 + (size_t)MP * CW * 2 <= WS_R6, "ws map 2");
constexpr int CW_BAR = 4096;
constexpr int CW_COUNT = 16384, CNT_STRIDE = 32;

constexpr int RING_BYTES = 131072, MISC_OFF = RING_BYTES, TBL_OFF = RING_BYTES + 1024, LDS_BYTES = 147456;

__device__ __forceinline__ unsigned pk_bf16(float lo, float hi) { f32x2 v = {lo, hi}; bf16x2_t b = __builtin_convertvector(v, bf16x2_t); return __builtin_bit_cast(unsigned, b); }
__device__ __forceinline__ unsigned pk_fp8x4(float a, float b, float c, float d) { int w = 0; w = __builtin_amdgcn_cvt_pk_fp8_f32(a, b, w, false); w = __builtin_amdgcn_cvt_pk_fp8_f32(c, d, w, true); return (unsigned)w; }
__device__ __forceinline__ float bf2f(unsigned short b) { return __uint_as_float(((unsigned)b) << 16); }
__device__ __forceinline__ float bflo(unsigned w) { return __uint_as_float(w << 16); }
__device__ __forceinline__ float bfhi(unsigned w) { return __uint_as_float(w & 0xffff0000u); }
__device__ __forceinline__ float fast_exp(float x) { return __builtin_amdgcn_exp2f(x * 1.44269504089f); }
__device__ __forceinline__ float sigmoidf_(float x) { return __builtin_amdgcn_rcpf(1.0f + fast_exp(-x)); }
__device__ __forceinline__ unsigned pk_gate4(float a, float b, float c, float d) {
    unsigned r = __builtin_amdgcn_cvt_pk_u8_f32(a * 255.0f, 0u, 0u); r = __builtin_amdgcn_cvt_pk_u8_f32(b * 255.0f, 1u, r); r = __builtin_amdgcn_cvt_pk_u8_f32(c * 255.0f, 2u, r); return __builtin_amdgcn_cvt_pk_u8_f32(d * 255.0f, 3u, r); }
__device__ __forceinline__ float wave_sum(float v) {
#pragma unroll
    for (int o = 1; o < 64; o <<= 1) v += __shfl_xor(v, o);
    return v;
}
__device__ __forceinline__ float wave_max(float v) {
#pragma unroll
    for (int o = 1; o < 64; o <<= 1) v = fmaxf(v, __shfl_xor(v, o));
    return v;
}

namespace pg8 {
constexpr int BM = 256, BK = 64, HALF = 128, HTB = HALF * BK * 2, STAGE_BYTES = 8 * HTB;
__host__ __device__ __forceinline__ int lds_byte(int r, int c) { const int st = (r >> 4) * 2 + (c >> 5), rr = r & 15, cc = c & 31, ob = rr * 64 + cc * 2; return st * 1024 + (ob ^ (((ob >> 9) & 1) << 5)); }
__host__ __device__ __forceinline__ void stage_rc(int b, int& R, int& C) { const int st = b / 1024, sb = b % 1024, swz = sb ^ (((sb >> 9) & 1) << 5); R = (st >> 1) * 16 + swz / 64; C = (st & 1) * 32 + (swz % 64) / 2; }
__host__ __device__ __forceinline__ int perm32(int rho) { const int n = rho >> 4, i = rho & 15; return 8 * (i >> 2) + 4 * n + (i & 3); }
struct Unit { int pm, pn, z; };

template <class P, class = void> struct adj_trait { static constexpr bool v = false; };
template <class P> struct adj_trait<P, decltype((void)P::ADJ)> { static constexpr bool v = P::ADJ; };
template <class P> __host__ __device__ constexpr bool adj_b() { return adj_trait<P>::v; }
template <class P, bool TAIL = false>
__device__ __forceinline__ void gemm_phase(LAS unsigned char* lds, const P& p, const int tid, const unsigned char* wsbase) {
    const __amdgpu_buffer_rsrc_t rsrc = __builtin_amdgcn_make_buffer_rsrc((void*)wsbase, 0, 0xffffffffu, 0x00020000);
    const int wid = __builtin_amdgcn_readfirstlane(tid >> 6), lane = tid & 63, wr = wid >> 2, wc = wid & 3, fr = lane & 15, fq = lane >> 4;
    constexpr int ESZ = P::ESZ;
    const int K = p.K, nt = K * ESZ / 128, lda = p.lda, ldb = p.ldb;
    unsigned voffA[2], voffB[2]; int Rr[2], Cc[2];
#pragma unroll
    for (int i = 0; i < 2; ++i) { int R, C; stage_rc(tid * 16 + i * 8192, R, C); Rr[i] = R; Cc[i] = C; const int Rb = adj_b<P>() ? (64 * (R >> 5) + perm32(R & 31)) : (P::PERM ? ((R & ~31) + perm32(R & 31)) : R);
        voffA[i] = (unsigned)(R * lda * ESZ + C * 2); voffB[i] = (unsigned)(Rb * ldb * ESZ + C * 2); }
    const unsigned kstep = (unsigned)(BK * 2);
    const unsigned hstepA = (unsigned)(HALF * lda * ESZ), hstepB = (unsigned)((adj_b<P>() ? 32 : HALF) * ldb * ESZ);
    const unsigned ldsw0 = (unsigned)wid * 1024u; const unsigned ldsw = ldsw0;
    const int aoff = lds_byte(wr * 64 + fr, fq * 8), boff = lds_byte(wc * 32 + fr, fq * 8);
    auto opaque_tid = [&]() { int t_ = tid; asm volatile("" : "+v"(t_)); return t_; };
    unsigned vc[2][2];
#define PG8_SA(b, h) (((b) * 2 + (h)) * HTB)
#define PG8_SB(b, h) ((4 + (b) * 2 + (h)) * HTB)
#define PG8_GLDS(so, vo, ldsoff) __builtin_amdgcn_raw_ptr_buffer_load_lds(rsrc, (LAS void*)(lds + (ldsoff)), 16, (int)(vo), (int)(so), 0, 0)
#define PG8_STAGE_B(bufoff, gb) do { PG8_GLDS((gb), voffB[0], (bufoff) + ldsw); PG8_GLDS((gb), voffB[1], (bufoff) + ldsw + 8192); } while (0)
#define PG8_STAGE_A(bufoff, ga, h, NX) do { if constexpr (P::GATHER) { PG8_GLDS((ga), vc[h][0], (bufoff) + ldsw); PG8_GLDS((ga), vc[h][1], (bufoff) + ldsw + 8192); } \
        else { PG8_GLDS((ga) + (h) * hstepA, voffA[0], (bufoff) + ldsw); PG8_GLDS((ga) + (h) * hstepA, voffA[1], (bufoff) + ldsw + 8192); } } while (0)
#define PG8_LDA(dst, b, h) do { if constexpr (TAIL) { if ((h) == 1 || wr == 1) break; } _Pragma("unroll") for (int m = 0; m < 4; ++m) _Pragma("unroll") for (int k = 0; k < 2; ++k) dst[m][k] = *(const LAS bf16x8*)(lds + PG8_SA(b, h) + aoff + m * 2048 + k * 1024); } while (0)
#define PG8_LDB(dst, b, h) do { if constexpr (TAIL) { if (wr == 1) break; } _Pragma("unroll") for (int n = 0; n < 2; ++n) _Pragma("unroll") for (int k = 0; k < 2; ++k) dst[n][k] = *(const LAS bf16x8*)(lds + PG8_SB(b, h) + boff + n * 2048 + k * 1024); } while (0)
#define PG8_MMA(ai, bj, At, Bt) do { if constexpr (TAIL) { if ((ai) == 1 || wr == 1) break; } __builtin_amdgcn_s_setprio(1); _Pragma("unroll") for (int m = 0; m < 4; ++m) _Pragma("unroll") for (int n = 0; n < 2; ++n) { \
        if constexpr (ESZ == 2) { _Pragma("unroll") for (int k = 0; k < 2; ++k) acc[ai][bj][m][n] = __builtin_amdgcn_mfma_f32_16x16x32_bf16(Bt[n][k], At[m][k], acc[ai][bj][m][n], 0, 0, 0); } \
        else { const i32x8 b8_ = __builtin_shufflevector(__builtin_bit_cast(i32x4, Bt[n][0]), __builtin_bit_cast(i32x4, Bt[n][1]), 0, 1, 2, 3, 4, 5, 6, 7), a8_ = __builtin_shufflevector(__builtin_bit_cast(i32x4, At[m][0]), __builtin_bit_cast(i32x4, At[m][1]), 0, 1, 2, 3, 4, 5, 6, 7); \
               asm volatile("v_mfma_f32_16x16x128_f8f6f4 %0, %1, %2, %0" : "+v"(acc[ai][bj][m][n]) : "v"(b8_), "v"(a8_)); } } \
        __builtin_amdgcn_s_setprio(0); } while (0)
#define PG8_WAIT_V(n) asm volatile("s_waitcnt vmcnt(" #n ")" ::: "memory")
#define PG8_WAIT_L(n) asm volatile("s_waitcnt lgkmcnt(" #n ")" ::: "memory")
#define PG8_BAR __builtin_amdgcn_s_barrier()
#define PG8_SCHED __builtin_amdgcn_sched_barrier(0)
#define PG8_ROWOFFS(dst, u) do { _Pragma("unroll") for (int i_ = 0; i_ < 2; ++i_) { int R_, C_; stage_rc(opaque_tid() * 16 + i_ * 8192, R_, C_); _Pragma("unroll") for (int h_ = 0; h_ < 2; ++h_) dst[h_][i_] = (unsigned)(p.a_row(u, h_ * HALF + R_) * lda * ESZ + C_ * 2); } } while (0)
    Unit cur, nxt; int ui = 0;
    if (!p.next(0, cur)) return;
    f32x4 acc[2][2][4][2];
#pragma unroll
    for (int a = 0; a < 2; ++a)
#pragma unroll
        for (int b = 0; b < 2; ++b)
#pragma unroll
            for (int m = 0; m < 4; ++m)
#pragma unroll
                for (int n = 0; n < 2; ++n) acc[a][b][m][n] = (f32x4){0.f, 0.f, 0.f, 0.f};
    bf16x8 At[4][2], B0[2][2], B1[2][2];
    unsigned cA = (unsigned)((const unsigned char*)p.a_ptr(cur) - wsbase), cB = (unsigned)((const unsigned char*)p.b_ptr(cur) - wsbase);
    if constexpr (P::GATHER) { PG8_ROWOFFS(vc, cur); }
    PG8_STAGE_B(PG8_SB(0, 0), cB); PG8_STAGE_B(PG8_SB(0, 1), cB + hstepB); PG8_STAGE_A(PG8_SA(0, 0), cA, 0, false); PG8_STAGE_A(PG8_SA(0, 1), cA, 1, false);
    if (wr == 1) PG8_BAR;
    PG8_WAIT_V(2); PG8_BAR;
    PG8_STAGE_B(PG8_SB(1, 0), cB + kstep); PG8_STAGE_A(PG8_SA(1, 0), cA + kstep, 0, false); PG8_STAGE_B(PG8_SB(1, 1), cB + hstepB + kstep);
    PG8_WAIT_V(6); PG8_BAR;
    for (;;) {
        const bool has_next = p.next(ui + 1, nxt);
        const unsigned nA = has_next ? (unsigned)((const unsigned char*)p.a_ptr(nxt) - wsbase) : cA, nB = has_next ? (unsigned)((const unsigned char*)p.b_ptr(nxt) - wsbase) : cB;
        for (int t = 0; t < nt; t += 2) {
            const bool last = (t == nt - 2);
            unsigned ldsw = ldsw0; asm volatile("" : "+s"(ldsw));
            const unsigned a1 = cA + (unsigned)(t + 1) * kstep;
            const unsigned a2 = last ? nA : cA + (unsigned)(t + 2) * kstep, b2 = last ? nB : cB + (unsigned)(t + 2) * kstep;
            const unsigned a3 = a2 + kstep, b3 = b2 + kstep;
            unsigned vt[2][2];
            if constexpr (P::GATHER) { if (last && has_next) { PG8_ROWOFFS(vt, nxt); } }
            PG8_LDB(B0, 0, 0); PG8_LDB(B1, 0, 1); PG8_SCHED; PG8_LDA(At, 0, 0); PG8_STAGE_A(PG8_SA(1, 1), a1, 1, false);
            PG8_WAIT_V(8); PG8_WAIT_L(0); PG8_BAR; PG8_MMA(0, 0, At, B0); PG8_MMA(0, 1, At, B1); PG8_BAR; PG8_SCHED;
            if constexpr (P::GATHER) { if (last && has_next) {
#pragma unroll
                for (int h = 0; h < 2; ++h) { vc[h][0] = vt[h][0]; vc[h][1] = vt[h][1]; } } }
            PG8_LDA(At, 0, 1); PG8_STAGE_B(PG8_SB(0, 0), b2); PG8_STAGE_B(PG8_SB(0, 1), b2 + hstepB); PG8_STAGE_A(PG8_SA(0, 0), a2, 0, last);
            PG8_WAIT_V(8); PG8_WAIT_L(0); PG8_BAR; PG8_MMA(1, 0, At, B0); PG8_MMA(1, 1, At, B1); PG8_BAR; PG8_SCHED;
            PG8_LDB(B0, 1, 0); PG8_LDB(B1, 1, 1); PG8_SCHED; PG8_LDA(At, 1, 0); PG8_STAGE_A(PG8_SA(0, 1), a2, 1, last);
            PG8_WAIT_V(8); PG8_WAIT_L(0); PG8_BAR; PG8_MMA(0, 0, At, B0); PG8_MMA(0, 1, At, B1); PG8_BAR; PG8_SCHED;
            PG8_LDA(At, 1, 1); PG8_STAGE_B(PG8_SB(1, 0), b3); PG8_STAGE_B(PG8_SB(1, 1), b3 + hstepB); PG8_STAGE_A(PG8_SA(1, 0), a3, 0, last);
            PG8_WAIT_V(8); PG8_WAIT_L(0); PG8_BAR; PG8_MMA(1, 0, At, B0); PG8_MMA(1, 1, At, B1); PG8_BAR; PG8_SCHED;
        }
        if constexpr (ESZ == 1) asm volatile("s_nop 15\n\ts_nop 15" ::: "memory");
        if (wr == 0) PG8_BAR;
        bool zero;
        { int t2 = tid; asm volatile("" : "+v"(t2));
          const int l2 = t2 & 63, w2 = __builtin_amdgcn_readfirstlane(t2 >> 6); zero = p.template epi<TAIL>(acc, cur, w2 >> 2, w2 & 3, l2 & 15, l2 >> 4); }
        if (!has_next) break;
        if (zero) {
#pragma unroll
            for (int a = 0; a < 2; ++a)
#pragma unroll
                for (int b = 0; b < 2; ++b)
#pragma unroll
                    for (int m = 0; m < 4; ++m)
#pragma unroll
                        for (int n = 0; n < 2; ++n) acc[a][b][m][n] = (f32x4){0.f, 0.f, 0.f, 0.f};
        }
        cur = nxt; cA = nA; cB = nB; ++ui;
        if (wr == 1) PG8_BAR;
    }
    PG8_WAIT_V(0);
    PG8_BAR;
#undef PG8_SA
#undef PG8_SB
#undef PG8_GLDS
#undef PG8_STAGE_A
#undef PG8_STAGE_B
#undef PG8_LDA
#undef PG8_LDB
#undef PG8_MMA
#undef PG8_WAIT_V
#undef PG8_WAIT_L
#undef PG8_BAR
#undef PG8_SCHED
#undef PG8_ROWOFFS
}
}

#define XB_TMO      128
#define XB_XCNT(j)  (256  + 64 * (j))
#define XB_XSUB(j)  (1280 + 64 * (j))
#define XB_XGEN(j)  (2304 + 64 * (j))
#define XB_TOP      3328
#define XB_TOPGEN   3392
#define XCD_BAR_WORDS 3456
#define XB_SPIN_CAP (1u << 18)
__device__ __forceinline__ unsigned xb_ld(unsigned* p)              { return __hip_atomic_load(p, __ATOMIC_RELAXED, __HIP_MEMORY_SCOPE_AGENT); }
__device__ __forceinline__ unsigned xb_add(unsigned* p, unsigned v) { return __hip_atomic_fetch_add(p, v, __ATOMIC_RELAXED, __HIP_MEMORY_SCOPE_AGENT); }
__device__ __forceinline__ unsigned xb_xcc_id() { return (unsigned)__builtin_amdgcn_s_getreg((3 << 11) | 20) & 0xFu; }
#define XB_SPIN(cond, bar) do { unsigned _sp = 0; while (cond) { __builtin_amdgcn_s_sleep(1); \
    if ((++_sp & 255u) == 0u) { if (xb_ld(&(bar)[XB_TMO])) break; if (_sp > XB_SPIN_CAP) { atomicAdd(&(bar)[XB_TMO], 1u); break; } } } } while (0)
struct XcdBarrier { unsigned* bar; unsigned x; volatile LAS unsigned* st; };
__device__ __forceinline__ XcdBarrier xcd_barrier_post(unsigned* bar, volatile LAS unsigned* st) {
    XcdBarrier b; b.bar = bar; b.x = xb_xcc_id(); b.st = st;
    if (threadIdx.x == 0) (void)xb_add(&bar[XB_XCNT(b.x)], 1u);
    return b;
}
__device__ __forceinline__ void xcd_barrier_complete(unsigned* bar, unsigned x, unsigned& nloc, unsigned& nx) {
    const unsigned G = gridDim.x * gridDim.y * gridDim.z;
    unsigned sum, cnt, mine, sp = 0u;
    for (;;) {
        sum = 0u; cnt = 0u; mine = 0u;
#pragma unroll
        for (unsigned j = 0; j < 16; ++j) { const unsigned c = xb_ld(&bar[XB_XCNT(j)]); sum += c; cnt += (c > 0u) ? 1u : 0u; mine = (j == x) ? c : mine; }
        if (sum == G) break;
        __builtin_amdgcn_s_sleep(1);
        if ((++sp & 255u) == 0u) { if (xb_ld(&bar[XB_TMO])) break; if (sp > XB_SPIN_CAP) { atomicAdd(&bar[XB_TMO], 1u); break; } }
    }
    nloc = mine > 0u ? mine : 1u; nx = cnt > 0u ? cnt : 1u;
}
__device__ __forceinline__ void xcd_barrier(const XcdBarrier& b) {
    asm volatile("s_waitcnt vmcnt(0)" ::: "memory");
    __syncthreads();
    if (threadIdx.x == 0) {
        unsigned* bar = b.bar;
        __builtin_amdgcn_s_waitcnt(0);
        unsigned nloc = b.st[0], nx = b.st[1];
        if (nloc == 0u) { xcd_barrier_complete(bar, b.x, nloc, nx); b.st[0] = nloc; b.st[1] = nx; }
        const unsigned old = xb_add(&bar[XB_XSUB(b.x)], 1u);
        const unsigned gen = old / nloc;
        if (old + 1u == (gen + 1u) * nloc) {
            __builtin_amdgcn_fence(__ATOMIC_RELEASE, "agent");
            asm volatile("s_waitcnt vmcnt(0)" ::: "memory");
            const unsigned og = xb_add(&bar[XB_TOP], 1u);
            const unsigned tg = og / nx;
            if (og + 1u == (tg + 1u) * nx) xb_add(&bar[XB_TOPGEN], 1u);
            else XB_SPIN(xb_ld(&bar[XB_TOPGEN]) == tg, bar);
            __builtin_amdgcn_fence(__ATOMIC_ACQUIRE, "agent");
            xb_add(&bar[XB_XGEN(b.x)], 1u);
            asm volatile("s_waitcnt vmcnt(0)" ::: "memory");
        } else {
            XB_SPIN(xb_ld(&bar[XB_XGEN(b.x)]) == gen, bar);
            __builtin_amdgcn_fence(__ATOMIC_ACQUIRE, "agent");
            asm volatile("s_waitcnt vmcnt(0)" ::: "memory");
        }
    }
    __syncthreads();
}

struct Args { const float* in[30]; float* out; unsigned char* ws; int ph_lo, ph_hi; };
enum { I_X = 0, I_META, I_LNE_G, I_LNE_B, I_WIN, I_POOLW, I_POOLS, I_SINK, I_CONVW, I_CONVB, I_WA, I_BA, I_WX, I_BX, I_LAM, I_PPOOL, I_PATTN, I_PLRU, I_WOUT,
       I_LN1G, I_LN1B, I_RGW, I_RGB, I_REW, I_REB, I_EG, I_EU, I_ED, I_LN2G, I_LN2B };

struct Frame {
    LAS unsigned char* lds;
    const float* const* inp; float* out; unsigned char* ws;
    int tid, lane, wave, vcu, G, z;
    __device__ __forceinline__ const float* I(int k) const { return inp[k + z]; }
};
__device__ __forceinline__ int opaque_s(int x) { asm volatile("" : "+s"(x)); return x; }
__device__ __forceinline__ int opaque_v(int x) { asm volatile("" : "+v"(x)); return x; }

__device__ __forceinline__ void transpose_item(const float* W, int ldw, int k0, int n0, bf16* WT, int ldt, int drow0, LAS float* scr, int lane) {
    f32x4 v[8]; const int kr = lane >> 3, nq = (lane & 7) * 4;
#pragma unroll
    for (int i = 0; i < 8; ++i) v[i] = __builtin_nontemporal_load((const f32x4*)(W + (size_t)(k0 + 8 * i + kr) * ldw + n0 + nq));
#pragma unroll
    for (int i = 0; i < 8; ++i) { LAS float* d = scr + (8 * i + kr) * 33 + nq; d[0] = v[i][0]; d[1] = v[i][1]; d[2] = v[i][2]; d[3] = v[i][3]; }
    LDS_WAIT();
    const int c = lane & 7;
#pragma unroll
    for (int j = 0; j < 4; ++j) { const int n = (lane >> 3) + 8 * j; const LAS float* s = scr + (8 * c) * 33 + n;
        u32x4 o; o.x = pk_bf16(s[0 * 33], s[1 * 33]); o.y = pk_bf16(s[2 * 33], s[3 * 33]); o.z = pk_bf16(s[4 * 33], s[5 * 33]); o.w = pk_bf16(s[6 * 33], s[7 * 33]);
        *(u32x4*)(WT + (size_t)(drow0 + n) * ldt + k0 + 8 * c) = o; }
    LDS_WAIT();
}

__device__ __forceinline__ void transpose_item8(const float* W, int ldw, int k0, int n0, unsigned char* WT, int ldt, int drow0, float scale, LAS float* scr, int lane) {
    f32x4 v[8]; const int kr = lane >> 3, nq = (lane & 7) * 4;
#pragma unroll
    for (int i = 0; i < 8; ++i) v[i] = __builtin_nontemporal_load((const f32x4*)(W + (size_t)(k0 + 8 * i + kr) * ldw + n0 + nq));
#pragma unroll
    for (int i = 0; i < 8; ++i) { LAS float* d = scr + (8 * i + kr) * 33 + nq; d[0] = v[i][0]; d[1] = v[i][1]; d[2] = v[i][2]; d[3] = v[i][3]; }
    LDS_WAIT();
    const int c = lane & 3;
#pragma unroll
    for (int j = 0; j < 2; ++j) { const int n = (lane >> 2) + 16 * j; const LAS float* s = scr + (16 * c) * 33 + n;
        u32x4 o; o.x = pk_fp8x4(s[0 * 33] * scale, s[1 * 33] * scale, s[2 * 33] * scale, s[3 * 33] * scale); o.y = pk_fp8x4(s[4 * 33] * scale, s[5 * 33] * scale, s[6 * 33] * scale, s[7 * 33] * scale);
        o.z = pk_fp8x4(s[8 * 33] * scale, s[9 * 33] * scale, s[10 * 33] * scale, s[11 * 33] * scale); o.w = pk_fp8x4(s[12 * 33] * scale, s[13 * 33] * scale, s[14 * 33] * scale, s[15 * 33] * scale);
        *(u32x4*)(WT + (size_t)(drow0 + n) * ldt + k0 + 16 * c) = o; }
    LDS_WAIT();
}

__device__ __forceinline__ void ln_regs(f32x4 (&v)[8], const float* g, const float* b, int lane) {
    float s = 0.f;
#pragma unroll
    for (int j = 0; j < 8; ++j) s += (v[j].x + v[j].y) + (v[j].z + v[j].w);
    const float mean = wave_sum(s) * (1.f / D); float s2 = 0.f;
#pragma unroll
    for (int j = 0; j < 8; ++j) { v[j] = v[j] - mean; s2 += (v[j].x * v[j].x + v[j].y * v[j].y) + (v[j].z * v[j].z + v[j].w * v[j].w); }
    const float rstd = 1.f / sqrtf(wave_sum(s2) * (1.f / D) + LN_EPS);
#pragma unroll
    for (int j = 0; j < 8; ++j) { const f32x4 gg = *(const f32x4*)(g + 4 * lane + 256 * j), bb = *(const f32x4*)(b + 4 * lane + 256 * j); v[j] = v[j] * rstd * gg + bb; }
}
__device__ __forceinline__ void store_row_bf16(bf16* orow, const f32x4 (&v)[8], int lane) {
#pragma unroll
    for (int j = 0; j < 8; ++j) { u32x2 w; w.x = pk_bf16(v[j].x, v[j].y); w.y = pk_bf16(v[j].z, v[j].w); *(u32x2*)(orow + 4 * lane + 256 * j) = w; }
}
__device__ __forceinline__ void store_row_fp8(unsigned char* orow, const f32x4 (&v)[8], int lane) {
#pragma unroll
    for (int j = 0; j < 8; ++j) *(unsigned*)(orow + 4 * lane + 256 * j) = pk_fp8x4(v[j].x, v[j].y, v[j].z, v[j].w);
}
__device__ __forceinline__ void store_row_f32(float* orow, const f32x4 (&v)[8], int lane) {
#pragma unroll
    for (int j = 0; j < 8; ++j) *(f32x4*)(orow + 4 * lane + 256 * j) = v[j];
}
__device__ __forceinline__ void load_row_f32(const float* row, f32x4 (&v)[8], int lane) {
#pragma unroll
    for (int j = 0; j < 8; ++j) v[j] = *(const f32x4*)(row + 4 * lane + 256 * j);
}

__device__ __forceinline__ void conv_small_weights(Frame& F, int l, int it, LAS float* scr) {
    bf16* wl = (bf16*)(F.ws + WS_WSMALL + (size_t)l * WL_BYTES);
    int r = it;
    if (r < 10752) { const int kb = r / 336, nb = r % 336;
        if (nb < CW / 32) { const int t = nb >> 3;
            if (!((A8_MASK >> t) & 1u)) transpose_item(F.I(I_WIN) + (size_t)l * D * INC, INC, 64 * kb, 32 * nb, (bf16*)((char*)wl + WL_WIN), D, __builtin_popcount(~A8_MASK & ((1u << t) - 1u)) * 256 + (nb & 7) * 32, scr, F.lane);
            else { const int ct = __builtin_popcount(A8_MASK & ((1u << t) - 1u)); transpose_item8(F.I(I_WIN) + (size_t)l * D * INC, INC, 64 * kb, 32 * nb, (unsigned char*)wl + WL_WIN8, D, GW + ct * 256 + (nb & 7) * 32, W8_SCALE, scr, F.lane); } }
        else transpose_item8(F.I(I_WIN) + (size_t)l * D * INC, INC, 64 * kb, 32 * nb, (unsigned char*)wl + WL_WIN8, D, 32 * nb - CW, W8_SCALE, scr, F.lane);
        return; } r -= 10752;
    if (r < 3072) { const int pi = r / 1024, q = r % 1024, kb = q / 64, nb = q % 64;
        transpose_item(F.I(I_PPOOL + pi) + (size_t)l * 1024 * D, D, 64 * kb, 32 * nb, (bf16*)((char*)wl + WL_PROJ) + (size_t)pi * D * 1024, 1024, 32 * nb, scr, F.lane); return; } r -= 3072;
    if (r < 2048) { const int kb = r / 64, nb = r % 64; transpose_item(F.I(I_WOUT) + (size_t)l * D * D, D, 64 * kb, 32 * nb, (bf16*)((char*)wl + WL_WOUT), D, 32 * nb, scr, F.lane); return; } r -= 2048;
    if (r < 128) { const int g = r / 32, q = r % 32, kb = q / 8, nb = q % 8;
        transpose_item(F.I(I_POOLW) + ((size_t)l * 4 + g) * 65536, 256, 64 * kb, 32 * nb, (bf16*)((char*)wl + WL_POOL) + (size_t)g * 65536, 256, 32 * nb, scr, F.lane); return; } r -= 128;
    { const int which = r / 128, q0 = r % 128, blk = q0 / 32, q = q0 % 32, kb = q / 8, nb = q % 8, n0 = 32 * nb;
        const int drow0 = (blk * 2 + (n0 >> 7)) * 256 + 64 * ((n0 & 127) >> 5) + 32 * which;
        transpose_item(F.I(which ? I_WX : I_WA) + ((size_t)l * 4 + blk) * 65536, 256, 64 * kb, n0, (bf16*)((char*)wl + WL_LRU), 256, drow0, scr, F.lane); }
}
__device__ __forceinline__ void conv_expert_weights(Frame& F, int l, int it, LAS float* scr) {
    unsigned char* gu = F.ws + WS_R2 + EXPW_GU; unsigned char* wd = F.ws + WS_R2 + EXPW_WD;
    const int e = it / 1536, r = it % 1536;
    if (r < 1024) { const int which = r / 512, q = r % 512, kb = q / 16, nb = q % 16, n0 = 32 * nb;
        const int drow0 = (e * 4 + (n0 >> 7)) * 256 + which * 128 + (n0 & 127);
        transpose_item8(F.I(which ? I_EU : I_EG) + ((size_t)l * NEXP + e) * D * DE, DE, 64 * kb, n0, gu, D, drow0, W8_SCALE, scr, F.lane); }
    else { const int q = r - 1024, kb = q / 64, nb = q % 64;
        transpose_item8(F.I(I_ED) + ((size_t)l * NEXP + e) * DE * D, D, 64 * kb, 32 * nb, wd, DE, e * D + 32 * nb, W8_SCALE, scr, F.lane); }
}
__device__ __forceinline__ void p0_prologue(Frame& F) {
    LAS float* scr = (LAS float*)(F.lds + F.wave * 16384);
    const int gw = F.vcu * 8 + F.wave, NGW = F.G * 8;
    for (int it = gw; it < 2 * 16256; it += NGW) conv_small_weights(F, it / 16256, it % 16256, scr);
    float* H = (float*)(F.ws + WS_H); bf16* HB = (bf16*)(F.ws + WS_HB);
    for (int n = gw; n < MP; n += NGW) {
        if (n < NTOK) { const int b = n / LSEQ, t = n % LSEQ; const float* src = t < NMETA ? F.I(I_META) + (size_t)t * D : F.I(I_X) + ((size_t)b * SEQ + (t - NMETA)) * D;
            f32x4 v[8]; load_row_f32(src, v, F.lane); ln_regs(v, F.I(I_LNE_G), F.I(I_LNE_B), F.lane);
            store_row_f32(H + (size_t)n * D, v, F.lane); store_row_bf16(HB + (size_t)n * D, v, F.lane); store_row_fp8(F.ws + WS_HB8 + (size_t)n * D, v, F.lane); }
        else { f32x4 v[8];
#pragma unroll
            for (int j = 0; j < 8; ++j) v[j] = (f32x4){0.f, 0.f, 0.f, 0.f};
            store_row_f32(H + (size_t)n * D, v, F.lane); store_row_bf16(HB + (size_t)n * D, v, F.lane); store_row_fp8(F.ws + WS_HB8 + (size_t)n * D, v, F.lane); }
    }
    { bf16* wrt = (bf16*)(F.ws + WS_WRT);
      for (int i = F.vcu * 512 + F.tid; i < 2 * 48 * 2048; i += F.G * 512) { const int l = i / (48 * 2048), c = (i / 2048) % 48, k = i % 2048;
          const float w = c < 4 ? F.I(I_RGW)[((size_t)l * D + k) * 4 + c] : c < 36 ? F.I(I_REW)[((size_t)l * D + k) * 32 + (c - 4)] : 0.f;
          const unsigned hi = pk_bf16(w, 0.f) & 0xffffu; const float rem = w - __uint_as_float(hi << 16);
          wrt[((size_t)(l * 2 + 0) * 48 + c) * 2048 + k] = (bf16)hi; wrt[((size_t)(l * 2 + 1) * 48 + c) * 2048 + k] = (bf16)(pk_bf16(rem, 0.f) & 0xffffu); } }
    { bf16* wsc = (bf16*)(F.ws + WS_WSC);
      for (int i = F.vcu * 512 + F.tid; i < 2 * 4 * 65536; i += F.G * 512) { const int e = i & 255, lg = i >> 16;
          wsc[i] = (bf16)(pk_bf16(F.I(I_POOLW)[i] * F.I(I_POOLS)[(size_t)lg * 256 + e], 0.f) & 0xffffu); } }
    float* sp8 = (float*)(F.ws + WS_SP8);
    for (int i = F.vcu * 512 + F.tid; i < 2 * 1024; i += F.G * 512) { const float lam = F.I(I_LAM)[i]; sp8[i] = 8.0f * log1pf(expf(-lam)); }
}

using pg8::Unit;
__device__ __forceinline__ int xcd_order(int i, int G, int c, int NT) { if (G % (8 * NT)) return i * G + c; const int P = G / (8 * NT), x = c & 7, s = c >> 3; return i * G + (x * P + s / NT) * NT + (s % NT); }
constexpr int A8_NCT = __builtin_popcount(A8_MASK), A8_NN = 24 + A8_NCT, ABF_NN = 18 - A8_NCT;
constexpr int A_H = (NPANEL * ABF_NN) % 256, A_LIGHT = 256 - A_H, A_NF = NPANEL * A8_NN, A_X = (A_NF + 2 * A_H + 255) / 256;
__device__ __forceinline__ int nth_bit(unsigned m, int n) { for (int i = 0; i < n; ++i) m &= m - 1; return __builtin_ctz(m); }
template <bool GATE> struct PolA_ {
    static constexpr bool PERM = true, GATHER = false, ADJ = true; static constexpr int ESZ = GATE ? 1 : 2, NN = GATE ? A8_NN : ABF_NN;
    int K, lda, ldb; const unsigned char* A; const unsigned char* Bt; bf16* out; bf16* outc; int G, c;
    __device__ __forceinline__ bool next(int i, Unit& u) const { int L;
        if (GATE && G == 256) {
            if (i < A_X - 2) L = i * 256 + c; else if (i < A_X) { if (c >= A_LIGHT) return false; L = (A_X - 2) * 256 + (i - (A_X - 2)) * A_LIGHT + c; if (L >= A_NF) return false; } else return false;
        } else { L = i * G + c; if (L >= NPANEL * NN) return false; }
        const int nwg = NPANEL * NN, q = nwg / 8, r = nwg % 8, xcd = L % 8, off = L / 8; const int w = (xcd < r ? xcd * (q + 1) : r * (q + 1) + (xcd - r) * q) + off;
        const int nig = 8 * NN, gid = w / nig, fm = gid * 8, gsz = (NPANEL - fm) < 8 ? (NPANEL - fm) : 8;
        u.pm = fm + ((w % nig) % gsz); u.pn = (w % nig) / gsz; u.z = 0; return true; }
    __device__ __forceinline__ const char* a_ptr(const Unit& u) const { return (const char*)(A + (size_t)u.pm * 256 * lda * ESZ); }
    __device__ __forceinline__ const char* b_ptr(const Unit& u) const { return (const char*)(Bt + (size_t)u.pn * 256 * ldb * ESZ); }
    __device__ __forceinline__ int a_row(const Unit&, int) const { return 0; }
    template <bool T1> __device__ __forceinline__ bool epi(f32x4 (&acc)[2][2][4][2], const Unit& u, int wr, int wc, int fr, int fq) const {
        const int row0 = u.pm * 256 + wr * 64 + fr;
        if constexpr (!GATE) {
            const int tile = nth_bit(~A8_MASK & 0x3FFFFu, u.pn); const float sc = (tile >= 4 && tile < 8) ? 0.125f : 1.0f;
            bf16* base = out + (size_t)row0 * CW + tile * 256 + wc * 64 + 8 * fq;
#pragma unroll
            for (int ai = 0; ai < 2; ++ai)
#pragma unroll
                for (int m = 0; m < 4; ++m)
#pragma unroll
                    for (int bj = 0; bj < 2; ++bj) { const f32x4 v0 = acc[ai][bj][m][0] * sc, v1 = acc[ai][bj][m][1] * sc;
                        u32x4 w; w.x = pk_bf16(v0[0], v0[1]); w.y = pk_bf16(v0[2], v0[3]); w.z = pk_bf16(v1[0], v1[1]); w.w = pk_bf16(v1[2], v1[3]);
                        *(u32x4*)(base + (size_t)(ai * 128 + m * 16) * CW + bj * 32) = w; }
        } else if (u.pn < 24) {
            unsigned char* base = (unsigned char*)out + (size_t)row0 * GW + u.pn * 256 + wc * 64 + 8 * fq;
#pragma unroll
            for (int ai = 0; ai < 2; ++ai)
#pragma unroll
                for (int m = 0; m < 4; ++m)
#pragma unroll
                    for (int bj = 0; bj < 2; ++bj) { const f32x4 a0 = acc[ai][bj][m][0] * (1.0f / W8_SCALE), a1 = acc[ai][bj][m][1] * (1.0f / W8_SCALE);
                        u32x2 w; w.x = pk_gate4(sigmoidf_(a0[0]), sigmoidf_(a0[1]), sigmoidf_(a0[2]), sigmoidf_(a0[3])); w.y = pk_gate4(sigmoidf_(a1[0]), sigmoidf_(a1[1]), sigmoidf_(a1[2]), sigmoidf_(a1[3]));
                        *(u32x2*)(base + (size_t)(ai * 128 + m * 16) * GW + bj * 32) = w; }
        } else {
            const int tile = nth_bit(A8_MASK, u.pn - 24); const float sc = ((tile >= 4 && tile < 8) ? 0.125f : 1.0f) * (1.0f / W8_SCALE);
            bf16* base = outc + (size_t)row0 * CW + tile * 256 + wc * 64 + 8 * fq;
#pragma unroll
            for (int ai = 0; ai < 2; ++ai)
#pragma unroll
                for (int m = 0; m < 4; ++m)
#pragma unroll
                    for (int bj = 0; bj < 2; ++bj) { const f32x4 v0 = acc[ai][bj][m][0] * sc, v1 = acc[ai][bj][m][1] * sc;
                        u32x4 w; w.x = pk_bf16(v0[0], v0[1]); w.y = pk_bf16(v0[2], v0[3]); w.z = pk_bf16(v1[0], v1[1]); w.w = pk_bf16(v1[2], v1[3]);
                        *(u32x4*)(base + (size_t)(ai * 128 + m * 16) * CW + bj * 32) = w; }
        }
        return true;
    }
};
__device__ __forceinline__ void unpack8(const u32x4 v, float (&f)[8]);
struct PolW {
    static constexpr bool PERM = true, GATHER = false, ADJ = true; static constexpr int ESZ = 2;
    int K, lda, ldb; const bf16* pt; const bf16* wsc; bf16* wct; int G, c;
    __device__ __forceinline__ bool next(int i, Unit& u) const { const int L = i * G + c; if (L >= 32) return false; u.pm = L >> 2; u.pn = L & 3; u.z = 0; return true; }
    __device__ __forceinline__ const char* a_ptr(const Unit& u) const { return (const char*)(pt + (size_t)u.pm * 256 * 1024 + u.pn * 256); }
    __device__ __forceinline__ const char* b_ptr(const Unit& u) const { return (const char*)(wsc + (size_t)u.pn * 65536); }
    __device__ __forceinline__ int a_row(const Unit&, int) const { return 0; }
    template <bool T1> __device__ __forceinline__ bool epi(f32x4 (&acc)[2][2][4][2], const Unit& u, int wr, int wc, int fr, int fq) const {
        bf16* base = wct + (size_t)(u.pm * 256 + wr * 64 + fr) * 1024 + u.pn * 256 + wc * 64 + 8 * fq;
#pragma unroll
        for (int ai = 0; ai < 2; ++ai)
#pragma unroll
            for (int m = 0; m < 4; ++m)
#pragma unroll
                for (int bj = 0; bj < 2; ++bj) { const f32x4 v0 = acc[ai][bj][m][0], v1 = acc[ai][bj][m][1];
                    u32x4 w; w.x = pk_bf16(v0[0], v0[1]); w.y = pk_bf16(v0[2], v0[3]); w.z = pk_bf16(v1[0], v1[1]); w.w = pk_bf16(v1[2], v1[3]);
                    *(u32x4*)(base + (size_t)(ai * 128 + m * 16) * 1024 + bj * 32) = w; }
        return true;
    }
};
struct PolC {
    static constexpr bool PERM = true, GATHER = false, ADJ = true; static constexpr int ESZ = 2;
    int K, lda, ldb; const bf16* delta; const bf16* xc; const bf16* pool_t; const bf16* lru_t; bf16* mix; bf16* Abuf; bf16* Bbuf;
    const float* pool_scale; const float* ba; const float* bx; const float* sp8; int G, c;
    __device__ __forceinline__ bool next(int i, Unit& u) const { const int L = i * G + c; if (L >= 64 * 8) return false; u.pm = L >> 3; u.pn = 4 + (L & 7); u.z = 0; return true; }
    __device__ __forceinline__ const char* a_ptr(const Unit& u) const { return u.pn < 4 ? (const char*)(delta + (size_t)u.pm * 256 * 1024 + u.pn * 256) : (const char*)(xc + (size_t)u.pm * 256 * 1024 + ((u.pn - 4) >> 1) * 256); }
    __device__ __forceinline__ const char* b_ptr(const Unit& u) const { return u.pn < 4 ? (const char*)(pool_t + (size_t)u.pn * 65536) : (const char*)(lru_t + (size_t)(u.pn - 4) * 65536); }
    __device__ __forceinline__ int a_row(const Unit&, int) const { return 0; }
    __device__ __forceinline__ int rows(const Unit& u) const { return NTOK - u.pm * 256; }
    template <bool T1> __device__ __forceinline__ bool epi(f32x4 (&acc)[2][2][4][2], const Unit& u, int wr, int wc, int fr, int fq) const {
        const int row0 = u.pm * 256 + wr * 64 + fr;
        if (u.pn < 4) {
#pragma unroll
            for (int bj = 0; bj < 2; ++bj) { const int col = u.pn * 256 + wc * 64 + bj * 32 + 8 * fq; const f32x4 p0 = *(const f32x4*)(pool_scale + col), p1 = *(const f32x4*)(pool_scale + col + 4);
#pragma unroll
                for (int ai = 0; ai < 2; ++ai)
#pragma unroll
                    for (int m = 0; m < 4; ++m) { const f32x4 v0 = acc[ai][bj][m][0] * p0, v1 = acc[ai][bj][m][1] * p1; u32x4 w; w.x = pk_bf16(v0[0], v0[1]); w.y = pk_bf16(v0[2], v0[3]); w.z = pk_bf16(v1[0], v1[1]); w.w = pk_bf16(v1[2], v1[3]);
                        *(u32x4*)(mix + (size_t)(row0 + ai * 128 + m * 16) * 3072 + col) = w; } }
        } else {
            const int q = u.pn - 4, ch = (q >> 1) * 256 + (q & 1) * 128 + wc * 32 + 8 * fq;
            float vba[8], vbx[8], vsp[8];
            { const f32x4 t0 = *(const f32x4*)(ba + ch), t1 = *(const f32x4*)(ba + ch + 4), t2 = *(const f32x4*)(bx + ch), t3 = *(const f32x4*)(bx + ch + 4), t4 = *(const f32x4*)(sp8 + ch), t5 = *(const f32x4*)(sp8 + ch + 4);
#pragma unroll
              for (int j = 0; j < 4; ++j) { vba[j] = t0[j]; vba[4 + j] = t1[j]; vbx[j] = t2[j]; vbx[4 + j] = t3[j]; vsp[j] = t4[j]; vsp[4 + j] = t5[j]; } }
#pragma unroll
            for (int ai = 0; ai < 2; ++ai) { u32x4 xw[4];
#pragma unroll
                for (int m = 0; m < 4; ++m) xw[m] = *(const u32x4*)(xc + (size_t)(row0 + ai * 128 + m * 16) * 1024 + ch);
#pragma unroll
                for (int m = 0; m < 4; ++m) { const int row = row0 + ai * 128 + m * 16; float xv[8]; unpack8(xw[m], xv);
                    const bool t0 = (row % LSEQ) == 0; float av[8], bv[8];
#pragma unroll
                    for (int j = 0; j < 8; ++j) { const float ga = sigmoidf_(acc[ai][0][m][j >> 2][j & 3] + vba[j]), gx = sigmoidf_(acc[ai][1][m][j >> 2][j & 3] + vbx[j]);
                        const float a = fast_exp(-vsp[j] * ga); bv[j] = sqrtf(fmaxf(1.0f - a * a, 0.f)) * gx * xv[j]; av[j] = t0 ? 1.0f : 1.0f - a; }
                    u32x4 wa, wb; wa.x = pk_bf16(av[0], av[1]); wa.y = pk_bf16(av[2], av[3]); wa.z = pk_bf16(av[4], av[5]); wa.w = pk_bf16(av[6], av[7]);
                    wb.x = pk_bf16(bv[0], bv[1]); wb.y = pk_bf16(bv[2], bv[3]); wb.z = pk_bf16(bv[4], bv[5]); wb.w = pk_bf16(bv[6], bv[7]);
                    *(u32x4*)(Abuf + (size_t)row * 1024 + ch) = wa; *(u32x4*)(Bbuf + (size_t)row * 1024 + ch) = wb; } }
        }
        return true;
    }
};
struct PolE {
    static constexpr bool PERM = true, GATHER = false, ADJ = true; static constexpr int ESZ = 2;
    int K, lda, ldb; const bf16* mix; const bf16* proj_t; const bf16* wct; const unsigned char* gates; bf16* merged; int G, c;
    int t0, t1;
    __device__ __forceinline__ bool next(int i, Unit& u) const { const int ti = t0 + xcd_order(i / 3, G, c, 8); if (ti >= t1) return false; u.pm = ti >> 3; u.pn = ti & 7; u.z = i % 3; return true; }
    __device__ __forceinline__ const char* a_ptr(const Unit& u) const { return (const char*)(mix + (size_t)u.pm * 256 * 3072 + u.z * 1024); }
    __device__ __forceinline__ const char* b_ptr(const Unit& u) const { return u.z == 0 ? (const char*)(wct + (size_t)u.pn * 256 * 1024) : (const char*)(proj_t + (size_t)u.z * D * 1024 + (size_t)u.pn * 256 * 1024); }
    __device__ __forceinline__ int a_row(const Unit&, int) const { return 0; }
    static __device__ __forceinline__ void unpack_gate(const u32x2 w, float (&f)[8]) { f[0] = (float)(w.x & 255u); f[1] = (float)((w.x >> 8) & 255u); f[2] = (float)((w.x >> 16) & 255u); f[3] = (float)(w.x >> 24);
        f[4] = (float)(w.y & 255u); f[5] = (float)((w.y >> 8) & 255u); f[6] = (float)((w.y >> 16) & 255u); f[7] = (float)(w.y >> 24); }
    template <bool T1> __device__ __forceinline__ bool epi(f32x4 (&acc)[2][2][4][2], const Unit& u, int wr, int wc, int fr, int fq) const {
        const int row0 = u.pm * 256 + wr * 64 + fr, col0 = u.pn * 256 + wc * 64 + 8 * fq;
        const unsigned char* gbase = gates + (size_t)row0 * GW + u.z * D + col0; const bool fin = (u.z == 2); const int dofs = fin ? 0 : D;
        const u32x2 ones = (u32x2){0xffffffffu, 0xffffffffu};
#pragma unroll
        for (int ai = 0; ai < (T1 ? 1 : 2); ++ai)
#pragma unroll
            for (int mh = 0; mh < 2; ++mh) { u32x2 ga[2][2], gb[2][2];
#pragma unroll
                for (int mm = 0; mm < 2; ++mm)
#pragma unroll
                    for (int bj = 0; bj < 2; ++bj) { const unsigned char* gp = gbase + (size_t)(ai * 128 + (2 * mh + mm) * 16) * GW + bj * 32; ga[mm][bj] = *(const u32x2*)gp; gb[mm][bj] = *(const u32x2*)(gp + dofs); }
#pragma unroll
                for (int mm = 0; mm < 2; ++mm)
#pragma unroll
                    for (int bj = 0; bj < 2; ++bj) { const int m = 2 * mh + mm; float f[8], h[8]; unpack_gate(ga[mm][bj], f); const u32x2 gsel = fin ? ones : gb[mm][bj]; unpack_gate(gsel, h);
#pragma unroll
                        for (int j = 0; j < 8; ++j) f[j] = fmaxf(f[j], 1e-20f) * __builtin_amdgcn_rcpf(fmaxf(h[j], 1e-20f));
                        f32x4 v0 = acc[ai][bj][m][0], v1 = acc[ai][bj][m][1];
                        v0[0] *= f[0]; v0[1] *= f[1]; v0[2] *= f[2]; v0[3] *= f[3]; v1[0] *= f[4]; v1[1] *= f[5]; v1[2] *= f[6]; v1[3] *= f[7];
                        acc[ai][bj][m][0] = v0; acc[ai][bj][m][1] = v1; }
                if (fin) {
#pragma unroll
                    for (int mm = 0; mm < 2; ++mm)
#pragma unroll
                        for (int bj = 0; bj < 2; ++bj) { const int m = 2 * mh + mm; const f32x4 a0 = acc[ai][bj][m][0], a1 = acc[ai][bj][m][1];
                            u32x4 w; w.x = pk_bf16(a0[0], a0[1]); w.y = pk_bf16(a0[2], a0[3]); w.z = pk_bf16(a1[0], a1[1]); w.w = pk_bf16(a1[2], a1[3]);
                            *(u32x4*)(merged + (size_t)(row0 + ai * 128 + m * 16) * D + col0 + bj * 32) = w; } }
                __builtin_amdgcn_sched_barrier(0); }
        return fin;
    }
};
struct PolF {
    static constexpr bool PERM = false, GATHER = false; static constexpr int ESZ = 2;
    int K, lda, ldb; const bf16* A; const bf16* Bt; float* H; float* stats; int G, c;
    int t0, t1;
    __device__ __forceinline__ bool next(int i, Unit& u) const { const int ti = t0 + xcd_order(i, G, c, 8); if (ti >= t1) return false; u.pm = ti >> 3; u.pn = ti & 7; u.z = 0; return true; }
    __device__ __forceinline__ const char* a_ptr(const Unit& u) const { return (const char*)(A + (size_t)u.pm * 256 * lda); }
    __device__ __forceinline__ const char* b_ptr(const Unit& u) const { return (const char*)(Bt + (size_t)u.pn * 256 * ldb); }
    __device__ __forceinline__ int a_row(const Unit&, int) const { return 0; }
    template <bool T1> __device__ __forceinline__ bool epi(f32x4 (&acc)[2][2][4][2], const Unit& u, int wr, int wc, int fr, int fq) const {
        const int row0 = u.pm * 256 + wr * 64 + fr, col0 = u.pn * 256 + wc * 32 + 4 * fq;
#pragma unroll
        for (int ai = 0; ai < (T1 ? 1 : 2); ++ai)
#pragma unroll
            for (int m = 0; m < 4; ++m) { const int row = row0 + ai * 128 + m * 16; float* rp = H + (size_t)row * D + col0; float s = 0.f, q = 0.f;
#pragma unroll
                for (int bj = 0; bj < 2; ++bj)
#pragma unroll
                    for (int n = 0; n < 2; ++n) { const f32x4 h = *(const f32x4*)(rp + bj * 128 + n * 16); const f32x4 y = h * ALPHA + acc[ai][bj][m][n]; *(f32x4*)(rp + bj * 128 + n * 16) = y;
                        s += (y[0] + y[1]) + (y[2] + y[3]); q += (y[0] * y[0] + y[1] * y[1]) + (y[2] * y[2] + y[3] * y[3]); }
                s += __shfl_xor(s, 16); s += __shfl_xor(s, 32); q += __shfl_xor(q, 16); q += __shfl_xor(q, 32);
                if (fq == 0) *(f32x2*)(stats + (size_t)row * 64 + (u.pn * 4 + wc) * 2) = (f32x2){s, q}; }
        return true;
    }
};
struct MoeTbl { const LAS int* t; __device__ __forceinline__ int ct(int e) const { return __builtin_amdgcn_readfirstlane(t[e]); } __device__ __forceinline__ int cnt(int e) const { return __builtin_amdgcn_readfirstlane(t[40 + e]); } };
__device__ __forceinline__ int moe_find(const MoeTbl& T, int mt) { int e = 0;
#pragma unroll 1
    while (e < 31 && T.ct(e + 1) <= mt) ++e;
    return e; }
struct PolI {
    static constexpr bool PERM = true, GATHER = true; static constexpr int ESZ = 1;
    int K, lda, ldb; const unsigned char* X; const unsigned char* gu; const int* elist; unsigned char* hdn; MoeTbl T; int G, c;
    __device__ __forceinline__ bool next(int i, Unit& u) const { const int L = xcd_order(i, G, c, 4), tot = T.ct(32); if (L >= tot * 4) return false; u.pm = L >> 2; u.pn = L & 3; u.z = moe_find(T, u.pm); return true; }
    __device__ __forceinline__ const char* a_ptr(const Unit&) const { return (const char*)X; }
    __device__ __forceinline__ const char* b_ptr(const Unit& u) const { return (const char*)(gu + (size_t)(u.z * 4 + u.pn) * 256 * D); }
    __device__ __forceinline__ int a_row(const Unit& u, int r) const { const int j = (u.pm - T.ct(u.z)) * 256 + r; return j < T.cnt(u.z) ? elist[(size_t)u.z * NTOK + j] : 0; }
    template <bool T1> __device__ __forceinline__ bool epi(f32x4 (&acc)[2][2][4][2], const Unit& u, int wr, int wc, int fr, int fq) const {
        const int row0 = u.pm * 256 + wr * 64 + fr, col0 = u.pn * 128 + wc * 32 + 8 * fq;
#pragma unroll
        for (int ai = 0; ai < 2; ++ai)
#pragma unroll
            for (int m = 0; m < 4; ++m) { float o[8];
#pragma unroll
                for (int n = 0; n < 2; ++n)
#pragma unroll
                    for (int j = 0; j < 4; ++j) { const float g = acc[ai][0][m][n][j] * (1.0f / W8_SCALE), up = acc[ai][1][m][n][j] * (HDN_SCALE / W8_SCALE); o[4 * n + j] = fminf(fmaxf(g * sigmoidf_(g) * up, -440.f), 440.f); }
                u32x2 w; w.x = pk_fp8x4(o[0], o[1], o[2], o[3]); w.y = pk_fp8x4(o[4], o[5], o[6], o[7]);
                *(u32x2*)(hdn + (size_t)(row0 + ai * 128 + m * 16) * DE + col0) = w; }
        return true;
    }
};
struct PolJ {
    static constexpr bool PERM = true, GATHER = false, ADJ = true; static constexpr int ESZ = 1;
    int K, lda, ldb; const unsigned char* hdn; const unsigned char* wd; unsigned char* yd; MoeTbl T; int G, c;
    __device__ __forceinline__ bool next(int i, Unit& u) const { const int L = xcd_order(i, G, c, 8), tot = T.ct(32); if (L >= tot * 8) return false; u.pm = L >> 3; u.pn = L & 7; u.z = moe_find(T, u.pm); return true; }
    __device__ __forceinline__ const char* a_ptr(const Unit& u) const { return (const char*)(hdn + (size_t)u.pm * 256 * DE); }
    __device__ __forceinline__ const char* b_ptr(const Unit& u) const { return (const char*)(wd + ((size_t)u.z * D + (size_t)u.pn * 256) * DE); }
    __device__ __forceinline__ int a_row(const Unit&, int) const { return 0; }
    template <bool T1> __device__ __forceinline__ bool epi(f32x4 (&acc)[2][2][4][2], const Unit& u, int wr, int wc, int fr, int fq) const {
        const int row0 = u.pm * 256 + wr * 64 + fr, col0 = u.pn * 256 + wc * 64 + 8 * fq;
#pragma unroll
        for (int ai = 0; ai < 2; ++ai)
#pragma unroll
            for (int m = 0; m < 4; ++m)
#pragma unroll
                for (int bj = 0; bj < 2; ++bj) { const f32x4 v0 = acc[ai][bj][m][0] * (YD_SCALE / (W8_SCALE * HDN_SCALE)), v1 = acc[ai][bj][m][1] * (YD_SCALE / (W8_SCALE * HDN_SCALE));
#define YCL(x) __builtin_amdgcn_fmed3f((x), -448.0f, 448.0f)
                    u32x2 w; w.x = pk_fp8x4(YCL(v0[0]), YCL(v0[1]), YCL(v0[2]), YCL(v0[3])); w.y = pk_fp8x4(YCL(v1[0]), YCL(v1[1]), YCL(v1[2]), YCL(v1[3]));
#undef YCL
                    *(u32x2*)(yd + (size_t)(row0 + ai * 128 + m * 16) * D + col0 + bj * 32) = w; }
        return true;
    }
};

template <int NCB> __device__ __forceinline__ void skinny_mma(f32x4 (&acc)[4][NCB], const bf16* A, int lda, const bf16* Bt, int ldb, int k0, int k1, int lane) {
    const int fr = lane & 15, fq = lane >> 4;
#pragma unroll 2
    for (int k = k0; k < k1; k += 32) { bf16x8 a[4], b[NCB];
#pragma unroll
        for (int rb = 0; rb < 4; ++rb) a[rb] = *(const bf16x8*)(A + (size_t)(16 * rb + fr) * lda + k + 8 * fq);
#pragma unroll
        for (int cb = 0; cb < NCB; ++cb) b[cb] = *(const bf16x8*)(Bt + (size_t)(16 * cb + fr) * ldb + k + 8 * fq);
#pragma unroll
        for (int rb = 0; rb < 4; ++rb)
#pragma unroll
            for (int cb = 0; cb < NCB; ++cb) acc[rb][cb] = __builtin_amdgcn_mfma_f32_16x16x32_bf16(b[cb], a[rb], acc[rb][cb], 0, 0, 0); }
}
__device__ __forceinline__ void tail_merge(Frame& F, int l) {
    if (F.vcu >= 128) return;
    const bf16* mix = (const bf16*)(F.ws + WS_R3) + (size_t)16384 * 3072; const bf16* proj_t = (const bf16*)(F.ws + WS_WSMALL + (size_t)l * WL_BYTES + WL_PROJ); const bf16* wct = (const bf16*)(F.ws + WS_WCT) + (size_t)l * D * 1024;
    const unsigned char* gates = F.ws + WS_R1 + (size_t)16384 * GW; bf16* merged = (bf16*)(F.ws + WS_R45) + (size_t)16384 * D;
    const int c0 = F.vcu * 16, lane = F.lane, wave = F.wave, fr = lane & 15, fq = lane >> 4;
    LAS float* part = (LAS float*)F.lds;
#pragma unroll
    for (int seg = 0; seg < 3; ++seg) { f32x4 acc[4][1];
#pragma unroll
        for (int rb = 0; rb < 4; ++rb) acc[rb][0] = (f32x4){0.f, 0.f, 0.f, 0.f};
        skinny_mma<1>(acc, mix + seg * 1024, 3072, (seg == 0 ? wct : proj_t + (size_t)seg * D * 1024) + (size_t)c0 * 1024, 1024, wave * 128, wave * 128 + 128, lane);
#pragma unroll
        for (int rb = 0; rb < 4; ++rb) *(LAS f32x4*)(part + ((wave * 3 + seg) * 64 + 16 * rb + fr) * 16 + 4 * fq) = acc[rb][0]; }
    __syncthreads();
#pragma unroll
    for (int e2 = 0; e2 < 2; ++e2) { const int e = F.tid + 512 * e2, row = e >> 4, col = e & 15; float m = 0.f;
#pragma unroll
        for (int seg = 0; seg < 3; ++seg) { float s = 0.f;
#pragma unroll
            for (int w = 0; w < 8; ++w) s += part[((w * 3 + seg) * 64 + row) * 16 + col];
            m += (float)gates[(size_t)row * GW + seg * D + c0 + col] * (1.0f / 255.0f) * s; }
        merged[(size_t)row * D + c0 + col] = (bf16)(pk_bf16(m, 0.f) & 0xffffu); }
    __syncthreads();
}
__device__ __forceinline__ void tail_lru(Frame& F, int l) {
    if (F.vcu >= 64) return;
    const bf16* xc = (const bf16*)(F.ws + WS_R45) + (size_t)MP * 1024 + (size_t)16384 * 1024; const bf16* lru_t = (const bf16*)(F.ws + WS_WSMALL + (size_t)l * WL_BYTES + WL_LRU);
    bf16* Abuf = (bf16*)(F.ws + WS_R6) + (size_t)16384 * 1024; bf16* Bbuf = (bf16*)(F.ws + WS_R6) + (size_t)MP * 1024 + (size_t)16384 * 1024;
    const float* ba = F.I(I_BA) + (size_t)l * 1024; const float* bx = F.I(I_BX) + (size_t)l * 1024; const float* sp8 = (const float*)(F.ws + WS_SP8) + (size_t)l * 1024;
    const int ch0 = F.vcu * 16, blk = ch0 >> 8, cib = ch0 & 255, lane = F.lane, wave = F.wave, fr = lane & 15, fq = lane >> 4;
    const bf16* wrow = lru_t + (size_t)((blk * 2 + (cib >> 7)) * 256 + 64 * ((cib & 127) >> 5) + (cib & 31)) * 256;
    LAS float* part = (LAS float*)F.lds;
    { f32x4 acc[4][2];
#pragma unroll
      for (int rb = 0; rb < 4; ++rb) { acc[rb][0] = (f32x4){0.f, 0.f, 0.f, 0.f}; acc[rb][1] = acc[rb][0]; }
      const int k = wave * 32 + 8 * fq; bf16x8 a[4], b[2];
#pragma unroll
      for (int rb = 0; rb < 4; ++rb) a[rb] = *(const bf16x8*)(xc + (size_t)(16 * rb + fr) * 1024 + blk * 256 + k);
      b[0] = *(const bf16x8*)(wrow + (size_t)fr * 256 + k); b[1] = *(const bf16x8*)(wrow + (size_t)(32 + fr) * 256 + k);
#pragma unroll
      for (int rb = 0; rb < 4; ++rb)
#pragma unroll
          for (int cb = 0; cb < 2; ++cb) acc[rb][cb] = __builtin_amdgcn_mfma_f32_16x16x32_bf16(b[cb], a[rb], acc[rb][cb], 0, 0, 0);
#pragma unroll
      for (int rb = 0; rb < 4; ++rb)
#pragma unroll
          for (int cb = 0; cb < 2; ++cb) *(LAS f32x4*)(part + (wave * 64 + 16 * rb + fr) * 32 + 16 * cb + 4 * fq) = acc[rb][cb]; }
    __syncthreads();
#pragma unroll
    for (int e2 = 0; e2 < 2; ++e2) { const int e = F.tid + 512 * e2, row = e >> 4, cc = e & 15, ch = ch0 + cc; float ga = 0.f, gx = 0.f;
#pragma unroll
        for (int w = 0; w < 8; ++w) { ga += part[(w * 64 + row) * 32 + cc]; gx += part[(w * 64 + row) * 32 + 16 + cc]; }
        const float sa = sigmoidf_(ga + ba[ch]), sx = sigmoidf_(gx + bx[ch]), a = fast_exp(-sp8[ch] * sa), xv = bf2f(xc[(size_t)row * 1024 + ch]);
        const bool t0 = ((16384 + row) % LSEQ) == 0;
        Abuf[(size_t)row * 1024 + ch] = (bf16)(pk_bf16(t0 ? 1.0f : 1.0f - a, 0.f) & 0xffffu); Bbuf[(size_t)row * 1024 + ch] = (bf16)(pk_bf16(sqrtf(fmaxf(1.0f - a * a, 0.f)) * sx * xv, 0.f) & 0xffffu); }
    __syncthreads();
}
__device__ __forceinline__ void tail_wout(Frame& F, int l) {
    if (F.vcu >= 32) return;
    const bf16* merged = (const bf16*)(F.ws + WS_R45) + (size_t)16384 * D; const bf16* wo = (const bf16*)(F.ws + WS_WSMALL + (size_t)l * WL_BYTES + WL_WOUT);
    float* H = (float*)(F.ws + WS_H) + (size_t)16384 * D; float* stats = (float*)(F.ws + WS_STATS) + (size_t)16384 * 64;
    const int c0 = F.vcu * 64, lane = F.lane, wave = F.wave, fr = lane & 15, fq = lane >> 4;
    LAS float* part = (LAS float*)F.lds;
    { f32x4 acc[4][4];
#pragma unroll
      for (int rb = 0; rb < 4; ++rb)
#pragma unroll
          for (int cb = 0; cb < 4; ++cb) acc[rb][cb] = (f32x4){0.f, 0.f, 0.f, 0.f};
      skinny_mma<4>(acc, merged, D, wo + (size_t)c0 * D, D, wave * 256, wave * 256 + 256, lane);
#pragma unroll
      for (int rb = 0; rb < 4; ++rb)
#pragma unroll
          for (int cb = 0; cb < 4; ++cb) *(LAS f32x4*)(part + (wave * 64 + 16 * rb + fr) * 64 + 16 * cb + 4 * fq) = acc[rb][cb]; }
    __syncthreads();
    { const int row = F.tid >> 3, cs = (F.tid & 7) * 8; float s = 0.f, q = 0.f;
#pragma unroll
      for (int h4 = 0; h4 < 2; ++h4) { f32x4 a = (f32x4){0.f, 0.f, 0.f, 0.f};
#pragma unroll
          for (int w = 0; w < 8; ++w) a += *(const LAS f32x4*)(part + (w * 64 + row) * 64 + cs + 4 * h4);
          float* hp = H + (size_t)row * D + c0 + cs + 4 * h4; const f32x4 y = *(const f32x4*)hp * ALPHA + a; *(f32x4*)hp = y;
          s += (y[0] + y[1]) + (y[2] + y[3]); q += (y[0] * y[0] + y[1] * y[1]) + (y[2] * y[2] + y[3] * y[3]); }
      s += __shfl_xor(s, 1); s += __shfl_xor(s, 2); s += __shfl_xor(s, 4); q += __shfl_xor(q, 1); q += __shfl_xor(q, 2); q += __shfl_xor(q, 4);
      if ((F.tid & 7) == 0) *(f32x2*)(stats + (size_t)row * 64 + F.vcu * 2) = (f32x2){s, q}; }
    __syncthreads();
}

__device__ __forceinline__ void unpack8(const u32x4 v, float (&f)[8]) { f[0] = bflo(v.x); f[1] = bfhi(v.x); f[2] = bflo(v.y); f[3] = bfhi(v.y); f[4] = bflo(v.z); f[5] = bfhi(v.z); f[6] = bflo(v.w); f[7] = bfhi(v.w); }
template <int W> __device__ __forceinline__ void delta_conv_item(const bf16* cols, bf16* delta, bf16* xc, const float* cw, const float* cb, int n0, int t0, int c8) {
    u32x4 R[W + 7], X[11];
#pragma unroll
    for (int j = 0; j < W + 7; ++j) { const int dt = j - (W - 1); R[j] = (t0 + dt >= 0) ? *(const u32x4*)(cols + (size_t)(n0 + dt) * CW + C_POOL + c8) : (u32x4){0u, 0u, 0u, 0u}; }
#pragma unroll
    for (int j = 0; j < 11; ++j) { const int dt = j - 3; X[j] = (t0 + dt >= 0) ? *(const u32x4*)(cols + (size_t)(n0 + dt) * CW + C_LX + c8) : (u32x4){0u, 0u, 0u, 0u}; }
    float s[8];
#pragma unroll
    for (int q = 0; q < 8; ++q) s[q] = 0.f;
#pragma unroll
    for (int j = 0; j < W - 1; ++j) { float f[8]; unpack8(R[j], f);
#pragma unroll
        for (int q = 0; q < 8; ++q) s[q] += f[q]; }
#pragma unroll
    for (int i = 0; i < 8; ++i) { float fn[8]; unpack8(R[i + W - 1], fn);
#pragma unroll
        for (int q = 0; q < 8; ++q) s[q] += fn[q];
        const int t = t0 + i; const float inv = 1.0f / (float)((t + 1) < W ? (t + 1) : W); u32x4 o;
        o.x = pk_bf16(s[0] * inv - fn[0], s[1] * inv - fn[1]); o.y = pk_bf16(s[2] * inv - fn[2], s[3] * inv - fn[3]); o.z = pk_bf16(s[4] * inv - fn[4], s[5] * inv - fn[5]); o.w = pk_bf16(s[6] * inv - fn[6], s[7] * inv - fn[7]);
        *(u32x4*)(delta + (size_t)(n0 + i) * 3072 + c8) = o;
        float fo[8]; unpack8(R[i], fo);
#pragma unroll
        for (int q = 0; q < 8; ++q) s[q] -= fo[q]; }
    float w0[8], w1[8], w2[8], w3[8], bb[8];
#pragma unroll
    for (int q = 0; q < 8; ++q) { w0[q] = cw[c8 + q]; w1[q] = cw[1024 + c8 + q]; w2[q] = cw[2048 + c8 + q]; w3[q] = cw[3072 + c8 + q]; bb[q] = cb[c8 + q]; }
#pragma unroll
    for (int i = 0; i < 8; ++i) { float a[8], b[8], c[8], d[8]; unpack8(X[i], a); unpack8(X[i + 1], b); unpack8(X[i + 2], c); unpack8(X[i + 3], d); float r[8];
#pragma unroll
        for (int q = 0; q < 8; ++q) r[q] = bb[q] + a[q] * w0[q] + b[q] * w1[q] + c[q] * w2[q] + d[q] * w3[q];
        u32x4 o; o.x = pk_bf16(r[0], r[1]); o.y = pk_bf16(r[2], r[3]); o.z = pk_bf16(r[4], r[5]); o.w = pk_bf16(r[6], r[7]);
        *(u32x4*)(xc + (size_t)(n0 + i) * 1024 + c8) = o; }
}
__device__ __forceinline__ void phase_delta_conv(Frame& F, int l) {
    const bf16* cols = (const bf16*)(F.ws + WS_R2); bf16* delta = (bf16*)(F.ws + WS_R3); bf16* xc = (bf16*)(F.ws + WS_R45) + (size_t)MP * 1024;
    const float* cw = F.I(I_CONVW) + (size_t)l * 4 * 1024; const float* cb = F.I(I_CONVB) + (size_t)l * 1024;
    const int gw = F.vcu * 8 + F.wave, NGW = F.G * 8, lane = F.lane;
    const int total = (NTOK / 16) * 4, full = total / NGW;
    for (int k = 0; k <= full; ++k) { const int it = k * NGW + (k == full ? NGW - 1 - gw : gw); if (it >= total) break;
        const int g = it & 3, tp = it >> 2, n0 = (tp * 2 + (lane >> 5)) * 8, t0 = n0 % LSEQ, c8 = g * 256 + (lane & 31) * 8;
        if (g == 0) delta_conv_item<2>(cols, delta, xc, cw, cb, n0, t0, c8);
        else if (g == 1) delta_conv_item<4>(cols, delta, xc, cw, cb, n0, t0, c8);
        else if (g == 2) delta_conv_item<8>(cols, delta, xc, cw, cb, n0, t0, c8);
        else delta_conv_item<16>(cols, delta, xc, cw, cb, n0, t0, c8);
    }
}
typedef float f32x16 __attribute__((ext_vector_type(16)));
__device__ __forceinline__ void phase_attn(Frame& F, int l) {
    const bf16* cols = (const bf16*)(F.ws + WS_R2); bf16* mix = (bf16*)(F.ws + WS_R3);
    constexpr int KS_BYTES = 27648, BUF_BYTES = 27648 + 25088;
    const int tid = F.tid, lane = F.lane, wave = F.wave, r = lane & 31, h = lane >> 5, g = wave >> 1, qh = wave & 1;
    const int NU = NB * 4 * 65;
    u32x4 kreg[3], vreg[3];
#define ATT_FETCH(u_) do { const int qb_ = (u_) % 65, bk_ = (u_) / 65, kvh_ = bk_ & 3, b_ = bk_ >> 2, t0_ = qb_ * 64; const size_t nb_ = (size_t)b_ * LSEQ; \
        _Pragma("unroll") for (int i = 0; i < 3; ++i) { const int c = tid + 512 * i, key = c >> 3, dc = c & 7; int tc = t0_ - 128 + key; tc = tc < 0 ? 0 : (tc > LSEQ - 1 ? LSEQ - 1 : tc); \
            const bf16* src = cols + (nb_ + tc) * CW + kvh_ * 64 + dc * 8; kreg[i] = *(const u32x4*)(src + C_K); vreg[i] = *(const u32x4*)(src + C_V); } } while (0)
    int u = F.vcu, buf = 0;
    if (u < NU) ATT_FETCH(u);
    for (; u < NU; u += F.G, buf ^= 1) {
        LAS unsigned char* Ks = F.lds + buf * BUF_BYTES; LAS unsigned char* Vt = Ks + KS_BYTES;
        const int qb = u % 65, bk = u / 65, kvh = bk & 3, b = bk >> 2, t0 = qb * 64; const size_t nb = (size_t)b * LSEQ;
#pragma unroll
        for (int i = 0; i < 3; ++i) { const int c = tid + 512 * i, key = c >> 3, dc = c & 7; const u32x4 vv = vreg[i];
            *(LAS u32x4*)(Ks + key * 144 + dc * 16) = kreg[i];
            LAS unsigned short* vp = (LAS unsigned short*)(Vt + (8 * dc) * 392 + key * 2);
            vp[0 * 196] = (unsigned short)(vv.x & 0xffffu); vp[1 * 196] = (unsigned short)(vv.x >> 16); vp[2 * 196] = (unsigned short)(vv.y & 0xffffu); vp[3 * 196] = (unsigned short)(vv.y >> 16);
            vp[4 * 196] = (unsigned short)(vv.z & 0xffffu); vp[5 * 196] = (unsigned short)(vv.z >> 16); vp[6 * 196] = (unsigned short)(vv.w & 0xffffu); vp[7 * 196] = (unsigned short)(vv.w >> 16); }
        const int head = kvh * 4 + g, tq = t0 + 32 * qh + r, tqc = tq > LSEQ - 1 ? LSEQ - 1 : tq;
        bf16x8 qf[4];
        { const bf16* qp = cols + (nb + tqc) * CW + C_Q + head * 64 + 8 * h;
#pragma unroll
          for (int ks = 0; ks < 4; ++ks) qf[ks] = *(const bf16x8*)(qp + 16 * ks); }
        if (u + F.G < NU) ATT_FETCH(u + F.G);
        const float slope2 = exp2f(-0.5f * (float)(head + 1)) * 1.44269504089f, sink2 = F.I(I_SINK)[l * 16 + head] * 1.44269504089f;
        __syncthreads();
        f32x16 st[5];
#pragma unroll
        for (int jj = 0; jj < 5; ++jj) { f32x16 a;
#pragma unroll
            for (int i = 0; i < 16; ++i) a[i] = 0.f;
#pragma unroll
            for (int ks = 0; ks < 4; ++ks) { const bf16x8 kf = *(const LAS bf16x8*)(Ks + (32 * (qh + jj) + r) * 144 + (16 * ks + 8 * h) * 2); a = __builtin_amdgcn_mfma_f32_32x32x16_bf16(kf, qf[ks], a, 0, 0, 0); }
            st[jj] = a; }
        float m = sink2;
#pragma unroll
        for (int jj = 0; jj < 5; ++jj) { const int tsb = t0 - 128 + 32 * (qh + jj) + 4 * h, db = 128 - 32 * jj + r - 4 * h; const float dl = slope2 * (float)db; const bool edge = (jj == 0) || (jj == 4) || (t0 - 128 + 32 * (qh + jj) < 0);
            if (!edge) {
#pragma unroll
                for (int i = 0; i < 16; ++i) { const float v = __builtin_fmaf(st[jj][i], 1.44269504089f, __builtin_fmaf(slope2, (float)((i & 3) + 8 * (i >> 2)), -dl)); st[jj][i] = v; m = fmaxf(m, v); }
            } else {
#pragma unroll
                for (int i = 0; i < 16; ++i) { const int cr = (i & 3) + 8 * (i >> 2), dist = db - cr; const bool ok = dist >= 0 && dist < 128 && (tsb + cr) >= 0;
                    const float v = ok ? __builtin_fmaf(st[jj][i], 1.44269504089f, __builtin_fmaf(slope2, (float)cr, -dl)) : -1e30f; st[jj][i] = v; m = fmaxf(m, v); }
            } }
        m = fmaxf(m, __shfl_xor(m, 32));
        float sum = 0.f;
#pragma unroll
        for (int jj = 0; jj < 5; ++jj)
#pragma unroll
            for (int i = 0; i < 16; ++i) { const float pv = __builtin_amdgcn_exp2f(st[jj][i] - m); st[jj][i] = pv; sum += pv; }
        sum += __shfl_xor(sum, 32);
        const float inv = 1.0f / (sum + __builtin_amdgcn_exp2f(sink2 - m));
        f32x16 o[2];
#pragma unroll
        for (int i = 0; i < 16; ++i) { o[0][i] = 0.f; o[1][i] = 0.f; }
#pragma unroll
        for (int jj = 0; jj < 5; ++jj)
#pragma unroll
            for (int s = 0; s < 2; ++s) { u32x4 pw; pw.x = pk_bf16(st[jj][8 * s], st[jj][8 * s + 1]); pw.y = pk_bf16(st[jj][8 * s + 2], st[jj][8 * s + 3]); pw.z = pk_bf16(st[jj][8 * s + 4], st[jj][8 * s + 5]); pw.w = pk_bf16(st[jj][8 * s + 6], st[jj][8 * s + 7]);
                const bf16x8 pf = __builtin_bit_cast(bf16x8, pw);
#pragma unroll
                for (int db2 = 0; db2 < 2; ++db2) { const LAS unsigned char* vb = Vt + (32 * db2 + r) * 392 + (32 * (qh + jj) + 16 * s + 4 * h) * 2;
                    const u32x2 lo = *(const LAS u32x2*)vb, hi = *(const LAS u32x2*)(vb + 16); u32x4 vw; vw.x = lo.x; vw.y = lo.y; vw.z = hi.x; vw.w = hi.y;
                    o[db2] = __builtin_amdgcn_mfma_f32_32x32x16_bf16(__builtin_bit_cast(bf16x8, vw), pf, o[db2], 0, 0, 0); } }
        if (tq < LSEQ) { bf16* op = mix + (nb + tq) * 3072 + 1024 + head * 64 + 4 * h;
#pragma unroll
            for (int db2 = 0; db2 < 2; ++db2)
#pragma unroll
                for (int g4 = 0; g4 < 4; ++g4) { u32x2 w; w.x = pk_bf16(o[db2][4 * g4] * inv, o[db2][4 * g4 + 1] * inv); w.y = pk_bf16(o[db2][4 * g4 + 2] * inv, o[db2][4 * g4 + 3] * inv);
                    *(u32x2*)(op + 32 * db2 + 8 * g4) = w; } }
    }
#undef ATT_FETCH
    __syncthreads();
}
__device__ __forceinline__ void phase_lru_summ(Frame& F) {
    const bf16* Ab = (const bf16*)(F.ws + WS_R6); const bf16* Bb = Ab + (size_t)MP * 1024; float* summ = (float*)(F.ws + WS_SUMM);
    const int gt = ((F.tid >> 8) * F.G + F.vcu) * 256 + (F.tid & 255), NT = F.G * 512;
    for (int it = gt; it < NCHUNK * 256; it += NT) { const int ck = it >> 8, c = (it & 255) * 4, r0 = ck * 64, nr = (r0 + 64) <= NTOK ? 64 : NTOK - r0;
        f32x4 A = (f32x4){1.f, 1.f, 1.f, 1.f}, Bv = (f32x4){0.f, 0.f, 0.f, 0.f};
        const bf16* ap = Ab + (size_t)r0 * 1024 + c; const bf16* bp = Bb + (size_t)r0 * 1024 + c;
        for (int r = 0; r < nr; r += 16) { u32x2 aw[16], bw[16];
#pragma unroll
            for (int i = 0; i < 16; ++i) { aw[i] = *(const u32x2*)(ap + (size_t)(r + i) * 1024); bw[i] = *(const u32x2*)(bp + (size_t)(r + i) * 1024); }
#pragma unroll
            for (int i = 0; i < 16; ++i) { const f32x4 a = (f32x4){1.f - bflo(aw[i].x), 1.f - bfhi(aw[i].x), 1.f - bflo(aw[i].y), 1.f - bfhi(aw[i].y)}, b = (f32x4){bflo(bw[i].x), bfhi(bw[i].x), bflo(bw[i].y), bfhi(bw[i].y)};
                Bv = a * Bv + b; A = A * a; } }
        *(f32x4*)(summ + ((size_t)ck * 1024 + c) * 2) = A; *(f32x4*)(summ + ((size_t)ck * 1024 + c) * 2 + 4) = Bv; }
}
__device__ __forceinline__ void phase_lru_final(Frame& F) {
    const bf16* Ab = (const bf16*)(F.ws + WS_R6); const bf16* Bb = Ab + (size_t)MP * 1024; const float* summ = (const float*)(F.ws + WS_SUMM);
    const bf16* cols = (const bf16*)(F.ws + WS_R2); bf16* mix = (bf16*)(F.ws + WS_R3);
    const int gt = ((F.tid >> 8) * F.G + F.vcu) * 256 + (F.tid & 255), NT = F.G * 512;
    for (int it = gt; it < NCHUNK * 256; it += NT) { const int ck = it >> 8, c = (it & 255) * 4, r0 = ck * 64, nr = (r0 + 64) <= NTOK ? 64 : NTOK - r0;
        const int c0 = ((r0 / LSEQ) * LSEQ) / 64; f32x4 h = (f32x4){0.f, 0.f, 0.f, 0.f};
        int cc = c0;
        for (; cc + 16 <= ck; cc += 16) { f32x4 sa[16], sb[16];
#pragma unroll
            for (int i = 0; i < 16; ++i) { const float* sp = summ + ((size_t)(cc + i) * 1024 + c) * 2; sa[i] = *(const f32x4*)sp; sb[i] = *(const f32x4*)(sp + 4); }
#pragma unroll
            for (int i = 0; i < 16; ++i) h = sa[i] * h + sb[i]; }
        for (; cc + 4 <= ck; cc += 4) { f32x4 sa[4], sb[4];
#pragma unroll
            for (int i = 0; i < 4; ++i) { const float* sp = summ + ((size_t)(cc + i) * 1024 + c) * 2; sa[i] = *(const f32x4*)sp; sb[i] = *(const f32x4*)(sp + 4); }
#pragma unroll
            for (int i = 0; i < 4; ++i) h = sa[i] * h + sb[i]; }
        for (; cc < ck; ++cc) { const float* sp = summ + ((size_t)cc * 1024 + c) * 2; h = *(const f32x4*)sp * h + *(const f32x4*)(sp + 4); }
        const bf16* ap = Ab + (size_t)r0 * 1024 + c; const bf16* bp = Bb + (size_t)r0 * 1024 + c;
        for (int r = 0; r < nr; r += 16) { u32x2 aw[16], bw[16]; u32x2 yw[16];
#pragma unroll
            for (int i = 0; i < 16; ++i) { aw[i] = *(const u32x2*)(ap + (size_t)(r + i) * 1024); bw[i] = *(const u32x2*)(bp + (size_t)(r + i) * 1024); yw[i] = *(const u32x2*)(cols + (size_t)(r0 + r + i) * CW + C_LY + c); }
#pragma unroll
            for (int i = 0; i < 16; ++i) { const f32x4 a = (f32x4){1.f - bflo(aw[i].x), 1.f - bfhi(aw[i].x), 1.f - bflo(aw[i].y), 1.f - bfhi(aw[i].y)}, b = (f32x4){bflo(bw[i].x), bfhi(bw[i].x), bflo(bw[i].y), bfhi(bw[i].y)};
                h = a * h + b;
                const float y[4] = {bflo(yw[i].x), bfhi(yw[i].x), bflo(yw[i].y), bfhi(yw[i].y)}; float o[4];
#pragma unroll
                for (int j = 0; j < 4; ++j) o[j] = h[j] * y[j] * sigmoidf_(1.5957691216f * (y[j] + 0.044715f * y[j] * y[j] * y[j]));
                u32x2 w; w.x = pk_bf16(o[0], o[1]); w.y = pk_bf16(o[2], o[3]); *(u32x2*)(mix + (size_t)(r0 + r + i) * 3072 + 2048 + c) = w; } } }
}
template <int NG, bool DUMMY> __device__ __forceinline__ void ln1_groups(Frame& F, int l, int j0) {
    float* H = (float*)(F.ws + WS_H); float* Hout = DUMMY ? (float*)(F.ws + WS_R6) : H; unsigned char* HB8 = F.ws + (DUMMY ? WS_R3 : WS_HB8); const float* stats = (const float*)(F.ws + WS_STATS);
    const float* g1 = F.I(I_LN1G) + (size_t)l * D; const float* b1 = F.I(I_LN1B) + (size_t)l * D;
    const bf16* whi = (const bf16*)(F.ws + WS_WRT) + (size_t)(l * 2) * 48 * 2048; const bf16* wlo = whi + 48 * 2048;
    const int lane = F.lane, p = lane & 15, kg = lane >> 4, wave = F.wave;
    float mean[NG], rstd[NG]; size_t roff[NG]; f32x4 acc[NG][3];
#pragma unroll
    for (int j = 0; j < NG; ++j) { const int row = (F.vcu + (j0 + j) * F.G) * 16 + p; roff[j] = (size_t)row * D;
        float s = 0.f, q = 0.f; const f32x4* sp = (const f32x4*)(stats + (size_t)row * 64 + kg * 16);
#pragma unroll
        for (int i = 0; i < 4; ++i) { const f32x4 t = sp[i]; s += t[0] + t[2]; q += t[1] + t[3]; }
        s += __shfl_xor(s, 16); s += __shfl_xor(s, 32); q += __shfl_xor(q, 16); q += __shfl_xor(q, 32);
        mean[j] = s * (1.f / D); rstd[j] = 1.f / sqrtf(fmaxf(q * (1.f / D) - mean[j] * mean[j], 0.f) + LN_EPS);
#pragma unroll
        for (int cb = 0; cb < 3; ++cb) acc[j][cb] = (f32x4){0.f, 0.f, 0.f, 0.f}; }
#pragma unroll 2
    for (int ks = 0; ks < 8; ++ks) {
        const int col = wave * 256 + ks * 32 + kg * 8;
        f32x4 y0[NG], y1[NG];
#pragma unroll
        for (int j = 0; j < NG; ++j) { y0[j] = *(const f32x4*)(H + roff[j] + col); y1[j] = *(const f32x4*)(H + roff[j] + col + 4); }
        const f32x4 ga = *(const f32x4*)(g1 + col), gb = *(const f32x4*)(g1 + col + 4), ba = *(const f32x4*)(b1 + col), bb = *(const f32x4*)(b1 + col + 4);
        bf16x8 wh[3], wl[3];
#pragma unroll
        for (int cb = 0; cb < 3; ++cb) { wh[cb] = *(const bf16x8*)(whi + (size_t)(cb * 16 + p) * 2048 + col); wl[cb] = *(const bf16x8*)(wlo + (size_t)(cb * 16 + p) * 2048 + col); }
#pragma unroll
        for (int j = 0; j < NG; ++j) {
            const f32x4 h0 = (y0[j] - mean[j]) * rstd[j] * ga + ba, h1 = (y1[j] - mean[j]) * rstd[j] * gb + bb;
            u32x4 hi; hi.x = pk_bf16(h0[0], h0[1]); hi.y = pk_bf16(h0[2], h0[3]); hi.z = pk_bf16(h1[0], h1[1]); hi.w = pk_bf16(h1[2], h1[3]);
            { u32x2 w8; w8.x = pk_fp8x4(h0[0], h0[1], h0[2], h0[3]); w8.y = pk_fp8x4(h1[0], h1[1], h1[2], h1[3]); *(u32x2*)(HB8 + roff[j] + col) = w8; }
            u32x4 lo; lo.x = pk_bf16(h0[0] - bflo(hi.x), h0[1] - bfhi(hi.x)); lo.y = pk_bf16(h0[2] - bflo(hi.y), h0[3] - bfhi(hi.y));
            lo.z = pk_bf16(h1[0] - bflo(hi.z), h1[1] - bfhi(hi.z)); lo.w = pk_bf16(h1[2] - bflo(hi.w), h1[3] - bfhi(hi.w));
            const bf16x8 xh = __builtin_bit_cast(bf16x8, hi), xl = __builtin_bit_cast(bf16x8, lo);
#pragma unroll
            for (int cb = 0; cb < 3; ++cb) { acc[j][cb] = __builtin_amdgcn_mfma_f32_16x16x32_bf16(wh[cb], xh, acc[j][cb], 0, 0, 0);
                acc[j][cb] = __builtin_amdgcn_mfma_f32_16x16x32_bf16(wh[cb], xl, acc[j][cb], 0, 0, 0); acc[j][cb] = __builtin_amdgcn_mfma_f32_16x16x32_bf16(wl[cb], xh, acc[j][cb], 0, 0, 0); } }
    }
#pragma unroll
    for (int j = 0; j < NG; ++j) { LAS float* lgs = (LAS float*)(F.lds + (j0 + j) * 24576);
#pragma unroll
        for (int cb = 0; cb < 3; ++cb) *(LAS f32x4*)(lgs + (wave * 16 + p) * 48 + cb * 16 + kg * 4) = acc[j][cb]; }
}
template <bool DUMMY> __device__ __forceinline__ void phase_ln1_router(Frame& F, int l) {
    float* H = (float*)(F.ws + WS_H); float* Hout = DUMMY ? (float*)(F.ws + WS_R6) : H; unsigned char* HB8 = F.ws + (DUMMY ? WS_R3 : WS_HB8); const float* stats = (const float*)(F.ws + WS_STATS);
    int* tokinfo = (int*)(F.ws + (DUMMY ? WS_R45 + 4 * MiB : WS_TOKINFO)); int* elist = (int*)(F.ws + (DUMMY ? WS_R45 : WS_ELIST)); unsigned* count = (unsigned*)(F.ws + WS_CTL) + CW_COUNT + ((DUMMY ? 64 : 0) + l * 32) * CNT_STRIDE;
    const float* g1 = F.I(I_LN1G) + (size_t)l * D; const float* b1 = F.I(I_LN1B) + (size_t)l * D;
    const bf16* whi = (const bf16*)(F.ws + WS_WRT) + (size_t)(l * 2) * 48 * 2048; const bf16* wlo = whi + 48 * 2048;
    const float* bg = F.I(I_RGB) + l * 4; const float* be = F.I(I_REB) + l * 32;
    const int lane = F.lane, p = lane & 15, kg = lane >> 4, wave = F.wave;
    ln1_groups<4, DUMMY>(F, l, 0); if (F.vcu + 4 * F.G < NTOK / 16) ln1_groups<1, DUMMY>(F, l, 4);
    __syncthreads();
    LAS unsigned* lcnt = (LAS unsigned*)(F.lds + TBL_OFF + 512);
    if (F.tid < 64) lcnt[F.tid] = 0u;
    __syncthreads();
    int ea = 0, eb = 0, n = 0; unsigned la = 0u, lb = 0u; float w0 = 0.f, w1 = 0.f; bool have = false;
    { const int grp = F.vcu + wave * F.G;
        if (grp < NTOK / 16 && lane < 16) {
            const LAS float* lgs = (const LAS float*)(F.lds + wave * 24576);
            n = grp * 16 + lane; have = true; float lg[36];
            const f32x4 bgv = *(const f32x4*)bg; f32x4 bev[8];
#pragma unroll
            for (int i = 0; i < 8; ++i) bev[i] = *(const f32x4*)(be + 4 * i);
#pragma unroll
            for (int i = 0; i < 36; ++i) lg[i] = 0.f;
#pragma unroll 1
            for (int w = 0; w < 8; ++w) {
#pragma unroll
                for (int i4 = 0; i4 < 9; ++i4) { const f32x4 t = *(const LAS f32x4*)(lgs + (w * 16 + lane) * 48 + 4 * i4); lg[4 * i4] += t[0]; lg[4 * i4 + 1] += t[1]; lg[4 * i4 + 2] += t[2]; lg[4 * i4 + 3] += t[3]; } }
            float gl[4];
#pragma unroll
            for (int i = 0; i < 4; ++i) gl[i] = lg[i] + bgv[i];
            int g = 0; float gm = gl[0];
#pragma unroll
            for (int i = 1; i < 4; ++i) if (gl[i] > gm) { gm = gl[i]; g = i; }
            float gs = 0.f;
#pragma unroll
            for (int i = 0; i < 4; ++i) gs += fast_exp(gl[i] - gm);
            const float pg = 1.0f / gs;
            float el[8];
#pragma unroll
            for (int j = 0; j < 8; ++j) { const float x0 = lg[4 + j] + bev[j >> 2][j & 3], x1 = lg[12 + j] + bev[2 + (j >> 2)][j & 3], x2 = lg[20 + j] + bev[4 + (j >> 2)][j & 3], x3 = lg[28 + j] + bev[6 + (j >> 2)][j & 3]; el[j] = g == 0 ? x0 : g == 1 ? x1 : g == 2 ? x2 : x3; }
            int i0 = 0; float m0 = el[0];
#pragma unroll
            for (int j = 1; j < 8; ++j) if (el[j] > m0) { m0 = el[j]; i0 = j; }
            int i1 = -1; float m1 = -3.0e38f;
#pragma unroll
            for (int j = 0; j < 8; ++j) if (j != i0 && el[j] > m1) { m1 = el[j]; i1 = j; }
            const float e1 = fast_exp(m1 - m0); w0 = pg / (1.0f + e1); w1 = pg * e1 / (1.0f + e1);
            ea = g * 8 + i0; eb = g * 8 + i1;
            la = __hip_atomic_fetch_add(lcnt + ea, 1u, __ATOMIC_RELAXED, __HIP_MEMORY_SCOPE_WORKGROUP); lb = __hip_atomic_fetch_add(lcnt + eb, 1u, __ATOMIC_RELAXED, __HIP_MEMORY_SCOPE_WORKGROUP);
        }
    }
    __syncthreads();
    if (F.tid < 32) { const unsigned c = lcnt[F.tid]; lcnt[32 + F.tid] = c ? __hip_atomic_fetch_add(count + F.tid * CNT_STRIDE, c, RLX_AGENT) : 0u; }
    __syncthreads();
    if (have) { const unsigned ra = lcnt[32 + ea] + la, rb = lcnt[32 + eb] + lb;
        elist[(size_t)ea * NTOK + ra] = n; elist[(size_t)eb * NTOK + rb] = n;
        int* ti = tokinfo + (size_t)n * 8; ti[0] = ea; ti[1] = (int)ra; ti[2] = __float_as_int(w0); ti[3] = eb; ti[4] = (int)rb; ti[5] = __float_as_int(w1); }
    __syncthreads();
    const int gw = F.vcu * 8 + F.wave, NGW = F.G * 8;
    LAS float* scr = (LAS float*)(F.lds + F.wave * 16384);
    if (!DUMMY) for (int it = gw; it < 49152; it += NGW) conv_expert_weights(F, l, it, scr);
}
__device__ __forceinline__ void moe_tables(Frame& F, int l) {
    LAS int* tb = (LAS int*)(F.lds + TBL_OFF);
    __syncthreads();
    if (F.tid < 64) { const unsigned* count = (const unsigned*)(F.ws + WS_CTL) + CW_COUNT + l * 32 * CNT_STRIDE; const int e = F.tid;
        const int cn = e < 32 ? (int)__hip_atomic_load(count + e * CNT_STRIDE, RLX_AGENT) : 0; const int tiles = (cn + 255) >> 8; int incl = tiles;
#pragma unroll
        for (int d = 1; d < 32; d <<= 1) { const int t = __shfl_up(incl, d); if (e >= d) incl += t; }
        if (e < 32) { tb[e] = incl - tiles; tb[40 + e] = cn; } if (e == 31) tb[32] = incl; }
    __syncthreads();
}
template <bool DUMMY> __device__ __forceinline__ void phase_final(Frame& F, int l) {
    float* H = (float*)(F.ws + WS_H); bf16* HB = (bf16*)(F.ws + (DUMMY ? WS_R45 : WS_HB)); float* Hout = DUMMY ? (float*)(F.ws + WS_R6) : H; unsigned char* H8 = F.ws + (DUMMY ? WS_R3 : WS_HB8); const unsigned char* yd = F.ws + WS_R1; const int* tokinfo = (const int*)(F.ws + WS_TOKINFO);
    const LAS int* tb = (const LAS int*)(F.lds + TBL_OFF);
    const float* g2 = F.I(I_LN2G) + (size_t)l * D; const float* b2 = F.I(I_LN2B) + (size_t)l * D; const float* g1 = F.I(I_LN1G) + (size_t)l * D; const float* b1 = F.I(I_LN1B) + (size_t)l * D; const float* stats = (const float*)(F.ws + WS_STATS);
    const int gw = F.vcu * 8 + F.wave, NGW = F.G * 8, lane = F.lane;
    for (int n = gw; n < NTOK; n += NGW) {
        const int t = n % LSEQ, b = n / LSEQ;
        if (!DUMMY && l == DEPTH - 1 && t < NMETA) continue;
        const int* ti = tokinfo + (size_t)n * 8; const int ea = ti[0], ra = ti[1], eb = ti[3], rb = ti[4]; const float w0 = __int_as_float(ti[2]) * (1.0f / YD_SCALE), w1 = __int_as_float(ti[5]) * (1.0f / YD_SCALE);
        const unsigned char* ya = yd + ((size_t)tb[ea] * 256 + ra) * D; const unsigned char* yb = yd + ((size_t)tb[eb] * 256 + rb) * D;
        f32x4 v[8]; load_row_f32(H + (size_t)n * D, v, lane);
        { float s = 0.f, q = 0.f;
          if (lane < 16) { const f32x4 t = *(const f32x4*)(stats + (size_t)n * 64 + 4 * lane); s = t[0] + t[2]; q = t[1] + t[3]; }
          s = wave_sum(s); q = wave_sum(q);
          const float mean = s * (1.f / D), rstd = 1.f / sqrtf(fmaxf(q * (1.f / D) - mean * mean, 0.f) + LN_EPS);
#pragma unroll
          for (int j = 0; j < 8; ++j) { const f32x4 gg = *(const f32x4*)(g1 + 4 * lane + 256 * j), bb = *(const f32x4*)(b1 + 4 * lane + 256 * j); v[j] = (v[j] - mean) * rstd * gg + bb; } }
#pragma unroll
        for (int j = 0; j < 8; ++j) { const unsigned a = *(const unsigned*)(ya + 4 * lane + 256 * j), c = *(const unsigned*)(yb + 4 * lane + 256 * j);
            const f32x2 a0 = __builtin_amdgcn_cvt_pk_f32_fp8((int)a, false), a1 = __builtin_amdgcn_cvt_pk_f32_fp8((int)a, true), c0 = __builtin_amdgcn_cvt_pk_f32_fp8((int)c, false), c1 = __builtin_amdgcn_cvt_pk_f32_fp8((int)c, true);
            v[j].x = v[j].x * ALPHA + w0 * a0.x + w1 * c0.x; v[j].y = v[j].y * ALPHA + w0 * a0.y + w1 * c0.y;
            v[j].z = v[j].z * ALPHA + w0 * a1.x + w1 * c1.x; v[j].w = v[j].w * ALPHA + w0 * a1.y + w1 * c1.y; }
        ln_regs(v, g2, b2, lane);
        if (!DUMMY && l == DEPTH - 1) store_row_f32(F.out + ((size_t)b * SEQ + (t - NMETA)) * D, v, lane);
        else { store_row_f32(Hout + (size_t)n * D, v, lane); store_row_bf16(HB + (size_t)n * D, v, lane); store_row_fp8(H8 + (size_t)n * D, v, lane); }
    }
}

constexpr int NPHASE = 1 + DEPTH * 11;
#define IN(k) (lo <= (k) && (k) < hi)
#define SEAM(k) do { if (IN(k) && IN((k) + 1)) { XcdBarrier b_ = bar; asm volatile("" : "+s"(b_.bar), "+s"(b_.x)); xcd_barrier(b_); } } while (0)
#define PH_BEGIN() F.z = opaque_s(0); F.ws = args.ws + F.z; F.vcu = vcu0 + F.z; F.tid = opaque_v(tid0); F.lane = F.tid & 63; F.wave = __builtin_amdgcn_readfirstlane(F.tid >> 6); const int bx = bx0 + F.z; (void)bx
template <int L> __device__ __forceinline__ void run_layer(Frame& F, const Args& args, const XcdBarrier& bar, const int lo, const int hi, const int bx0, const int vcu0, const int tid0) {
    constexpr int l = L; constexpr int pb = 1 + L * 11;
#define wl (F.ws + WS_WSMALL + (size_t)l * WL_BYTES)
        if (IN(pb + 0)) PREP(1) { PH_BEGIN();
            { PolA_<false> p; p.K = D; p.lda = D; p.ldb = D; p.A = F.ws + WS_HB; p.Bt = wl + WL_WIN; p.out = (bf16*)(F.ws + WS_R2); p.outc = p.out; p.G = F.G; p.c = bx;
              pg8::gemm_phase(F.lds, p, F.tid, F.ws); }
            { PolA_<true> p; p.K = D; p.lda = D; p.ldb = D; p.A = F.ws + WS_HB8; p.Bt = wl + WL_WIN8; p.out = (bf16*)(F.ws + WS_R1); p.outc = (bf16*)(F.ws + WS_R2); p.G = F.G; p.c = (F.G == 256) ? ((bx + A_LIGHT) & 255) : bx;
              pg8::gemm_phase(F.lds, p, F.tid, F.ws); } }
        SEAM(pb + 0);
        if (IN(pb + 1)) PREP(2) { PH_BEGIN();
            { PolW p; p.K = 256; p.lda = 1024; p.ldb = 256; p.pt = (const bf16*)(wl + WL_PROJ); p.wsc = (const bf16*)(F.ws + WS_WSC) + (size_t)l * 4 * 65536; p.wct = (bf16*)(F.ws + WS_WCT) + (size_t)l * D * 1024; p.G = F.G; p.c = (F.vcu + (F.G >> 1)) % F.G;
              pg8::gemm_phase(F.lds, p, F.tid, F.ws); }
            phase_delta_conv(F, l); phase_attn(F, l); }
        SEAM(pb + 1);
        if (IN(pb + 2)) PREP(3) { PH_BEGIN();
            PolC p; p.K = 256; p.lda = 1024; p.ldb = 256; p.delta = (const bf16*)(F.ws + WS_R45); p.xc = p.delta + (size_t)MP * 1024; p.pool_t = (const bf16*)(wl + WL_POOL); p.lru_t = (const bf16*)(wl + WL_LRU);
            p.mix = (bf16*)(F.ws + WS_R3); p.Abuf = (bf16*)(F.ws + WS_R6); p.Bbuf = p.Abuf + (size_t)MP * 1024; p.pool_scale = F.I(I_POOLS) + (size_t)l * 1024; p.ba = F.I(I_BA) + (size_t)l * 1024; p.bx = F.I(I_BX) + (size_t)l * 1024;
            p.sp8 = (const float*)(F.ws + WS_SP8) + (size_t)l * 1024; p.G = F.G; p.c = bx;
            pg8::gemm_phase(F.lds, p, F.tid, F.ws); tail_lru(F, l); }
        SEAM(pb + 2);
        if (IN(pb + 3)) PREP(4) { PH_BEGIN(); phase_lru_summ(F); }
        SEAM(pb + 3);
        if (IN(pb + 4)) PREP(5) { PH_BEGIN(); phase_lru_final(F); }
        SEAM(pb + 4);
        if (IN(pb + 5)) PREP(6) { PH_BEGIN();
            PolE p; p.K = 1024; p.lda = 3072; p.ldb = 1024; p.mix = (const bf16*)(F.ws + WS_R3); p.proj_t = (const bf16*)(wl + WL_PROJ); p.wct = (const bf16*)(F.ws + WS_WCT) + (size_t)l * D * 1024; p.gates = F.ws + WS_R1; p.merged = (bf16*)(F.ws + WS_R45); p.G = F.G; p.c = bx;
            p.t0 = 0; p.t1 = 512; pg8::gemm_phase(F.lds, p, F.tid, F.ws); tail_merge(F, l); }
        SEAM(pb + 5);
        if (IN(pb + 6)) PREP(7) { PH_BEGIN();
            PolF p; p.K = D; p.lda = D; p.ldb = D; p.A = (const bf16*)(F.ws + WS_R45); p.Bt = (const bf16*)(wl + WL_WOUT); p.H = (float*)(F.ws + WS_H); p.stats = (float*)(F.ws + WS_STATS); p.G = F.G; p.c = bx;
            p.t0 = 0; p.t1 = 512; pg8::gemm_phase(F.lds, p, F.tid, F.ws); tail_wout(F, l); }
        SEAM(pb + 6);
        if (IN(pb + 7)) PREP(8) { PH_BEGIN(); if (PROBE_G2) phase_ln1_router<true>(F, l); phase_ln1_router<false>(F, l); }
        SEAM(pb + 7);
        if (IN(pb + 8)) PREP(9) { PH_BEGIN();
            moe_tables(F, l);
            PolI p; p.K = D; p.lda = D; p.ldb = D; p.X = F.ws + WS_HB8; p.gu = F.ws + WS_R2 + EXPW_GU; p.elist = (const int*)(F.ws + WS_ELIST); p.hdn = F.ws + WS_R3;
            p.T.t = (const LAS int*)(F.lds + TBL_OFF); p.G = F.G; p.c = bx;
            pg8::gemm_phase(F.lds, p, F.tid, F.ws); }
        SEAM(pb + 8);
        if (IN(pb + 9)) PREP(10) { PH_BEGIN();
            moe_tables(F, l);
            PolJ p; p.K = DE; p.lda = DE; p.ldb = DE; p.hdn = F.ws + WS_R3; p.wd = F.ws + WS_R2 + EXPW_WD; p.yd = F.ws + WS_R1; p.T.t = (const LAS int*)(F.lds + TBL_OFF); p.G = F.G; p.c = bx;
            pg8::gemm_phase(F.lds, p, F.tid, F.ws); }
        SEAM(pb + 9);
        if (IN(pb + 10)) PREP(11) { PH_BEGIN(); moe_tables(F, l); if (PROBE_K2) phase_final<true>(F, l); phase_final<false>(F, l); }
        SEAM(pb + 10);
    }
#undef wl
__global__ void __launch_bounds__(512, 2) fwd(Args args) {
    extern __shared__ __attribute__((aligned(16))) unsigned char lds_raw[];
    Frame F; F.lds = (LAS unsigned char*)lds_raw; F.inp = args.in; F.z = 0; F.out = args.out; F.ws = args.ws;
    F.tid = threadIdx.x; F.lane = F.tid & 63; F.wave = __builtin_amdgcn_readfirstlane(F.tid >> 6);
    F.G = gridDim.x; { const int bx = blockIdx.x; F.vcu = (F.G % 8 == 0) ? (bx % 8) * (F.G / 8) + bx / 8 : bx; }
    volatile LAS unsigned* MISC = (volatile LAS unsigned*)(F.lds + MISC_OFF);
    for (int u = F.tid; u < (LDS_BYTES - MISC_OFF) / 4; u += 512) ((LAS unsigned*)(F.lds + MISC_OFF))[u] = 0u;
    __syncthreads();
    unsigned* ctl = (unsigned*)(F.ws + WS_CTL);
    XcdBarrier bar; bar.bar = ctl + CW_BAR; bar.x = 0; bar.st = nullptr;
    if (MK_ONE_LAUNCH) bar = xcd_barrier_post(ctl + CW_BAR, MISC + 8);
    const int lo = args.ph_lo, hi = args.ph_hi;
    const int bx0 = (int)blockIdx.x, vcu0 = F.vcu, tid0 = F.tid;

    if (IN(0)) PREP(0) { PH_BEGIN(); p0_prologue(F); } SEAM(0);

    run_layer<0>(F, args, bar, lo, hi, bx0, vcu0, tid0);
    run_layer<1>(F, args, bar, lo, hi, bx0, vcu0, tid0);
#undef IN
#undef SEAM
}

extern "C" void kernel_launch(void* const* d_in, const int* in_sizes, int n_in, void* d_out, int out_size, void* d_ws, size_t ws_size, hipStream_t stream) {
    static int grid = 0;
    if (grid == 0) {
        if (n_in != 30 || out_size != NB * SEQ * D || ws_size < WS_END) { fprintf(stderr, "kernel_launch: unexpected shapes (n_in %d, out %d, ws %zu)\n", n_in, out_size, ws_size); grid = -1; return; }
        int dev = 0, cus = 0, per_cu = 0;
        if (hipGetDevice(&dev) != hipSuccess || hipDeviceGetAttribute(&cus, hipDeviceAttributeMultiprocessorCount, dev) != hipSuccess) { grid = -1; return; }
        if (hipFuncSetAttribute((const void*)fwd, hipFuncAttributeMaxDynamicSharedMemorySize, LDS_BYTES) != hipSuccess) { fprintf(stderr, "kernel_launch: hipFuncSetAttribute failed\n"); grid = -1; return; }
        if (hipOccupancyMaxActiveBlocksPerMultiprocessor(&per_cu, (const void*)fwd, 512, LDS_BYTES) != hipSuccess || per_cu < 1) fprintf(stderr, "kernel_launch: occupancy query says %d\n", per_cu);
        (void)hipGetLastError();
        grid = cus;
    }
    if (grid < 0) return;
    (void)hipMemsetAsync((char*)d_ws + WS_CTL, 0, CTL_ZERO_BYTES, stream);
    Args a{};
    for (int i = 0; i < 30; ++i) a.in[i] = (const float*)d_in[i];
    a.out = (float*)d_out; a.ws = (unsigned char*)d_ws;
#if MK_ONE_LAUNCH
    a.ph_lo = 0; a.ph_hi = NPHASE;
    hipLaunchKernelGGL(fwd, dim3(grid), dim3(512), LDS_BYTES, stream, a);
#else
    for (int k = 0; k < NPHASE; ++k) { a.ph_lo = k; a.ph_hi = k + 1; hipLaunchKernelGGL(fwd, dim3(grid), dim3(512), LDS_BYTES, stream, a); }
#endif
}
```

```cpp
#include <hip/hip_runtime.h>
#include <cstdio>
#include <cstdint>

#define PROBE_MASK 0
#define PROBE_K2 0
#define PROBE_G2 0
#define PREP(k) for (int rep_ = 0; rep_ < (((PROBE_MASK) >> (k)) & 1) + 1; ++rep_)
#ifndef MK_ONE_LAUNCH
#define MK_ONE_LAUNCH 1
#endif

#define LAS __attribute__((address_space(3)))
#define GAS __attribute__((address_space(1)))
typedef unsigned short bf16;
typedef short bf16x8 __attribute__((ext_vector_type(8)));
typedef float f32x4 __attribute__((ext_vector_type(4)));
typedef float f32x2 __attribute__((ext_vector_type(2)));
typedef unsigned u32x4 __attribute__((ext_vector_type(4)));
typedef unsigned u32x2 __attribute__((ext_vector_type(2)));
typedef __bf16 bf16x2_t __attribute__((ext_vector_type(2)));
typedef int i32x4 __attribute__((ext_vector_type(4)));
typedef int i32x8 __attribute__((ext_vector_type(8)));
typedef GAS unsigned gu32;
#define RLX_AGENT __ATOMIC_RELAXED, __HIP_MEMORY_SCOPE_AGENT
#define LDS_WAIT() asm volatile("s_waitcnt lgkmcnt(0)" ::: "memory")
#define VM_WAIT() asm volatile("s_waitcnt vmcnt(0)" ::: "memory")

constexpr int D = 2048, NB = 4, SEQ = 4096, NMETA = 16, LSEQ = SEQ + NMETA, NTOK = NB * LSEQ  , MP = 16640  , NPANEL = 65, DEPTH = 2;
constexpr int CW = 4608  , GW = 6144, INC = CW + GW;
#ifndef A8_MASK
#define A8_MASK 0x3FE00u
#endif
constexpr int C_POOL = 0, C_Q = 1024, C_K = 2048, C_V = 2304, C_LX = 2560, C_LY = 3584;
constexpr int NEXP = 32, DE = 512, CAPT = 161, CAP = CAPT * 256, NCHUNK = (NTOK + 63) / 64  ;
constexpr float LN_EPS = 1e-5f, ALPHA = 1.41421356237f;

constexpr size_t MiB = 1u << 20;
constexpr size_t WS_CTL = 0, CTL_ZERO_BYTES = 1 * MiB;
constexpr size_t WS_SP8 = 1 * MiB;
constexpr size_t WS_TOKINFO = 2 * MiB;
constexpr size_t WS_ELIST = 3 * MiB;
constexpr size_t WS_SUMM = 6 * MiB;
constexpr size_t WS_WSMALL = 9 * MiB;
constexpr size_t WL_WIN8 = (size_t)CW * 2048 * 2;
constexpr size_t WL_BYTES = 66584576, WL_WIN = 0, WL_PROJ = 44040192, WL_WOUT = 56623104, WL_POOL = 65011712, WL_LRU = 65536000;
constexpr size_t WS_H = 136 * MiB;
constexpr size_t WS_HB = 266 * MiB;
constexpr size_t WS_R1 = 331 * MiB;
constexpr size_t WS_R2 = 526 * MiB;
constexpr size_t WS_R6 = 673 * MiB;
constexpr size_t WS_R3 = 803 * MiB;
constexpr size_t WS_R45 = 901 * MiB;
constexpr size_t WS_STATS = 966 * MiB;
constexpr size_t WS_WRT = 972 * MiB;
constexpr size_t WS_HB8 = 974 * MiB;
constexpr size_t WS_WSC = 1008 * MiB;
constexpr size_t WS_WCT = 1010 * MiB;
constexpr size_t WS_END = 1018 * MiB;
constexpr size_t EXPW_GU = 0, EXPW_WD = 67108864;
constexpr float W8_SCALE = 64.0f, HDN_SCALE = 8.0f, YD_SCALE = 16.0f;
static_assert(WS_WSMALL + 2 * WL_BYTES <= WS_H && WS_R2 + 201326592 <= WS_R3 && WS_R6 + 2ull * MP * 1024 * 4 <= WS_R3 && WS_R3 + (size_t)MP * 3072 * 2 <= WS_R45 && WS_R45 + (size_t)MP * 2048 * 2 <= WS_END, "ws map");
static_assert(WS_R1 + (size_t)MP * GW * 2 <= WS_R2 && (size_t)CAP * 2048 * 2 <= (size_t)MP * GW * 2 && WS_R2 + (size_t)MP * CW * 2 <= WS_R6, "ws map 2");
constexpr int CW_BAR = 4096;
constexpr int CW_COUNT = 16384, CNT_STRIDE = 32;

constexpr int RING_BYTES = 131072, MISC_OFF = RING_BYTES, TBL_OFF = RING_BYTES + 1024, LDS_BYTES = 147456;

__device__ __forceinline__ unsigned pk_bf16(float lo, float hi) { f32x2 v = {lo, hi}; bf16x2_t b = __builtin_convertvector(v, bf16x2_t); return __builtin_bit_cast(unsigned, b); }
__device__ __forceinline__ unsigned pk_fp8x4(float a, float b, float c, float d) { int w = 0; w = __builtin_amdgcn_cvt_pk_fp8_f32(a, b, w, false); w = __builtin_amdgcn_cvt_pk_fp8_f32(c, d, w, true); return (unsigned)w; }
__device__ __forceinline__ float bf2f(unsigned short b) { return __uint_as_float(((unsigned)b) << 16); }
__device__ __forceinline__ float bflo(unsigned w) { return __uint_as_float(w << 16); }
__device__ __forceinline__ float bfhi(unsigned w) { return __uint_as_float(w & 0xffff0000u); }
__device__ __forceinline__ float fast_exp(float x) { return __builtin_amdgcn_exp2f(x * 1.44269504089f); }
__device__ __forceinline__ float sigmoidf_(float x) { return __builtin_amdgcn_rcpf(1.0f + fast_exp(-x)); }
__device__ __forceinline__ unsigned pk_gate4(float a, float b, float c, float d) {
    unsigned r = __builtin_amdgcn_cvt_pk_u8_f32(a * 255.0f, 0u, 0u); r = __builtin_amdgcn_cvt_pk_u8_f32(b * 255.0f, 1u, r); r = __builtin_amdgcn_cvt_pk_u8_f32(c * 255.0f, 2u, r); return __builtin_amdgcn_cvt_pk_u8_f32(d * 255.0f, 3u, r); }
__device__ __forceinline__ float wave_sum(float v) {
#pragma unroll
    for (int o = 1; o < 64; o <<= 1) v += __shfl_xor(v, o);
    return v;
}
__device__ __forceinline__ float wave_max(float v) {
#pragma unroll
    for (int o = 1; o < 64; o <<= 1) v = fmaxf(v, __shfl_xor(v, o));
    return v;
}

namespace pg8 {
constexpr int BM = 256, BK = 64, HALF = 128, HTB = HALF * BK * 2, STAGE_BYTES = 8 * HTB;
__host__ __device__ __forceinline__ int lds_byte(int r, int c) { const int st = (r >> 4) * 2 + (c >> 5), rr = r & 15, cc = c & 31, ob = rr * 64 + cc * 2; return st * 1024 + (ob ^ (((ob >> 9) & 1) << 5)); }
__host__ __device__ __forceinline__ void stage_rc(int b, int& R, int& C) { const int st = b / 1024, sb = b % 1024, swz = sb ^ (((sb >> 9) & 1) << 5); R = (st >> 1) * 16 + swz / 64; C = (st & 1) * 32 + (swz % 64) / 2; }
__host__ __device__ __forceinline__ int perm32(int rho) { const int n = rho >> 4, i = rho & 15; return 8 * (i >> 2) + 4 * n + (i & 3); }
struct Unit { int pm, pn, z; };

template <class P, class = void> struct adj_trait { static constexpr bool v = false; };
template <class P> struct adj_trait<P, decltype((void)P::ADJ)> { static constexpr bool v = P::ADJ; };
template <class P> __host__ __device__ constexpr bool adj_b() { return adj_trait<P>::v; }
template <class P, bool TAIL = false>
__device__ __forceinline__ void gemm_phase(LAS unsigned char* lds, const P& p, const int tid, const unsigned char* wsbase) {
    const __amdgpu_buffer_rsrc_t rsrc = __builtin_amdgcn_make_buffer_rsrc((void*)wsbase, 0, 0xffffffffu, 0x00020000);
    const int wid = __builtin_amdgcn_readfirstlane(tid >> 6), lane = tid & 63, wr = wid >> 2, wc = wid & 3, fr = lane & 15, fq = lane >> 4;
    constexpr int ESZ = P::ESZ;
    const int K = p.K, nt = K * ESZ / 128, lda = p.lda, ldb = p.ldb;
    unsigned voffA[2], voffB[2]; int Rr[2], Cc[2];
#pragma unroll
    for (int i = 0; i < 2; ++i) { int R, C; stage_rc(tid * 16 + i * 8192, R, C); Rr[i] = R; Cc[i] = C; const int Rb = adj_b<P>() ? (64 * (R >> 5) + perm32(R & 31)) : (P::PERM ? ((R & ~31) + perm32(R & 31)) : R);
        voffA[i] = (unsigned)(R * lda * ESZ + C * 2); voffB[i] = (unsigned)(Rb * ldb * ESZ + C * 2); }
    const unsigned kstep = (unsigned)(BK * 2);
    const unsigned hstepA = (unsigned)(HALF * lda * ESZ), hstepB = (unsigned)((adj_b<P>() ? 32 : HALF) * ldb * ESZ);
    const unsigned ldsw0 = (unsigned)wid * 1024u; const unsigned ldsw = ldsw0;
    const int aoff = lds_byte(wr * 64 + fr, fq * 8), boff = lds_byte(wc * 32 + fr, fq * 8);
    auto opaque_tid = [&]() { int t_ = tid; asm volatile("" : "+v"(t_)); return t_; };
    unsigned vc[2][2];
#define PG8_SA(b, h) (((b) * 2 + (h)) * HTB)
#define PG8_SB(b, h) ((4 + (b) * 2 + (h)) * HTB)
#define PG8_GLDS(so, vo, ldsoff) __builtin_amdgcn_raw_ptr_buffer_load_lds(rsrc, (LAS void*)(lds + (ldsoff)), 16, (int)(vo), (int)(so), 0, 0)
#define PG8_STAGE_B(bufoff, gb) do { PG8_GLDS((gb), voffB[0], (bufoff) + ldsw); PG8_GLDS((gb), voffB[1], (bufoff) + ldsw + 8192); } while (0)
#define PG8_STAGE_A(bufoff, ga, h, NX) do { if constexpr (P::GATHER) { PG8_GLDS((ga), vc[h][0], (bufoff) + ldsw); PG8_GLDS((ga), vc[h][1], (bufoff) + ldsw + 8192); } \
        else { PG8_GLDS((ga) + (h) * hstepA, voffA[0], (bufoff) + ldsw); PG8_GLDS((ga) + (h) * hstepA, voffA[1], (bufoff) + ldsw + 8192); } } while (0)
#define PG8_LDA(dst, b, h) do { if constexpr (TAIL) { if ((h) == 1 || wr == 1) break; } _Pragma("unroll") for (int m = 0; m < 4; ++m) _Pragma("unroll") for (int k = 0; k < 2; ++k) dst[m][k] = *(const LAS bf16x8*)(lds + PG8_SA(b, h) + aoff + m * 2048 + k * 1024); } while (0)
#define PG8_LDB(dst, b, h) do { if constexpr (TAIL) { if (wr == 1) break; } _Pragma("unroll") for (int n = 0; n < 2; ++n) _Pragma("unroll") for (int k = 0; k < 2; ++k) dst[n][k] = *(const LAS bf16x8*)(lds + PG8_SB(b, h) + boff + n * 2048 + k * 1024); } while (0)
#define PG8_MMA(ai, bj, At, Bt) do { if constexpr (TAIL) { if ((ai) == 1 || wr == 1) break; } __builtin_amdgcn_s_setprio(1); _Pragma("unroll") for (int m = 0; m < 4; ++m) _Pragma("unroll") for (int n = 0; n < 2; ++n) { \
        if constexpr (ESZ == 2) { _Pragma("unroll") for (int k = 0; k < 2; ++k) acc[ai][bj][m][n] = __builtin_amdgcn_mfma_f32_16x16x32_bf16(Bt[n][k], At[m][k], acc[ai][bj][m][n], 0, 0, 0); } \
        else { const i32x8 b8_ = __builtin_shufflevector(__builtin_bit_cast(i32x4, Bt[n][0]), __builtin_bit_cast(i32x4, Bt[n][1]), 0, 1, 2, 3, 4, 5, 6, 7), a8_ = __builtin_shufflevector(__builtin_bit_cast(i32x4, At[m][0]), __builtin_bit_cast(i32x4, At[m][1]), 0, 1, 2, 3, 4, 5, 6, 7); \
               asm volatile("v_mfma_f32_16x16x128_f8f6f4 %0, %1, %2, %0" : "+v"(acc[ai][bj][m][n]) : "v"(b8_), "v"(a8_)); } } \
        __builtin_amdgcn_s_setprio(0); } while (0)
#define PG8_WAIT_V(n) asm volatile("s_waitcnt vmcnt(" #n ")" ::: "memory")
#define PG8_WAIT_L(n) asm volatile("s_waitcnt lgkmcnt(" #n ")" ::: "memory")
#define PG8_BAR __builtin_amdgcn_s_barrier()
#define PG8_SCHED __builtin_amdgcn_sched_barrier(0)
#define PG8_ROWOFFS(dst, u) do { _Pragma("unroll") for (int i_ = 0; i_ < 2; ++i_) { int R_, C_; stage_rc(opaque_tid() * 16 + i_ * 8192, R_, C_); _Pragma("unroll") for (int h_ = 0; h_ < 2; ++h_) dst[h_][i_] = (unsigned)(p.a_row(u, h_ * HALF + R_) * lda * ESZ + C_ * 2); } } while (0)
    Unit cur, nxt; int ui = 0;
    if (!p.next(0, cur)) return;
    f32x4 acc[2][2][4][2];
#pragma unroll
    for (int a = 0; a < 2; ++a)
#pragma unroll
        for (int b = 0; b < 2; ++b)
#pragma unroll
            for (int m = 0; m < 4; ++m)
#pragma unroll
                for (int n = 0; n < 2; ++n) acc[a][b][m][n] = (f32x4){0.f, 0.f, 0.f, 0.f};
    bf16x8 At[4][2], B0[2][2], B1[2][2];
    unsigned cA = (unsigned)((const unsigned char*)p.a_ptr(cur) - wsbase), cB = (unsigned)((const unsigned char*)p.b_ptr(cur) - wsbase);
    if constexpr (P::GATHER) { PG8_ROWOFFS(vc, cur); }
    PG8_STAGE_B(PG8_SB(0, 0), cB); PG8_STAGE_B(PG8_SB(0, 1), cB + hstepB); PG8_STAGE_A(PG8_SA(0, 0), cA, 0, false); PG8_STAGE_A(PG8_SA(0, 1), cA, 1, false);
    if (wr == 1) PG8_BAR;
    PG8_WAIT_V(2); PG8_BAR;
    PG8_STAGE_B(PG8_SB(1, 0), cB + kstep); PG8_STAGE_A(PG8_SA(1, 0), cA + kstep, 0, false); PG8_STAGE_B(PG8_SB(1, 1), cB + hstepB + kstep);
    PG8_WAIT_V(6); PG8_BAR;
    for (;;) {
        const bool has_next = p.next(ui + 1, nxt);
        const unsigned nA = has_next ? (unsigned)((const unsigned char*)p.a_ptr(nxt) - wsbase) : cA, nB = has_next ? (unsigned)((const unsigned char*)p.b_ptr(nxt) - wsbase) : cB;
        for (int t = 0; t < nt; t += 2) {
            const bool last = (t == nt - 2);
            unsigned ldsw = ldsw0; asm volatile("" : "+s"(ldsw));
            const unsigned a1 = cA + (unsigned)(t + 1) * kstep;
            const unsigned a2 = last ? nA : cA + (unsigned)(t + 2) * kstep, b2 = last ? nB : cB + (unsigned)(t + 2) * kstep;
            const unsigned a3 = a2 + kstep, b3 = b2 + kstep;
            unsigned vt[2][2];
            if constexpr (P::GATHER) { if (last && has_next) { PG8_ROWOFFS(vt, nxt); } }
            PG8_LDB(B0, 0, 0); PG8_LDB(B1, 0, 1); PG8_SCHED; PG8_LDA(At, 0, 0); PG8_STAGE_A(PG8_SA(1, 1), a1, 1, false);
            PG8_WAIT_V(8); PG8_WAIT_L(0); PG8_BAR; PG8_MMA(0, 0, At, B0); PG8_MMA(0, 1, At, B1); PG8_BAR; PG8_SCHED;
            if constexpr (P::GATHER) { if (last && has_next) {
#pragma unroll
                for (int h = 0; h < 2; ++h) { vc[h][0] = vt[h][0]; vc[h][1] = vt[h][1]; } } }
            PG8_LDA(At, 0, 1); PG8_STAGE_B(PG8_SB(0, 0), b2); PG8_STAGE_B(PG8_SB(0, 1), b2 + hstepB); PG8_STAGE_A(PG8_SA(0, 0), a2, 0, last);
            PG8_WAIT_V(8); PG8_WAIT_L(0); PG8_BAR; PG8_MMA(1, 0, At, B0); PG8_MMA(1, 1, At, B1); PG8_BAR; PG8_SCHED;
            PG8_LDB(B0, 1, 0); PG8_LDB(B1, 1, 1); PG8_SCHED; PG8_LDA(At, 1, 0); PG8_STAGE_A(PG8_SA(0, 1), a2, 1, last);
            PG8_WAIT_V(8); PG8_WAIT_L(0); PG8_BAR; PG8_MMA(0, 0, At, B0); PG8_MMA(0, 1, At, B1); PG8_BAR; PG8_SCHED;
            PG8_LDA(At, 1, 1); PG8_STAGE_B(PG8_SB(1, 0), b3); PG8_STAGE_B(PG8_SB(1, 1), b3 + hstepB); PG8_STAGE_A(PG8_SA(1, 0), a3, 0, last);
            PG8_WAIT_V(8); PG8_WAIT_L(0); PG8_BAR; PG8_MMA(1, 0, At, B0); PG8_MMA(1, 1, At, B1); PG8_BAR; PG8_SCHED;
        }
        if constexpr (ESZ == 1) asm volatile("s_nop 15\n\ts_nop 15" ::: "memory");
        if (wr == 0) PG8_BAR;
        bool zero;
        { int t2 = tid; asm volatile("" : "+v"(t2));
          const int l2 = t2 & 63, w2 = __builtin_amdgcn_readfirstlane(t2 >> 6); zero = p.template epi<TAIL>(acc, cur, w2 >> 2, w2 & 3, l2 & 15, l2 >> 4); }
        if (!has_next) break;
        if (zero) {
#pragma unroll
            for (int a = 0; a < 2; ++a)
#pragma unroll
                for (int b = 0; b < 2; ++b)
#pragma unroll
                    for (int m = 0; m < 4; ++m)
#pragma unroll
                        for (int n = 0; n < 2; ++n) acc[a][b][m][n] = (f32x4){0.f, 0.f, 0.f, 0.f};
        }
        cur = nxt; cA = nA; cB = nB; ++ui;
        if (wr == 1) PG8_BAR;
    }
    PG8_WAIT_V(0);
    PG8_BAR;
#undef PG8_SA
#undef PG8_SB
#undef PG8_GLDS
#undef PG8_STAGE_A
#undef PG8_STAGE_B
#undef PG8_LDA
#undef PG8_LDB
#undef PG8_MMA
#undef PG8_WAIT_V
#undef PG8_WAIT_L
#undef PG8_BAR
#undef PG8_SCHED
#undef PG8_ROWOFFS
}
}

#define XB_TMO      128
#define XB_XCNT(j)  (256  + 64 * (j))
#define XB_XSUB(j)  (1280 + 64 * (j))
#define XB_XGEN(j)  (2304 + 64 * (j))
#define XB_TOP      3328
#define XB_TOPGEN   3392
#define XCD_BAR_WORDS 3456
#define XB_SPIN_CAP (1u << 18)
__device__ __forceinline__ unsigned xb_ld(unsigned* p)              { return __hip_atomic_load(p, __ATOMIC_RELAXED, __HIP_MEMORY_SCOPE_AGENT); }
__device__ __forceinline__ unsigned xb_add(unsigned* p, unsigned v) { return __hip_atomic_fetch_add(p, v, __ATOMIC_RELAXED, __HIP_MEMORY_SCOPE_AGENT); }
__device__ __forceinline__ unsigned xb_xcc_id() { return (unsigned)__builtin_amdgcn_s_getreg((3 << 11) | 20) & 0xFu; }
#define XB_SPIN(cond, bar) do { unsigned _sp = 0; while (cond) { __builtin_amdgcn_s_sleep(1); \
    if ((++_sp & 255u) == 0u) { if (xb_ld(&(bar)[XB_TMO])) break; if (_sp > XB_SPIN_CAP) { atomicAdd(&(bar)[XB_TMO], 1u); break; } } } } while (0)
struct XcdBarrier { unsigned* bar; unsigned x; volatile LAS unsigned* st; };
__device__ __forceinline__ XcdBarrier xcd_barrier_post(unsigned* bar, volatile LAS unsigned* st) {
    XcdBarrier b; b.bar = bar; b.x = xb_xcc_id(); b.st = st;
    if (threadIdx.x == 0) (void)xb_add(&bar[XB_XCNT(b.x)], 1u);
    return b;
}
__device__ __forceinline__ void xcd_barrier_complete(unsigned* bar, unsigned x, unsigned& nloc, unsigned& nx) {
    const unsigned G = gridDim.x * gridDim.y * gridDim.z;
    unsigned sum, cnt, mine, sp = 0u;
    for (;;) {
        sum = 0u; cnt = 0u; mine = 0u;
#pragma unroll
        for (unsigned j = 0; j < 16; ++j) { const unsigned c = xb_ld(&bar[XB_XCNT(j)]); sum += c; cnt += (c > 0u) ? 1u : 0u; mine = (j == x) ? c : mine; }
        if (sum == G) break;
        __builtin_amdgcn_s_sleep(1);
        if ((++sp & 255u) == 0u) { if (xb_ld(&bar[XB_TMO])) break; if (sp > XB_SPIN_CAP) { atomicAdd(&bar[XB_TMO], 1u); break; } }
    }
    nloc = mine > 0u ? mine : 1u; nx = cnt > 0u ? cnt : 1u;
}
__device__ __forceinline__ void xcd_barrier(const XcdBarrier& b) {
    asm volatile("s_waitcnt vmcnt(0)" ::: "memory");
    __syncthreads();
    if (threadIdx.x == 0) {
        unsigned* bar = b.bar;
        __builtin_amdgcn_s_waitcnt(0);
        unsigned nloc = b.st[0], nx = b.st[1];
        if (nloc == 0u) { xcd_barrier_complete(bar, b.x, nloc, nx); b.st[0] = nloc; b.st[1] = nx; }
        const unsigned old = xb_add(&bar[XB_XSUB(b.x)], 1u);
        const unsigned gen = old / nloc;
        if (old + 1u == (gen + 1u) * nloc) {
            __builtin_amdgcn_fence(__ATOMIC_RELEASE, "agent");
            asm volatile("s_waitcnt vmcnt(0)" ::: "memory");
            const unsigned og = xb_add(&bar[XB_TOP], 1u);
            const unsigned tg = og / nx;
            if (og + 1u == (tg + 1u) * nx) xb_add(&bar[XB_TOPGEN], 1u);
            else XB_SPIN(xb_ld(&bar[XB_TOPGEN]) == tg, bar);
            __builtin_amdgcn_fence(__ATOMIC_ACQUIRE, "agent");
            xb_add(&bar[XB_XGEN(b.x)], 1u);
            asm volatile("s_waitcnt vmcnt(0)" ::: "memory");
        } else {
            XB_SPIN(xb_ld(&bar[XB_XGEN(b.x)]) == gen, bar);
            __builtin_amdgcn_fence(__ATOMIC_ACQUIRE, "agent");
            asm volatile("s_waitcnt vmcnt(0)" ::: "memory");
        }
    }
    __syncthreads();
}

struct Args { const float* in[30]; float* out; unsigned char* ws; int ph_lo, ph_hi; };
enum { I_X = 0, I_META, I_LNE_G, I_LNE_B, I_WIN, I_POOLW, I_POOLS, I_SINK, I_CONVW, I_CONVB, I_WA, I_BA, I_WX, I_BX, I_LAM, I_PPOOL, I_PATTN, I_PLRU, I_WOUT,
       I_LN1G, I_LN1B, I_RGW, I_RGB, I_REW, I_REB, I_EG, I_EU, I_ED, I_LN2G, I_LN2B };

struct Frame {
    LAS unsigned char* lds;
    const float* const* inp; float* out; unsigned char* ws;
    int tid, lane, wave, vcu, G, z;
    __device__ __forceinline__ const float* I(int k) const { return inp[k + z]; }
};
__device__ __forceinline__ int opaque_s(int x) { asm volatile("" : "+s"(x)); return x; }
__device__ __forceinline__ int opaque_v(int x) { asm volatile("" : "+v"(x)); return x; }

__device__ __forceinline__ void transpose_item(const float* W, int ldw, int k0, int n0, bf16* WT, int ldt, int drow0, LAS float* scr, int lane) {
    f32x4 v[8]; const int kr = lane >> 3, nq = (lane & 7) * 4;
#pragma unroll
    for (int i = 0; i < 8; ++i) v[i] = __builtin_nontemporal_load((const f32x4*)(W + (size_t)(k0 + 8 * i + kr) * ldw + n0 + nq));
#pragma unroll
    for (int i = 0; i < 8; ++i) { LAS float* d = scr + (8 * i + kr) * 33 + nq; d[0] = v[i][0]; d[1] = v[i][1]; d[2] = v[i][2]; d[3] = v[i][3]; }
    LDS_WAIT();
    const int c = lane & 7;
#pragma unroll
    for (int j = 0; j < 4; ++j) { const int n = (lane >> 3) + 8 * j; const LAS float* s = scr + (8 * c) * 33 + n;
        u32x4 o; o.x = pk_bf16(s[0 * 33], s[1 * 33]); o.y = pk_bf16(s[2 * 33], s[3 * 33]); o.z = pk_bf16(s[4 * 33], s[5 * 33]); o.w = pk_bf16(s[6 * 33], s[7 * 33]);
        *(u32x4*)(WT + (size_t)(drow0 + n) * ldt + k0 + 8 * c) = o; }
    LDS_WAIT();
}

__device__ __forceinline__ void transpose_item8(const float* W, int ldw, int k0, int n0, unsigned char* WT, int ldt, int drow0, float scale, LAS float* scr, int lane) {
    f32x4 v[8]; const int kr = lane >> 3, nq = (lane & 7) * 4;
#pragma unroll
    for (int i = 0; i < 8; ++i) v[i] = __builtin_nontemporal_load((const f32x4*)(W + (size_t)(k0 + 8 * i + kr) * ldw + n0 + nq));
#pragma unroll
    for (int i = 0; i < 8; ++i) { LAS float* d = scr + (8 * i + kr) * 33 + nq; d[0] = v[i][0]; d[1] = v[i][1]; d[2] = v[i][2]; d[3] = v[i][3]; }
    LDS_WAIT();
    const int c = lane & 3;
#pragma unroll
    for (int j = 0; j < 2; ++j) { const int n = (lane >> 2) + 16 * j; const LAS float* s = scr + (16 * c) * 33 + n;
        u32x4 o; o.x = pk_fp8x4(s[0 * 33] * scale, s[1 * 33] * scale, s[2 * 33] * scale, s[3 * 33] * scale); o.y = pk_fp8x4(s[4 * 33] * scale, s[5 * 33] * scale, s[6 * 33] * scale, s[7 * 33] * scale);
        o.z = pk_fp8x4(s[8 * 33] * scale, s[9 * 33] * scale, s[10 * 33] * scale, s[11 * 33] * scale); o.w = pk_fp8x4(s[12 * 33] * scale, s[13 * 33] * scale, s[14 * 33] * scale, s[15 * 33] * scale);
        *(u32x4*)(WT + (size_t)(drow0 + n) * ldt + k0 + 16 * c) = o; }
    LDS_WAIT();
}

__device__ __forceinline__ void ln_regs(f32x4 (&v)[8], const float* g, const float* b, int lane) {
    float s = 0.f;
#pragma unroll
    for (int j = 0; j < 8; ++j) s += (v[j].x + v[j].y) + (v[j].z + v[j].w);
    const float mean = wave_sum(s) * (1.f / D); float s2 = 0.f;
#pragma unroll
    for (int j = 0; j < 8; ++j) { v[j] = v[j] - mean; s2 += (v[j].x * v[j].x + v[j].y * v[j].y) + (v[j].z * v[j].z + v[j].w * v[j].w); }
    const float rstd = 1.f / sqrtf(wave_sum(s2) * (1.f / D) + LN_EPS);
#pragma unroll
    for (int j = 0; j < 8; ++j) { const f32x4 gg = *(const f32x4*)(g + 4 * lane + 256 * j), bb = *(const f32x4*)(b + 4 * lane + 256 * j); v[j] = v[j] * rstd * gg + bb; }
}
__device__ __forceinline__ void store_row_bf16(bf16* orow, const f32x4 (&v)[8], int lane) {
#pragma unroll
    for (int j = 0; j < 8; ++j) { u32x2 w; w.x = pk_bf16(v[j].x, v[j].y); w.y = pk_bf16(v[j].z, v[j].w); *(u32x2*)(orow + 4 * lane + 256 * j) = w; }
}
__device__ __forceinline__ void store_row_fp8(unsigned char* orow, const f32x4 (&v)[8], int lane) {
#pragma unroll
    for (int j = 0; j < 8; ++j) *(unsigned*)(orow + 4 * lane + 256 * j) = pk_fp8x4(v[j].x, v[j].y, v[j].z, v[j].w);
}
__device__ __forceinline__ void store_row_f32(float* orow, const f32x4 (&v)[8], int lane) {
#pragma unroll
    for (int j = 0; j < 8; ++j) *(f32x4*)(orow + 4 * lane + 256 * j) = v[j];
}
__device__ __forceinline__ void load_row_f32(const float* row, f32x4 (&v)[8], int lane) {
#pragma unroll
    for (int j = 0; j < 8; ++j) v[j] = *(const f32x4*)(row + 4 * lane + 256 * j);
}

__device__ __forceinline__ void conv_small_weights(Frame& F, int l, int it, LAS float* scr) {
    bf16* wl = (bf16*)(F.ws + WS_WSMALL + (size_t)l * WL_BYTES);
    int r = it;
    if (r < 10752) { const int kb = r / 336, nb = r % 336;
        if (nb < CW / 32) { const int t = nb >> 3;
            if (!((A8_MASK >> t) & 1u)) transpose_item(F.I(I_WIN) + (size_t)l * D * INC, INC, 64 * kb, 32 * nb, (bf16*)((char*)wl + WL_WIN), D, __builtin_popcount(~A8_MASK & ((1u << t) - 1u)) * 256 + (nb & 7) * 32, scr, F.lane);
            else { const int ct = __builtin_popcount(A8_MASK & ((1u << t) - 1u)); transpose_item8(F.I(I_WIN) + (size_t)l * D * INC, INC, 64 * kb, 32 * nb, (unsigned char*)wl + WL_WIN8, D, GW + ct * 256 + (nb & 7) * 32, W8_SCALE, scr, F.lane); } }
        else transpose_item8(F.I(I_WIN) + (size_t)l * D * INC, INC, 64 * kb, 32 * nb, (unsigned char*)wl + WL_WIN8, D, 32 * nb - CW, W8_SCALE, scr, F.lane);
        return; } r -= 10752;
    if (r < 3072) { const int pi = r / 1024, q = r % 1024, kb = q / 64, nb = q % 64;
        transpose_item(F.I(I_PPOOL + pi) + (size_t)l * 1024 * D, D, 64 * kb, 32 * nb, (bf16*)((char*)wl + WL_PROJ) + (size_t)pi * D * 1024, 1024, 32 * nb, scr, F.lane); return; } r -= 3072;
    if (r < 2048) { const int kb = r / 64, nb = r % 64; transpose_item(F.I(I_WOUT) + (size_t)l * D * D, D, 64 * kb, 32 * nb, (bf16*)((char*)wl + WL_WOUT), D, 32 * nb, scr, F.lane); return; } r -= 2048;
    if (r < 128) { const int g = r / 32, q = r % 32, kb = q / 8, nb = q % 8;
        transpose_item(F.I(I_POOLW) + ((size_t)l * 4 + g) * 65536, 256, 64 * kb, 32 * nb, (bf16*)((char*)wl + WL_POOL) + (size_t)g * 65536, 256, 32 * nb, scr, F.lane); return; } r -= 128;
    { const int which = r / 128, q0 = r % 128, blk = q0 / 32, q = q0 % 32, kb = q / 8, nb = q % 8, n0 = 32 * nb;
        const int drow0 = (blk * 2 + (n0 >> 7)) * 256 + 64 * ((n0 & 127) >> 5) + 32 * which;
        transpose_item(F.I(which ? I_WX : I_WA) + ((size_t)l * 4 + blk) * 65536, 256, 64 * kb, n0, (bf16*)((char*)wl + WL_LRU), 256, drow0, scr, F.lane); }
}
__device__ __forceinline__ void conv_expert_weights(Frame& F, int l, int it, LAS float* scr) {
    unsigned char* gu = F.ws + WS_R2 + EXPW_GU; unsigned char* wd = F.ws + WS_R2 + EXPW_WD;
    const int e = it / 1536, r = it % 1536;
    if (r < 1024) { const int which = r / 512, q = r % 512, kb = q / 16, nb = q % 16, n0 = 32 * nb;
        const int drow0 = (e * 4 + (n0 >> 7)) * 256 + which * 128 + (n0 & 127);
        transpose_item8(F.I(which ? I_EU : I_EG) + ((size_t)l * NEXP + e) * D * DE, DE, 64 * kb, n0, gu, D, drow0, W8_SCALE, scr, F.lane); }
    else { const int q = r - 1024, kb = q / 64, nb = q % 64;
        transpose_item8(F.I(I_ED) + ((size_t)l * NEXP + e) * DE * D, D, 64 * kb, 32 * nb, wd, DE, e * D + 32 * nb, W8_SCALE, scr, F.lane); }
}
__device__ __forceinline__ void p0_prologue(Frame& F) {
    LAS float* scr = (LAS float*)(F.lds + F.wave * 16384);
    const int gw = F.vcu * 8 + F.wave, NGW = F.G * 8;
    for (int it = gw; it < 2 * 16256; it += NGW) conv_small_weights(F, it / 16256, it % 16256, scr);
    float* H = (float*)(F.ws + WS_H); bf16* HB = (bf16*)(F.ws + WS_HB);
    for (int n = gw; n < MP; n += NGW) {
        if (n < NTOK) { const int b = n / LSEQ, t = n % LSEQ; const float* src = t < NMETA ? F.I(I_META) + (size_t)t * D : F.I(I_X) + ((size_t)b * SEQ + (t - NMETA)) * D;
            f32x4 v[8]; load_row_f32(src, v, F.lane); ln_regs(v, F.I(I_LNE_G), F.I(I_LNE_B), F.lane);
            store_row_f32(H + (size_t)n * D, v, F.lane); store_row_bf16(HB + (size_t)n * D, v, F.lane); store_row_fp8(F.ws + WS_HB8 + (size_t)n * D, v, F.lane); }
        else { f32x4 v[8];
#pragma unroll
            for (int j = 0; j < 8; ++j) v[j] = (f32x4){0.f, 0.f, 0.f, 0.f};
            store_row_f32(H + (size_t)n * D, v, F.lane); store_row_bf16(HB + (size_t)n * D, v, F.lane); store_row_fp8(F.ws + WS_HB8 + (size_t)n * D, v, F.lane); }
    }
    { bf16* wrt = (bf16*)(F.ws + WS_WRT);
      for (int i = F.vcu * 512 + F.tid; i < 2 * 48 * 2048; i += F.G * 512) { const int l = i / (48 * 2048), c = (i / 2048) % 48, k = i % 2048;
          const float w = c < 4 ? F.I(I_RGW)[((size_t)l * D + k) * 4 + c] : c < 36 ? F.I(I_REW)[((size_t)l * D + k) * 32 + (c - 4)] : 0.f;
          const unsigned hi = pk_bf16(w, 0.f) & 0xffffu; const float rem = w - __uint_as_float(hi << 16);
          wrt[((size_t)(l * 2 + 0) * 48 + c) * 2048 + k] = (bf16)hi; wrt[((size_t)(l * 2 + 1) * 48 + c) * 2048 + k] = (bf16)(pk_bf16(rem, 0.f) & 0xffffu); } }
    { bf16* wsc = (bf16*)(F.ws + WS_WSC);
      for (int i = F.vcu * 512 + F.tid; i < 2 * 4 * 65536; i += F.G * 512) { const int e = i & 255, lg = i >> 16;
          wsc[i] = (bf16)(pk_bf16(F.I(I_POOLW)[i] * F.I(I_POOLS)[(size_t)lg * 256 + e], 0.f) & 0xffffu); } }
    float* sp8 = (float*)(F.ws + WS_SP8);
    for (int i = F.vcu * 512 + F.tid; i < 2 * 1024; i += F.G * 512) { const float lam = F.I(I_LAM)[i]; sp8[i] = 8.0f * log1pf(expf(-lam)); }
}

using pg8::Unit;
__device__ __forceinline__ int xcd_order(int i, int G, int c, int NT) { if (G % (8 * NT)) return i * G + c; const int P = G / (8 * NT), x = c & 7, s = c >> 3; return i * G + (x * P + s / NT) * NT + (s % NT); }
constexpr int A8_NCT = __builtin_popcount(A8_MASK), A8_NN = 24 + A8_NCT, ABF_NN = 18 - A8_NCT;
constexpr int A_H = (NPANEL * ABF_NN) % 256, A_LIGHT = 256 - A_H, A_NF = NPANEL * A8_NN, A_X = (A_NF + 2 * A_H + 255) / 256;
__device__ __forceinline__ int nth_bit(unsigned m, int n) { for (int i = 0; i < n; ++i) m &= m - 1; return __builtin_ctz(m); }
template <bool GATE> struct PolA_ {
    static constexpr bool PERM = true, GATHER = false, ADJ = true; static constexpr int ESZ = GATE ? 1 : 2, NN = GATE ? A8_NN : ABF_NN;
    int K, lda, ldb; const unsigned char* A; const unsigned char* Bt; bf16* out; bf16* outc; int G, c;
    __device__ __forceinline__ bool next(int i, Unit& u) const { int L;
        if (GATE && G == 256) {
            if (i < A_X - 2) L = i * 256 + c; else if (i < A_X) { if (c >= A_LIGHT) return false; L = (A_X - 2) * 256 + (i - (A_X - 2)) * A_LIGHT + c; if (L >= A_NF) return false; } else return false;
        } else { L = i * G + c; if (L >= NPANEL * NN) return false; }
        const int nwg = NPANEL * NN, q = nwg / 8, r = nwg % 8, xcd = L % 8, off = L / 8; const int w = (xcd < r ? xcd * (q + 1) : r * (q + 1) + (xcd - r) * q) + off;
        const int nig = 8 * NN, gid = w / nig, fm = gid * 8, gsz = (NPANEL - fm) < 8 ? (NPANEL - fm) : 8;
        u.pm = fm + ((w % nig) % gsz); u.pn = (w % nig) / gsz; u.z = 0; return true; }
    __device__ __forceinline__ const char* a_ptr(const Unit& u) const { return (const char*)(A + (size_t)u.pm * 256 * lda * ESZ); }
    __device__ __forceinline__ const char* b_ptr(const Unit& u) const { return (const char*)(Bt + (size_t)u.pn * 256 * ldb * ESZ); }
    __device__ __forceinline__ int a_row(const Unit&, int) const { return 0; }
    template <bool T1> __device__ __forceinline__ bool epi(f32x4 (&acc)[2][2][4][2], const Unit& u, int wr, int wc, int fr, int fq) const {
        const int row0 = u.pm * 256 + wr * 64 + fr;
        if constexpr (!GATE) {
            const int tile = nth_bit(~A8_MASK & 0x3FFFFu, u.pn); const float sc = (tile >= 4 && tile < 8) ? 0.125f : 1.0f;
            bf16* base = out + (size_t)row0 * CW + tile * 256 + wc * 64 + 8 * fq;
#pragma unroll
            for (int ai = 0; ai < 2; ++ai)
#pragma unroll
                for (int m = 0; m < 4; ++m)
#pragma unroll
                    for (int bj = 0; bj < 2; ++bj) { const f32x4 v0 = acc[ai][bj][m][0] * sc, v1 = acc[ai][bj][m][1] * sc;
                        u32x4 w; w.x = pk_bf16(v0[0], v0[1]); w.y = pk_bf16(v0[2], v0[3]); w.z = pk_bf16(v1[0], v1[1]); w.w = pk_bf16(v1[2], v1[3]);
                        *(u32x4*)(base + (size_t)(ai * 128 + m * 16) * CW + bj * 32) = w; }
        } else if (u.pn < 24) {
            unsigned char* base = (unsigned char*)out + (size_t)row0 * GW + u.pn * 256 + wc * 64 + 8 * fq;
#pragma unroll
            for (int ai = 0; ai < 2; ++ai)
#pragma unroll
                for (int m = 0; m < 4; ++m)
#pragma unroll
                    for (int bj = 0; bj < 2; ++bj) { const f32x4 a0 = acc[ai][bj][m][0] * (1.0f / W8_SCALE), a1 = acc[ai][bj][m][1] * (1.0f / W8_SCALE);
                        u32x2 w; w.x = pk_gate4(sigmoidf_(a0[0]), sigmoidf_(a0[1]), sigmoidf_(a0[2]), sigmoidf_(a0[3])); w.y = pk_gate4(sigmoidf_(a1[0]), sigmoidf_(a1[1]), sigmoidf_(a1[2]), sigmoidf_(a1[3]));
                        *(u32x2*)(base + (size_t)(ai * 128 + m * 16) * GW + bj * 32) = w; }
        } else {
            const int tile = nth_bit(A8_MASK, u.pn - 24); const float sc = ((tile >= 4 && tile < 8) ? 0.125f : 1.0f) * (1.0f / W8_SCALE);
            bf16* base = outc + (size_t)row0 * CW + tile * 256 + wc * 64 + 8 * fq;
#pragma unroll
            for (int ai = 0; ai < 2; ++ai)
#pragma unroll
                for (int m = 0; m < 4; ++m)
#pragma unroll
                    for (int bj = 0; bj < 2; ++bj) { const f32x4 v0 = acc[ai][bj][m][0] * sc, v1 = acc[ai][bj][m][1] * sc;
                        u32x4 w; w.x = pk_bf16(v0[0], v0[1]); w.y = pk_bf16(v0[2], v0[3]); w.z = pk_bf16(v1[0], v1[1]); w.w = pk_bf16(v1[2], v1[3]);
                        *(u32x4*)(base + (size_t)(ai * 128 + m * 16) * CW + bj * 32) = w; }
        }
        return true;
    }
};
__device__ __forceinline__ void unpack8(const u32x4 v, float (&f)[8]);
struct PolW {
    static constexpr bool PERM = true, GATHER = false, ADJ = true; static constexpr int ESZ = 2;
    int K, lda, ldb; const bf16* pt; const bf16* wsc; bf16* wct; int G, c;
    __device__ __forceinline__ bool next(int i, Unit& u) const { const int L = i * G + c; if (L >= 32) return false; u.pm = L >> 2; u.pn = L & 3; u.z = 0; return true; }
    __device__ __forceinline__ const char* a_ptr(const Unit& u) const { return (const char*)(pt + (size_t)u.pm * 256 * 1024 + u.pn * 256); }
    __device__ __forceinline__ const char* b_ptr(const Unit& u) const { return (const char*)(wsc + (size_t)u.pn * 65536); }
    __device__ __forceinline__ int a_row(const Unit&, int) const { return 0; }
    template <bool T1> __device__ __forceinline__ bool epi(f32x4 (&acc)[2][2][4][2], const Unit& u, int wr, int wc, int fr, int fq) const {
        bf16* base = wct + (size_t)(u.pm * 256 + wr * 64 + fr) * 1024 + u.pn * 256 + wc * 64 + 8 * fq;
#pragma unroll
        for (int ai = 0; ai < 2; ++ai)
#pragma unroll
            for (int m = 0; m < 4; ++m)
#pragma unroll
                for (int bj = 0; bj < 2; ++bj) { const f32x4 v0 = acc[ai][bj][m][0], v1 = acc[ai][bj][m][1];
                    u32x4 w; w.x = pk_bf16(v0[0], v0[1]); w.y = pk_bf16(v0[2], v0[3]); w.z = pk_bf16(v1[0], v1[1]); w.w = pk_bf16(v1[2], v1[3]);
                    *(u32x4*)(base + (size_t)(ai * 128 + m * 16) * 1024 + bj * 32) = w; }
        return true;
    }
};
struct PolC {
    static constexpr bool PERM = true, GATHER = false, ADJ = true; static constexpr int ESZ = 2;
    int K, lda, ldb; const bf16* delta; const bf16* xc; const bf16* pool_t; const bf16* lru_t; bf16* mix; bf16* Abuf; bf16* Bbuf;
    const float* pool_scale; const float* ba; const float* bx; const float* sp8; int G, c;
    __device__ __forceinline__ bool next(int i, Unit& u) const { const int L = i * G + c; if (L >= 64 * 8) return false; u.pm = L >> 3; u.pn = 4 + (L & 7); u.z = 0; return true; }
    __device__ __forceinline__ const char* a_ptr(const Unit& u) const { return u.pn < 4 ? (const char*)(delta + (size_t)u.pm * 256 * 1024 + u.pn * 256) : (const char*)(xc + (size_t)u.pm * 256 * 1024 + ((u.pn - 4) >> 1) * 256); }
    __device__ __forceinline__ const char* b_ptr(const Unit& u) const { return u.pn < 4 ? (const char*)(pool_t + (size_t)u.pn * 65536) : (const char*)(lru_t + (size_t)(u.pn - 4) * 65536); }
    __device__ __forceinline__ int a_row(const Unit&, int) const { return 0; }
    __device__ __forceinline__ int rows(const Unit& u) const { return NTOK - u.pm * 256; }
    template <bool T1> __device__ __forceinline__ bool epi(f32x4 (&acc)[2][2][4][2], const Unit& u, int wr, int wc, int fr, int fq) const {
        const int row0 = u.pm * 256 + wr * 64 + fr;
        if (u.pn < 4) {
#pragma unroll
            for (int bj = 0; bj < 2; ++bj) { const int col = u.pn * 256 + wc * 64 + bj * 32 + 8 * fq; const f32x4 p0 = *(const f32x4*)(pool_scale + col), p1 = *(const f32x4*)(pool_scale + col + 4);
#pragma unroll
                for (int ai = 0; ai < 2; ++ai)
#pragma unroll
                    for (int m = 0; m < 4; ++m) { const f32x4 v0 = acc[ai][bj][m][0] * p0, v1 = acc[ai][bj][m][1] * p1; u32x4 w; w.x = pk_bf16(v0[0], v0[1]); w.y = pk_bf16(v0[2], v0[3]); w.z = pk_bf16(v1[0], v1[1]); w.w = pk_bf16(v1[2], v1[3]);
                        *(u32x4*)(mix + (size_t)(row0 + ai * 128 + m * 16) * 3072 + col) = w; } }
        } else {
            const int q = u.pn - 4, ch = (q >> 1) * 256 + (q & 1) * 128 + wc * 32 + 8 * fq;
            float vba[8], vbx[8], vsp[8];
            { const f32x4 t0 = *(const f32x4*)(ba + ch), t1 = *(const f32x4*)(ba + ch + 4), t2 = *(const f32x4*)(bx + ch), t3 = *(const f32x4*)(bx + ch + 4), t4 = *(const f32x4*)(sp8 + ch), t5 = *(const f32x4*)(sp8 + ch + 4);
#pragma unroll
              for (int j = 0; j < 4; ++j) { vba[j] = t0[j]; vba[4 + j] = t1[j]; vbx[j] = t2[j]; vbx[4 + j] = t3[j]; vsp[j] = t4[j]; vsp[4 + j] = t5[j]; } }
#pragma unroll
            for (int ai = 0; ai < 2; ++ai) { u32x4 xw[4];
#pragma unroll
                for (int m = 0; m < 4; ++m) xw[m] = *(const u32x4*)(xc + (size_t)(row0 + ai * 128 + m * 16) * 1024 + ch);
#pragma unroll
                for (int m = 0; m < 4; ++m) { const int row = row0 + ai * 128 + m * 16; float xv[8]; unpack8(xw[m], xv);
                    const bool t0 = (row % LSEQ) == 0; float av[8], bv[8];
#pragma unroll
                    for (int j = 0; j < 8; ++j) { const float ga = sigmoidf_(acc[ai][0][m][j >> 2][j & 3] + vba[j]), gx = sigmoidf_(acc[ai][1][m][j >> 2][j & 3] + vbx[j]);
                        const float a = fast_exp(-vsp[j] * ga); bv[j] = sqrtf(fmaxf(1.0f - a * a, 0.f)) * gx * xv[j]; av[j] = t0 ? 1.0f : 1.0f - a; }
                    u32x4 wa, wb; wa.x = pk_bf16(av[0], av[1]); wa.y = pk_bf16(av[2], av[3]); wa.z = pk_bf16(av[4], av[5]); wa.w = pk_bf16(av[6], av[7]);
                    wb.x = pk_bf16(bv[0], bv[1]); wb.y = pk_bf16(bv[2], bv[3]); wb.z = pk_bf16(bv[4], bv[5]); wb.w = pk_bf16(bv[6], bv[7]);
                    *(u32x4*)(Abuf + (size_t)row * 1024 + ch) = wa; *(u32x4*)(Bbuf + (size_t)row * 1024 + ch) = wb; } }
        }
        return true;
    }
};
struct PolE {
    static constexpr bool PERM = true, GATHER = false, ADJ = true; static constexpr int ESZ = 2;
    int K, lda, ldb; const bf16* mix; const bf16* proj_t; const bf16* wct; const unsigned char* gates; bf16* merged; int G, c;
    int t0, t1;
    __device__ __forceinline__ bool next(int i, Unit& u) const { const int ti = t0 + xcd_order(i / 3, G, c, 8); if (ti >= t1) return false; u.pm = ti >> 3; u.pn = ti & 7; u.z = i % 3; return true; }
    __device__ __forceinline__ const char* a_ptr(const Unit& u) const { return (const char*)(mix + (size_t)u.pm * 256 * 3072 + u.z * 1024); }
    __device__ __forceinline__ const char* b_ptr(const Unit& u) const { return u.z == 0 ? (const char*)(wct + (size_t)u.pn * 256 * 1024) : (const char*)(proj_t + (size_t)u.z * D * 1024 + (size_t)u.pn * 256 * 1024); }
    __device__ __forceinline__ int a_row(const Unit&, int) const { return 0; }
    static __device__ __forceinline__ void unpack_gate(const u32x2 w, float (&f)[8]) { f[0] = (float)(w.x & 255u); f[1] = (float)((w.x >> 8) & 255u); f[2] = (float)((w.x >> 16) & 255u); f[3] = (float)(w.x >> 24);
        f[4] = (float)(w.y & 255u); f[5] = (float)((w.y >> 8) & 255u); f[6] = (float)((w.y >> 16) & 255u); f[7] = (float)(w.y >> 24); }
    template <bool T1> __device__ __forceinline__ bool epi(f32x4 (&acc)[2][2][4][2], const Unit& u, int wr, int wc, int fr, int fq) const {
        const int row0 = u.pm * 256 + wr * 64 + fr, col0 = u.pn * 256 + wc * 64 + 8 * fq;
        const unsigned char* gbase = gates + (size_t)row0 * GW + u.z * D + col0; const bool fin = (u.z == 2); const int dofs = fin ? 0 : D;
        const u32x2 ones = (u32x2){0xffffffffu, 0xffffffffu};
#pragma unroll
        for (int ai = 0; ai < (T1 ? 1 : 2); ++ai)
#pragma unroll
            for (int mh = 0; mh < 2; ++mh) { u32x2 ga[2][2], gb[2][2];
#pragma unroll
                for (int mm = 0; mm < 2; ++mm)
#pragma unroll
                    for (int bj = 0; bj < 2; ++bj) { const unsigned char* gp = gbase + (size_t)(ai * 128 + (2 * mh + mm) * 16) * GW + bj * 32; ga[mm][bj] = *(const u32x2*)gp; gb[mm][bj] = *(const u32x2*)(gp + dofs); }
#pragma unroll
                for (int mm = 0; mm < 2; ++mm)
#pragma unroll
                    for (int bj = 0; bj < 2; ++bj) { const int m = 2 * mh + mm; float f[8], h[8]; unpack_gate(ga[mm][bj], f); const u32x2 gsel = fin ? ones : gb[mm][bj]; unpack_gate(gsel, h);
#pragma unroll
                        for (int j = 0; j < 8; ++j) f[j] = fmaxf(f[j], 1e-20f) * __builtin_amdgcn_rcpf(fmaxf(h[j], 1e-20f));
                        f32x4 v0 = acc[ai][bj][m][0], v1 = acc[ai][bj][m][1];
                        v0[0] *= f[0]; v0[1] *= f[1]; v0[2] *= f[2]; v0[3] *= f[3]; v1[0] *= f[4]; v1[1] *= f[5]; v1[2] *= f[6]; v1[3] *= f[7];
                        acc[ai][bj][m][0] = v0; acc[ai][bj][m][1] = v1; }
                if (fin) {
#pragma unroll
                    for (int mm = 0; mm < 2; ++mm)
#pragma unroll
                        for (int bj = 0; bj < 2; ++bj) { const int m = 2 * mh + mm; const f32x4 a0 = acc[ai][bj][m][0], a1 = acc[ai][bj][m][1];
                            u32x4 w; w.x = pk_bf16(a0[0], a0[1]); w.y = pk_bf16(a0[2], a0[3]); w.z = pk_bf16(a1[0], a1[1]); w.w = pk_bf16(a1[2], a1[3]);
                            *(u32x4*)(merged + (size_t)(row0 + ai * 128 + m * 16) * D + col0 + bj * 32) = w; } }
                __builtin_amdgcn_sched_barrier(0); }
        return fin;
    }
};
struct PolF {
    static constexpr bool PERM = false, GATHER = false; static constexpr int ESZ = 2;
    int K, lda, ldb; const bf16* A; const bf16* Bt; float* H; float* stats; int G, c;
    int t0, t1;
    __device__ __forceinline__ bool next(int i, Unit& u) const { const int ti = t0 + xcd_order(i, G, c, 8); if (ti >= t1) return false; u.pm = ti >> 3; u.pn = ti & 7; u.z = 0; return true; }
    __device__ __forceinline__ const char* a_ptr(const Unit& u) const { return (const char*)(A + (size_t)u.pm * 256 * lda); }
    __device__ __forceinline__ const char* b_ptr(const Unit& u) const { return (const char*)(Bt + (size_t)u.pn * 256 * ldb); }
    __device__ __forceinline__ int a_row(const Unit&, int) const { return 0; }
    template <bool T1> __device__ __forceinline__ bool epi(f32x4 (&acc)[2][2][4][2], const Unit& u, int wr, int wc, int fr, int fq) const {
        const int row0 = u.pm * 256 + wr * 64 + fr, col0 = u.pn * 256 + wc * 32 + 4 * fq;
#pragma unroll
        for (int ai = 0; ai < (T1 ? 1 : 2); ++ai)
#pragma unroll
            for (int m = 0; m < 4; ++m) { const int row = row0 + ai * 128 + m * 16; float* rp = H + (size_t)row * D + col0; float s = 0.f, q = 0.f;
#pragma unroll
                for (int bj = 0; bj < 2; ++bj)
#pragma unroll
                    for (int n = 0; n < 2; ++n) { const f32x4 h = *(const f32x4*)(rp + bj * 128 + n * 16); const f32x4 y = h * ALPHA + acc[ai][bj][m][n]; *(f32x4*)(rp + bj * 128 + n * 16) = y;
                        s += (y[0] + y[1]) + (y[2] + y[3]); q += (y[0] * y[0] + y[1] * y[1]) + (y[2] * y[2] + y[3] * y[3]); }
                s += __shfl_xor(s, 16); s += __shfl_xor(s, 32); q += __shfl_xor(q, 16); q += __shfl_xor(q, 32);
                if (fq == 0) *(f32x2*)(stats + (size_t)row * 64 + (u.pn * 4 + wc) * 2) = (f32x2){s, q}; }
        return true;
    }
};
struct MoeTbl { const LAS int* t; __device__ __forceinline__ int ct(int e) const { return __builtin_amdgcn_readfirstlane(t[e]); } __device__ __forceinline__ int cnt(int e) const { return __builtin_amdgcn_readfirstlane(t[40 + e]); } };
__device__ __forceinline__ int moe_find(const MoeTbl& T, int mt) { int e = 0;
#pragma unroll 1
    while (e < 31 && T.ct(e + 1) <= mt) ++e;
    return e; }
struct PolI {
    static constexpr bool PERM = true, GATHER = true; static constexpr int ESZ = 1;
    int K, lda, ldb; const unsigned char* X; const unsigned char* gu; const int* elist; unsigned char* hdn; MoeTbl T; int G, c;
    __device__ __forceinline__ bool next(int i, Unit& u) const { const int L = xcd_order(i, G, c, 4), tot = T.ct(32); if (L >= tot * 4) return false; u.pm = L >> 2; u.pn = L & 3; u.z = moe_find(T, u.pm); return true; }
    __device__ __forceinline__ const char* a_ptr(const Unit&) const { return (const char*)X; }
    __device__ __forceinline__ const char* b_ptr(const Unit& u) const { return (const char*)(gu + (size_t)(u.z * 4 + u.pn) * 256 * D); }
    __device__ __forceinline__ int a_row(const Unit& u, int r) const { const int j = (u.pm - T.ct(u.z)) * 256 + r; return j < T.cnt(u.z) ? elist[(size_t)u.z * NTOK + j] : 0; }
    template <bool T1> __device__ __forceinline__ bool epi(f32x4 (&acc)[2][2][4][2], const Unit& u, int wr, int wc, int fr, int fq) const {
        const int row0 = u.pm * 256 + wr * 64 + fr, col0 = u.pn * 128 + wc * 32 + 8 * fq;
#pragma unroll
        for (int ai = 0; ai < 2; ++ai)
#pragma unroll
            for (int m = 0; m < 4; ++m) { float o[8];
#pragma unroll
                for (int n = 0; n < 2; ++n)
#pragma unroll
                    for (int j = 0; j < 4; ++j) { const float g = acc[ai][0][m][n][j] * (1.0f / W8_SCALE), up = acc[ai][1][m][n][j] * (HDN_SCALE / W8_SCALE); o[4 * n + j] = fminf(fmaxf(g * sigmoidf_(g) * up, -440.f), 440.f); }
                u32x2 w; w.x = pk_fp8x4(o[0], o[1], o[2], o[3]); w.y = pk_fp8x4(o[4], o[5], o[6], o[7]);
                *(u32x2*)(hdn + (size_t)(row0 + ai * 128 + m * 16) * DE + col0) = w; }
        return true;
    }
};
struct PolJ {
    static constexpr bool PERM = true, GATHER = false, ADJ = true; static constexpr int ESZ = 1;
    int K, lda, ldb; const unsigned char* hdn; const unsigned char* wd; unsigned char* yd; MoeTbl T; int G, c;
    __device__ __forceinline__ bool next(int i, Unit& u) const { const int L = xcd_order(i, G, c, 8), tot = T.ct(32); if (L >= tot * 8) return false; u.pm = L >> 3; u.pn = L & 7; u.z = moe_find(T, u.pm); return true; }
    __device__ __forceinline__ const char* a_ptr(const Unit& u) const { return (const char*)(hdn + (size_t)u.pm * 256 * DE); }
    __device__ __forceinline__ const char* b_ptr(const Unit& u) const { return (const char*)(wd + ((size_t)u.z * D + (size_t)u.pn * 256) * DE); }
    __device__ __forceinline__ int a_row(const Unit&, int) const { return 0; }
    template <bool T1> __device__ __forceinline__ bool epi(f32x4 (&acc)[2][2][4][2], const Unit& u, int wr, int wc, int fr, int fq) const {
        const int row0 = u.pm * 256 + wr * 64 + fr, col0 = u.pn * 256 + wc * 64 + 8 * fq;
#pragma unroll
        for (int ai = 0; ai < 2; ++ai)
#pragma unroll
            for (int m = 0; m < 4; ++m)
#pragma unroll
                for (int bj = 0; bj < 2; ++bj) { const f32x4 v0 = acc[ai][bj][m][0] * (YD_SCALE / (W8_SCALE * HDN_SCALE)), v1 = acc[ai][bj][m][1] * (YD_SCALE / (W8_SCALE * HDN_SCALE));
#define YCL(x) __builtin_amdgcn_fmed3f((x), -448.0f, 448.0f)
                    u32x2 w; w.x = pk_fp8x4(YCL(v0[0]), YCL(v0[1]), YCL(v0[2]), YCL(v0[3])); w.y = pk_fp8x4(YCL(v1[0]), YCL(v1[1]), YCL(v1[2]), YCL(v1[3]));
#undef YCL
                    *(u32x2*)(yd + (size_t)(row0 + ai * 128 + m * 16) * D + col0 + bj * 32) = w; }
        return true;
    }
};

template <int NCB> __device__ __forceinline__ void skinny_mma(f32x4 (&acc)[4][NCB], const bf16* A, int lda, const bf16* Bt, int ldb, int k0, int k1, int lane) {
    const int fr = lane & 15, fq = lane >> 4;
#pragma unroll 2
    for (int k = k0; k < k1; k += 32) { bf16x8 a[4], b[NCB];
#pragma unroll
        for (int rb = 0; rb < 4; ++rb) a[rb] = *(const bf16x8*)(A + (size_t)(16 * rb + fr) * lda + k + 8 * fq);
#pragma unroll
        for (int cb = 0; cb < NCB; ++cb) b[cb] = *(const bf16x8*)(Bt + (size_t)(16 * cb + fr) * ldb + k + 8 * fq);
#pragma unroll
        for (int rb = 0; rb < 4; ++rb)
#pragma unroll
            for (int cb = 0; cb < NCB; ++cb) acc[rb][cb] = __builtin_amdgcn_mfma_f32_16x16x32_bf16(b[cb], a[rb], acc[rb][cb], 0, 0, 0); }
}
__device__ __forceinline__ void tail_merge(Frame& F, int l) {
    if (F.vcu >= 128) return;
    const bf16* mix = (const bf16*)(F.ws + WS_R3) + (size_t)16384 * 3072; const bf16* proj_t = (const bf16*)(F.ws + WS_WSMALL + (size_t)l * WL_BYTES + WL_PROJ); const bf16* wct = (const bf16*)(F.ws + WS_WCT) + (size_t)l * D * 1024;
    const unsigned char* gates = F.ws + WS_R1 + (size_t)16384 * GW; bf16* merged = (bf16*)(F.ws + WS_R45) + (size_t)16384 * D;
    const int c0 = F.vcu * 16, lane = F.lane, wave = F.wave, fr = lane & 15, fq = lane >> 4;
    LAS float* part = (LAS float*)F.lds;
#pragma unroll
    for (int seg = 0; seg < 3; ++seg) { f32x4 acc[4][1];
#pragma unroll
        for (int rb = 0; rb < 4; ++rb) acc[rb][0] = (f32x4){0.f, 0.f, 0.f, 0.f};
        skinny_mma<1>(acc, mix + seg * 1024, 3072, (seg == 0 ? wct : proj_t + (size_t)seg * D * 1024) + (size_t)c0 * 1024, 1024, wave * 128, wave * 128 + 128, lane);
#pragma unroll
        for (int rb = 0; rb < 4; ++rb) *(LAS f32x4*)(part + ((wave * 3 + seg) * 64 + 16 * rb + fr) * 16 + 4 * fq) = acc[rb][0]; }
    __syncthreads();
#pragma unroll
    for (int e2 = 0; e2 < 2; ++e2) { const int e = F.tid + 512 * e2, row = e >> 4, col = e & 15; float m = 0.f;
#pragma unroll
        for (int seg = 0; seg < 3; ++seg) { float s = 0.f;
#pragma unroll
            for (int w = 0; w < 8; ++w) s += part[((w * 3 + seg) * 64 + row) * 16 + col];
            m += (float)gates[(size_t)row * GW + seg * D + c0 + col] * (1.0f / 255.0f) * s; }
        merged[(size_t)row * D + c0 + col] = (bf16)(pk_bf16(m, 0.f) & 0xffffu); }
    __syncthreads();
}
__device__ __forceinline__ void tail_lru(Frame& F, int l) {
    if (F.vcu >= 64) return;
    const bf16* xc = (const bf16*)(F.ws + WS_R45) + (size_t)MP * 1024 + (size_t)16384 * 1024; const bf16* lru_t = (const bf16*)(F.ws + WS_WSMALL + (size_t)l * WL_BYTES + WL_LRU);
    bf16* Abuf = (bf16*)(F.ws + WS_R6) + (size_t)16384 * 1024; bf16* Bbuf = (bf16*)(F.ws + WS_R6) + (size_t)MP * 1024 + (size_t)16384 * 1024;
    const float* ba = F.I(I_BA) + (size_t)l * 1024; const float* bx = F.I(I_BX) + (size_t)l * 1024; const float* sp8 = (const float*)(F.ws + WS_SP8) + (size_t)l * 1024;
    const int ch0 = F.vcu * 16, blk = ch0 >> 8, cib = ch0 & 255, lane = F.lane, wave = F.wave, fr = lane & 15, fq = lane >> 4;
    const bf16* wrow = lru_t + (size_t)((blk * 2 + (cib >> 7)) * 256 + 64 * ((cib & 127) >> 5) + (cib & 31)) * 256;
    LAS float* part = (LAS float*)F.lds;
    { f32x4 acc[4][2];
#pragma unroll
      for (int rb = 0; rb < 4; ++rb) { acc[rb][0] = (f32x4){0.f, 0.f, 0.f, 0.f}; acc[rb][1] = acc[rb][0]; }
      const int k = wave * 32 + 8 * fq; bf16x8 a[4], b[2];
#pragma unroll
      for (int rb = 0; rb < 4; ++rb) a[rb] = *(const bf16x8*)(xc + (size_t)(16 * rb + fr) * 1024 + blk * 256 + k);
      b[0] = *(const bf16x8*)(wrow + (size_t)fr * 256 + k); b[1] = *(const bf16x8*)(wrow + (size_t)(32 + fr) * 256 + k);
#pragma unroll
      for (int rb = 0; rb < 4; ++rb)
#pragma unroll
          for (int cb = 0; cb < 2; ++cb) acc[rb][cb] = __builtin_amdgcn_mfma_f32_16x16x32_bf16(b[cb], a[rb], acc[rb][cb], 0, 0, 0);
#pragma unroll
      for (int rb = 0; rb < 4; ++rb)
#pragma unroll
          for (int cb = 0; cb < 2; ++cb) *(LAS f32x4*)(part + (wave * 64 + 16 * rb + fr) * 32 + 16 * cb + 4 * fq) = acc[rb][cb]; }
    __syncthreads();
#pragma unroll
    for (int e2 = 0; e2 < 2; ++e2) { const int e = F.tid + 512 * e2, row = e >> 4, cc = e & 15, ch = ch0 + cc; float ga = 0.f, gx = 0.f;
#pragma unroll
        for (int w = 0; w < 8; ++w) { ga += part[(w * 64 + row) * 32 + cc]; gx += part[(w * 64 + row) * 32 + 16 + cc]; }
        const float sa = sigmoidf_(ga + ba[ch]), sx = sigmoidf_(gx + bx[ch]), a = fast_exp(-sp8[ch] * sa), xv = bf2f(xc[(size_t)row * 1024 + ch]);
        const bool t0 = ((16384 + row) % LSEQ) == 0;
        Abuf[(size_t)row * 1024 + ch] = (bf16)(pk_bf16(t0 ? 1.0f : 1.0f - a, 0.f) & 0xffffu); Bbuf[(size_t)row * 1024 + ch] = (bf16)(pk_bf16(sqrtf(fmaxf(1.0f - a * a, 0.f)) * sx * xv, 0.f) & 0xffffu); }
    __syncthreads();
}
__device__ __forceinline__ void tail_wout(Frame& F, int l) {
    if (F.vcu >= 32) return;
    const bf16* merged = (const bf16*)(F.ws + WS_R45) + (size_t)16384 * D; const bf16* wo = (const bf16*)(F.ws + WS_WSMALL + (size_t)l * WL_BYTES + WL_WOUT);
    float* H = (float*)(F.ws + WS_H) + (size_t)16384 * D; float* stats = (float*)(F.ws + WS_STATS) + (size_t)16384 * 64;
    const int c0 = F.vcu * 64, lane = F.lane, wave = F.wave, fr = lane & 15, fq = lane >> 4;
    LAS float* part = (LAS float*)F.lds;
    { f32x4 acc[4][4];
#pragma unroll
      for (int rb = 0; rb < 4; ++rb)
#pragma unroll
          for (int cb = 0; cb < 4; ++cb) acc[rb][cb] = (f32x4){0.f, 0.f, 0.f, 0.f};
      skinny_mma<4>(acc, merged, D, wo + (size_t)c0 * D, D, wave * 256, wave * 256 + 256, lane);
#pragma unroll
      for (int rb = 0; rb < 4; ++rb)
#pragma unroll
          for (int cb = 0; cb < 4; ++cb) *(LAS f32x4*)(part + (wave * 64 + 16 * rb + fr) * 64 + 16 * cb + 4 * fq) = acc[rb][cb]; }
    __syncthreads();
    { const int row = F.tid >> 3, cs = (F.tid & 7) * 8; float s = 0.f, q = 0.f;
#pragma unroll
      for (int h4 = 0; h4 < 2; ++h4) { f32x4 a = (f32x4){0.f, 0.f, 0.f, 0.f};
#pragma unroll
          for (int w = 0; w < 8; ++w) a += *(const LAS f32x4*)(part + (w * 64 + row) * 64 + cs + 4 * h4);
          float* hp = H + (size_t)row * D + c0 + cs + 4 * h4; const f32x4 y = *(const f32x4*)hp * ALPHA + a; *(f32x4*)hp = y;
          s += (y[0] + y[1]) + (y[2] + y[3]); q += (y[0] * y[0] + y[1] * y[1]) + (y[2] * y[2] + y[3] * y[3]); }
      s += __shfl_xor(s, 1); s += __shfl_xor(s, 2); s += __shfl_xor(s, 4); q += __shfl_xor(q, 1); q += __shfl_xor(q, 2); q += __shfl_xor(q, 4);
      if ((F.tid & 7) == 0) *(f32x2*)(stats + (size_t)row * 64 + F.vcu * 2) = (f32x2){s, q}; }
    __syncthreads();
}

__device__ __forceinline__ void unpack8(const u32x4 v, float (&f)[8]) { f[0] = bflo(v.x); f[1] = bfhi(v.x); f[2] = bflo(v.y); f[3] = bfhi(v.y); f[4] = bflo(v.z); f[5] = bfhi(v.z); f[6] = bflo(v.w); f[7] = bfhi(v.w); }
template <int W> __device__ __forceinline__ void delta_conv_item(const bf16* cols, bf16* delta, bf16* xc, const float* cw, const float* cb, int n0, int t0, int c8) {
    u32x4 R[W + 7], X[11];
#pragma unroll
    for (int j = 0; j < W + 7; ++j) { const int dt = j - (W - 1); R[j] = (t0 + dt >= 0) ? *(const u32x4*)(cols + (size_t)(n0 + dt) * CW + C_POOL + c8) : (u32x4){0u, 0u, 0u, 0u}; }
#pragma unroll
    for (int j = 0; j < 11; ++j) { const int dt = j - 3; X[j] = (t0 + dt >= 0) ? *(const u32x4*)(cols + (size_t)(n0 + dt) * CW + C_LX + c8) : (u32x4){0u, 0u, 0u, 0u}; }
    float s[8];
#pragma unroll
    for (int q = 0; q < 8; ++q) s[q] = 0.f;
#pragma unroll
    for (int j = 0; j < W - 1; ++j) { float f[8]; unpack8(R[j], f);
#pragma unroll
        for (int q = 0; q < 8; ++q) s[q] += f[q]; }
#pragma unroll
    for (int i = 0; i < 8; ++i) { float fn[8]; unpack8(R[i + W - 1], fn);
#pragma unroll
        for (int q = 0; q < 8; ++q) s[q] += fn[q];
        const int t = t0 + i; const float inv = 1.0f / (float)((t + 1) < W ? (t + 1) : W); u32x4 o;
        o.x = pk_bf16(s[0] * inv - fn[0], s[1] * inv - fn[1]); o.y = pk_bf16(s[2] * inv - fn[2], s[3] * inv - fn[3]); o.z = pk_bf16(s[4] * inv - fn[4], s[5] * inv - fn[5]); o.w = pk_bf16(s[6] * inv - fn[6], s[7] * inv - fn[7]);
        *(u32x4*)(delta + (size_t)(n0 + i) * 3072 + c8) = o;
        float fo[8]; unpack8(R[i], fo);
#pragma unroll
        for (int q = 0; q < 8; ++q) s[q] -= fo[q]; }
    float w0[8], w1[8], w2[8], w3[8], bb[8];
#pragma unroll
    for (int q = 0; q < 8; ++q) { w0[q] = cw[c8 + q]; w1[q] = cw[1024 + c8 + q]; w2[q] = cw[2048 + c8 + q]; w3[q] = cw[3072 + c8 + q]; bb[q] = cb[c8 + q]; }
#pragma unroll
    for (int i = 0; i < 8; ++i) { float a[8], b[8], c[8], d[8]; unpack8(X[i], a); unpack8(X[i + 1], b); unpack8(X[i + 2], c); unpack8(X[i + 3], d); float r[8];
#pragma unroll
        for (int q = 0; q < 8; ++q) r[q] = bb[q] + a[q] * w0[q] + b[q] * w1[q] + c[q] * w2[q] + d[q] * w3[q];
        u32x4 o; o.x = pk_bf16(r[0], r[1]); o.y = pk_bf16(r[2], r[3]); o.z = pk_bf16(r[4], r[5]); o.w = pk_bf16(r[6], r[7]);
        *(u32x4*)(xc + (size_t)(n0 + i) * 1024 + c8) = o; }
}
__device__ __forceinline__ void phase_delta_conv(Frame& F, int l) {
    const bf16* cols = (const bf16*)(F.ws + WS_R2); bf16* delta = (bf16*)(F.ws + WS_R3); bf16* xc = (bf16*)(F.ws + WS_R45) + (size_t)MP * 1024;
    const float* cw = F.I(I_CONVW) + (size_t)l * 4 * 1024; const float* cb = F.I(I_CONVB) + (size_t)l * 1024;
    const int gw = F.vcu * 8 + F.wave, NGW = F.G * 8, lane = F.lane;
    const int total = (NTOK / 16) * 4, full = total / NGW;
    for (int k = 0; k <= full; ++k) { const int it = k * NGW + (k == full ? NGW - 1 - gw : gw); if (it >= total) break;
        const int g = it & 3, tp = it >> 2, n0 = (tp * 2 + (lane >> 5)) * 8, t0 = n0 % LSEQ, c8 = g * 256 + (lane & 31) * 8;
        if (g == 0) delta_conv_item<2>(cols, delta, xc, cw, cb, n0, t0, c8);
        else if (g == 1) delta_conv_item<4>(cols, delta, xc, cw, cb, n0, t0, c8);
        else if (g == 2) delta_conv_item<8>(cols, delta, xc, cw, cb, n0, t0, c8);
        else delta_conv_item<16>(cols, delta, xc, cw, cb, n0, t0, c8);
    }
}
typedef float f32x16 __attribute__((ext_vector_type(16)));
__device__ __forceinline__ void phase_attn(Frame& F, int l) {
    const bf16* cols = (const bf16*)(F.ws + WS_R2); bf16* mix = (bf16*)(F.ws + WS_R3);
    constexpr int KS_BYTES = 27648, BUF_BYTES = 27648 + 25088;
    const int tid = F.tid, lane = F.lane, wave = F.wave, r = lane & 31, h = lane >> 5, g = wave >> 1, qh = wave & 1;
    const int NU = NB * 4 * 65;
    u32x4 kreg[3], vreg[3];
#define ATT_FETCH(u_) do { const int qb_ = (u_) % 65, bk_ = (u_) / 65, kvh_ = bk_ & 3, b_ = bk_ >> 2, t0_ = qb_ * 64; const size_t nb_ = (size_t)b_ * LSEQ; \
        _Pragma("unroll") for (int i = 0; i < 3; ++i) { const int c = tid + 512 * i, key = c >> 3, dc = c & 7; int tc = t0_ - 128 + key; tc = tc < 0 ? 0 : (tc > LSEQ - 1 ? LSEQ - 1 : tc); \
            const bf16* src = cols + (nb_ + tc) * CW + kvh_ * 64 + dc * 8; kreg[i] = *(const u32x4*)(src + C_K); vreg[i] = *(const u32x4*)(src + C_V); } } while (0)
    int u = F.vcu, buf = 0;
    if (u < NU) ATT_FETCH(u);
    for (; u < NU; u += F.G, buf ^= 1) {
        LAS unsigned char* Ks = F.lds + buf * BUF_BYTES; LAS unsigned char* Vt = Ks + KS_BYTES;
        const int qb = u % 65, bk = u / 65, kvh = bk & 3, b = bk >> 2, t0 = qb * 64; const size_t nb = (size_t)b * LSEQ;
#pragma unroll
        for (int i = 0; i < 3; ++i) { const int c = tid + 512 * i, key = c >> 3, dc = c & 7; const u32x4 vv = vreg[i];
            *(LAS u32x4*)(Ks + key * 144 + dc * 16) = kreg[i];
            LAS unsigned short* vp = (LAS unsigned short*)(Vt + (8 * dc) * 392 + key * 2);
            vp[0 * 196] = (unsigned short)(vv.x & 0xffffu); vp[1 * 196] = (unsigned short)(vv.x >> 16); vp[2 * 196] = (unsigned short)(vv.y & 0xffffu); vp[3 * 196] = (unsigned short)(vv.y >> 16);
            vp[4 * 196] = (unsigned short)(vv.z & 0xffffu); vp[5 * 196] = (unsigned short)(vv.z >> 16); vp[6 * 196] = (unsigned short)(vv.w & 0xffffu); vp[7 * 196] = (unsigned short)(vv.w >> 16); }
        const int head = kvh * 4 + g, tq = t0 + 32 * qh + r, tqc = tq > LSEQ - 1 ? LSEQ - 1 : tq;
        bf16x8 qf[4];
        { const bf16* qp = cols + (nb + tqc) * CW + C_Q + head * 64 + 8 * h;
#pragma unroll
          for (int ks = 0; ks < 4; ++ks) qf[ks] = *(const bf16x8*)(qp + 16 * ks); }
        if (u + F.G < NU) ATT_FETCH(u + F.G);
        const float slope2 = exp2f(-0.5f * (float)(head + 1)) * 1.44269504089f, sink2 = F.I(I_SINK)[l * 16 + head] * 1.44269504089f;
        __syncthreads();
        f32x16 st[5];
#pragma unroll
        for (int jj = 0; jj < 5; ++jj) { f32x16 a;
#pragma unroll
            for (int i = 0; i < 16; ++i) a[i] = 0.f;
#pragma unroll
            for (int ks = 0; ks < 4; ++ks) { const bf16x8 kf = *(const LAS bf16x8*)(Ks + (32 * (qh + jj) + r) * 144 + (16 * ks + 8 * h) * 2); a = __builtin_amdgcn_mfma_f32_32x32x16_bf16(kf, qf[ks], a, 0, 0, 0); }
            st[jj] = a; }
        float m = sink2;
#pragma unroll
        for (int jj = 0; jj < 5; ++jj) { const int tsb = t0 - 128 + 32 * (qh + jj) + 4 * h, db = 128 - 32 * jj + r - 4 * h; const float dl = slope2 * (float)db; const bool edge = (jj == 0) || (jj == 4) || (t0 - 128 + 32 * (qh + jj) < 0);
            if (!edge) {
#pragma unroll
                for (int i = 0; i < 16; ++i) { const float v = __builtin_fmaf(st[jj][i], 1.44269504089f, __builtin_fmaf(slope2, (float)((i & 3) + 8 * (i >> 2)), -dl)); st[jj][i] = v; m = fmaxf(m, v); }
            } else {
#pragma unroll
                for (int i = 0; i < 16; ++i) { const int cr = (i & 3) + 8 * (i >> 2), dist = db - cr; const bool ok = dist >= 0 && dist < 128 && (tsb + cr) >= 0;
                    const float v = ok ? __builtin_fmaf(st[jj][i], 1.44269504089f, __builtin_fmaf(slope2, (float)cr, -dl)) : -1e30f; st[jj][i] = v; m = fmaxf(m, v); }
            } }
        m = fmaxf(m, __shfl_xor(m, 32));
        float sum = 0.f;
#pragma unroll
        for (int jj = 0; jj < 5; ++jj)
#pragma unroll
            for (int i = 0; i < 16; ++i) { const float pv = __builtin_amdgcn_exp2f(st[jj][i] - m); st[jj][i] = pv; sum += pv; }
        sum += __shfl_xor(sum, 32);
        const float inv = 1.0f / (sum + __builtin_amdgcn_exp2f(sink2 - m));
        f32x16 o[2];
#pragma unroll
        for (int i = 0; i < 16; ++i) { o[0][i] = 0.f; o[1][i] = 0.f; }
#pragma unroll
        for (int jj = 0; jj < 5; ++jj)
#pragma unroll
            for (int s = 0; s < 2; ++s) { u32x4 pw; pw.x = pk_bf16(st[jj][8 * s], st[jj][8 * s + 1]); pw.y = pk_bf16(st[jj][8 * s + 2], st[jj][8 * s + 3]); pw.z = pk_bf16(st[jj][8 * s + 4], st[jj][8 * s + 5]); pw.w = pk_bf16(st[jj][8 * s + 6], st[jj][8 * s + 7]);
                const bf16x8 pf = __builtin_bit_cast(bf16x8, pw);
#pragma unroll
                for (int db2 = 0; db2 < 2; ++db2) { const LAS unsigned char* vb = Vt + (32 * db2 + r) * 392 + (32 * (qh + jj) + 16 * s + 4 * h) * 2;
                    const u32x2 lo = *(const LAS u32x2*)vb, hi = *(const LAS u32x2*)(vb + 16); u32x4 vw; vw.x = lo.x; vw.y = lo.y; vw.z = hi.x; vw.w = hi.y;
                    o[db2] = __builtin_amdgcn_mfma_f32_32x32x16_bf16(__builtin_bit_cast(bf16x8, vw), pf, o[db2], 0, 0, 0); } }
        if (tq < LSEQ) { bf16* op = mix + (nb + tq) * 3072 + 1024 + head * 64 + 4 * h;
#pragma unroll
            for (int db2 = 0; db2 < 2; ++db2)
#pragma unroll
                for (int g4 = 0; g4 < 4; ++g4) { u32x2 w; w.x = pk_bf16(o[db2][4 * g4] * inv, o[db2][4 * g4 + 1] * inv); w.y = pk_bf16(o[db2][4 * g4 + 2] * inv, o[db2][4 * g4 + 3] * inv);
                    *(u32x2*)(op + 32 * db2 + 8 * g4) = w; } }
    }
#undef ATT_FETCH
    __syncthreads();
}
__device__ __forceinline__ void phase_lru_summ(Frame& F) {
    const bf16* Ab = (const bf16*)(F.ws + WS_R6); const bf16* Bb = Ab + (size_t)MP * 1024; float* summ = (float*)(F.ws + WS_SUMM);
    const int gt = ((F.tid >> 8) * F.G + F.vcu) * 256 + (F.tid & 255), NT = F.G * 512;
    for (int it = gt; it < NCHUNK * 256; it += NT) { const int ck = it >> 8, c = (it & 255) * 4, r0 = ck * 64, nr = (r0 + 64) <= NTOK ? 64 : NTOK - r0;
        f32x4 A = (f32x4){1.f, 1.f, 1.f, 1.f}, Bv = (f32x4){0.f, 0.f, 0.f, 0.f};
        const bf16* ap = Ab + (size_t)r0 * 1024 + c; const bf16* bp = Bb + (size_t)r0 * 1024 + c;
        for (int r = 0; r < nr; r += 16) { u32x2 aw[16], bw[16];
#pragma unroll
            for (int i = 0; i < 16; ++i) { aw[i] = *(const u32x2*)(ap + (size_t)(r + i) * 1024); bw[i] = *(const u32x2*)(bp + (size_t)(r + i) * 1024); }
#pragma unroll
            for (int i = 0; i < 16; ++i) { const f32x4 a = (f32x4){1.f - bflo(aw[i].x), 1.f - bfhi(aw[i].x), 1.f - bflo(aw[i].y), 1.f - bfhi(aw[i].y)}, b = (f32x4){bflo(bw[i].x), bfhi(bw[i].x), bflo(bw[i].y), bfhi(bw[i].y)};
                Bv = a * Bv + b; A = A * a; } }
        *(f32x4*)(summ + ((size_t)ck * 1024 + c) * 2) = A; *(f32x4*)(summ + ((size_t)ck * 1024 + c) * 2 + 4) = Bv; }
}
__device__ __forceinline__ void phase_lru_final(Frame& F) {
    const bf16* Ab = (const bf16*)(F.ws + WS_R6); const bf16* Bb = Ab + (size_t)MP * 1024; const float* summ = (const float*)(F.ws + WS_SUMM);
    const bf16* cols = (const bf16*)(F.ws + WS_R2); bf16* mix = (bf16*)(F.ws + WS_R3);
    const int gt = ((F.tid >> 8) * F.G + F.vcu) * 256 + (F.tid & 255), NT = F.G * 512;
    for (int it = gt; it < NCHUNK * 256; it += NT) { const int ck = it >> 8, c = (it & 255) * 4, r0 = ck * 64, nr = (r0 + 64) <= NTOK ? 64 : NTOK - r0;
        const int c0 = ((r0 / LSEQ) * LSEQ) / 64; f32x4 h = (f32x4){0.f, 0.f, 0.f, 0.f};
        int cc = c0;
        for (; cc + 16 <= ck; cc += 16) { f32x4 sa[16], sb[16];
#pragma unroll
            for (int i = 0; i < 16; ++i) { const float* sp = summ + ((size_t)(cc + i) * 1024 + c) * 2; sa[i] = *(const f32x4*)sp; sb[i] = *(const f32x4*)(sp + 4); }
#pragma unroll
            for (int i = 0; i < 16; ++i) h = sa[i] * h + sb[i]; }
        for (; cc + 4 <= ck; cc += 4) { f32x4 sa[4], sb[4];
#pragma unroll
            for (int i = 0; i < 4; ++i) { const float* sp = summ + ((size_t)(cc + i) * 1024 + c) * 2; sa[i] = *(const f32x4*)sp; sb[i] = *(const f32x4*)(sp + 4); }
#pragma unroll
            for (int i = 0; i < 4; ++i) h = sa[i] * h + sb[i]; }
        for (; cc < ck; ++cc) { const float* sp = summ + ((size_t)cc * 1024 + c) * 2; h = *(const f32x4*)sp * h + *(const f32x4*)(sp + 4); }
        const bf16* ap = Ab + (size_t)r0 * 1024 + c; const bf16* bp = Bb + (size_t)r0 * 1024 + c;
        for (int r = 0; r < nr; r += 16) { u32x2 aw[16], bw[16]; u32x2 yw[16];
#pragma unroll
            for (int i = 0; i < 16; ++i) { aw[i] = *(const u32x2*)(ap + (size_t)(r + i) * 1024); bw[i] = *(const u32x2*)(bp + (size_t)(r + i) * 1024); yw[i] = *(const u32x2*)(cols + (size_t)(r0 + r + i) * CW + C_LY + c); }
#pragma unroll
            for (int i = 0; i < 16; ++i) { const f32x4 a = (f32x4){1.f - bflo(aw[i].x), 1.f - bfhi(aw[i].x), 1.f - bflo(aw[i].y), 1.f - bfhi(aw[i].y)}, b = (f32x4){bflo(bw[i].x), bfhi(bw[i].x), bflo(bw[i].y), bfhi(bw[i].y)};
                h = a * h + b;
                const float y[4] = {bflo(yw[i].x), bfhi(yw[i].x), bflo(yw[i].y), bfhi(yw[i].y)}; float o[4];
#pragma unroll
                for (int j = 0; j < 4; ++j) o[j] = h[j] * y[j] * sigmoidf_(1.5957691216f * (y[j] + 0.044715f * y[j] * y[j] * y[j]));
                u32x2 w; w.x = pk_bf16(o[0], o[1]); w.y = pk_bf16(o[2], o[3]); *(u32x2*)(mix + (size_t)(r0 + r + i) * 3072 + 2048 + c) = w; } } }
}
template <int NG, bool DUMMY> __device__ __forceinline__ void ln1_groups(Frame& F, int l, int j0) {
    float* H = (float*)(F.ws + WS_H); float* Hout = DUMMY ? (float*)(F.ws + WS_R6) : H; unsigned char* HB8 = F.ws + (DUMMY ? WS_R3 : WS_HB8); const float* stats = (const float*)(F.ws + WS_STATS);
    const float* g1 = F.I(I_LN1G) + (size_t)l * D; const float* b1 = F.I(I_LN1B) + (size_t)l * D;
    const bf16* whi = (const bf16*)(F.ws + WS_WRT) + (size_t)(l * 2) * 48 * 2048; const bf16* wlo = whi + 48 * 2048;
    const int lane = F.lane, p = lane & 15, kg = lane >> 4, wave = F.wave;
    float mean[NG], rstd[NG]; size_t roff[NG]; f32x4 acc[NG][3];
#pragma unroll
    for (int j = 0; j < NG; ++j) { const int row = (F.vcu + (j0 + j) * F.G) * 16 + p; roff[j] = (size_t)row * D;
        float s = 0.f, q = 0.f; const f32x4* sp = (const f32x4*)(stats + (size_t)row * 64 + kg * 16);
#pragma unroll
        for (int i = 0; i < 4; ++i) { const f32x4 t = sp[i]; s += t[0] + t[2]; q += t[1] + t[3]; }
        s += __shfl_xor(s, 16); s += __shfl_xor(s, 32); q += __shfl_xor(q, 16); q += __shfl_xor(q, 32);
        mean[j] = s * (1.f / D); rstd[j] = 1.f / sqrtf(fmaxf(q * (1.f / D) - mean[j] * mean[j], 0.f) + LN_EPS);
#pragma unroll
        for (int cb = 0; cb < 3; ++cb) acc[j][cb] = (f32x4){0.f, 0.f, 0.f, 0.f}; }
#pragma unroll 2
    for (int ks = 0; ks < 8; ++ks) {
        const int col = wave * 256 + ks * 32 + kg * 8;
        f32x4 y0[NG], y1[NG];
#pragma unroll
        for (int j = 0; j < NG; ++j) { y0[j] = *(const f32x4*)(H + roff[j] + col); y1[j] = *(const f32x4*)(H + roff[j] + col + 4); }
        const f32x4 ga = *(const f32x4*)(g1 + col), gb = *(const f32x4*)(g1 + col + 4), ba = *(const f32x4*)(b1 + col), bb = *(const f32x4*)(b1 + col + 4);
        bf16x8 wh[3], wl[3];
#pragma unroll
        for (int cb = 0; cb < 3; ++cb) { wh[cb] = *(const bf16x8*)(whi + (size_t)(cb * 16 + p) * 2048 + col); wl[cb] = *(const bf16x8*)(wlo + (size_t)(cb * 16 + p) * 2048 + col); }
#pragma unroll
        for (int j = 0; j < NG; ++j) {
            const f32x4 h0 = (y0[j] - mean[j]) * rstd[j] * ga + ba, h1 = (y1[j] - mean[j]) * rstd[j] * gb + bb;
            u32x4 hi; hi.x = pk_bf16(h0[0], h0[1]); hi.y = pk_bf16(h0[2], h0[3]); hi.z = pk_bf16(h1[0], h1[1]); hi.w = pk_bf16(h1[2], h1[3]);
            { u32x2 w8; w8.x = pk_fp8x4(h0[0], h0[1], h0[2], h0[3]); w8.y = pk_fp8x4(h1[0], h1[1], h1[2], h1[3]); *(u32x2*)(HB8 + roff[j] + col) = w8; }
            u32x4 lo; lo.x = pk_bf16(h0[0] - bflo(hi.x), h0[1] - bfhi(hi.x)); lo.y = pk_bf16(h0[2] - bflo(hi.y), h0[3] - bfhi(hi.y));
            lo.z = pk_bf16(h1[0] - bflo(hi.z), h1[1] - bfhi(hi.z)); lo.w = pk_bf16(h1[2] - bflo(hi.w), h1[3] - bfhi(hi.w));
            const bf16x8 xh = __builtin_bit_cast(bf16x8, hi), xl = __builtin_bit_cast(bf16x8, lo);
#pragma unroll
            for (int cb = 0; cb < 3; ++cb) { acc[j][cb] = __builtin_amdgcn_mfma_f32_16x16x32_bf16(wh[cb], xh, acc[j][cb], 0, 0, 0);
                acc[j][cb] = __builtin_amdgcn_mfma_f32_16x16x32_bf16(wh[cb], xl, acc[j][cb], 0, 0, 0); acc[j][cb] = __builtin_amdgcn_mfma_f32_16x16x32_bf16(wl[cb], xh, acc[j][cb], 0, 0, 0); } }
    }
#pragma unroll
    for (int j = 0; j < NG; ++j) { LAS float* lgs = (LAS float*)(F.lds + (j0 + j) * 24576);
#pragma unroll
        for (int cb = 0; cb < 3; ++cb) *(LAS f32x4*)(lgs + (wave * 16 + p) * 48 + cb * 16 + kg * 4) = acc[j][cb]; }
}
template <bool DUMMY> __device__ __forceinline__ void phase_ln1_router(Frame& F, int l) {
    float* H = (float*)(F.ws + WS_H); float* Hout = DUMMY ? (float*)(F.ws + WS_R6) : H; unsigned char* HB8 = F.ws + (DUMMY ? WS_R3 : WS_HB8); const float* stats = (const float*)(F.ws + WS_STATS);
    int* tokinfo = (int*)(F.ws + (DUMMY ? WS_R45 + 4 * MiB : WS_TOKINFO)); int* elist = (int*)(F.ws + (DUMMY ? WS_R45 : WS_ELIST)); unsigned* count = (unsigned*)(F.ws + WS_CTL) + CW_COUNT + ((DUMMY ? 64 : 0) + l * 32) * CNT_STRIDE;
    const float* g1 = F.I(I_LN1G) + (size_t)l * D; const float* b1 = F.I(I_LN1B) + (size_t)l * D;
    const bf16* whi = (const bf16*)(F.ws + WS_WRT) + (size_t)(l * 2) * 48 * 2048; const bf16* wlo = whi + 48 * 2048;
    const float* bg = F.I(I_RGB) + l * 4; const float* be = F.I(I_REB) + l * 32;
    const int lane = F.lane, p = lane & 15, kg = lane >> 4, wave = F.wave;
    ln1_groups<4, DUMMY>(F, l, 0); if (F.vcu + 4 * F.G < NTOK / 16) ln1_groups<1, DUMMY>(F, l, 4);
    __syncthreads();
    LAS unsigned* lcnt = (LAS unsigned*)(F.lds + TBL_OFF + 512);
    if (F.tid < 64) lcnt[F.tid] = 0u;
    __syncthreads();
    int ea = 0, eb = 0, n = 0; unsigned la = 0u, lb = 0u; float w0 = 0.f, w1 = 0.f; bool have = false;
    { const int grp = F.vcu + wave * F.G;
        if (grp < NTOK / 16 && lane < 16) {
            const LAS float* lgs = (const LAS float*)(F.lds + wave * 24576);
            n = grp * 16 + lane; have = true; float lg[36];
            const f32x4 bgv = *(const f32x4*)bg; f32x4 bev[8];
#pragma unroll
            for (int i = 0; i < 8; ++i) bev[i] = *(const f32x4*)(be + 4 * i);
#pragma unroll
            for (int i = 0; i < 36; ++i) lg[i] = 0.f;
#pragma unroll 1
            for (int w = 0; w < 8; ++w) {
#pragma unroll
                for (int i4 = 0; i4 < 9; ++i4) { const f32x4 t = *(const LAS f32x4*)(lgs + (w * 16 + lane) * 48 + 4 * i4); lg[4 * i4] += t[0]; lg[4 * i4 + 1] += t[1]; lg[4 * i4 + 2] += t[2]; lg[4 * i4 + 3] += t[3]; } }
            float gl[4];
#pragma unroll
            for (int i = 0; i < 4; ++i) gl[i] = lg[i] + bgv[i];
            int g = 0; float gm = gl[0];
#pragma unroll
            for (int i = 1; i < 4; ++i) if (gl[i] > gm) { gm = gl[i]; g = i; }
            float gs = 0.f;
#pragma unroll
            for (int i = 0; i < 4; ++i) gs += fast_exp(gl[i] - gm);
            const float pg = 1.0f / gs;
            float el[8];
#pragma unroll
            for (int j = 0; j < 8; ++j) { const float x0 = lg[4 + j] + bev[j >> 2][j & 3], x1 = lg[12 + j] + bev[2 + (j >> 2)][j & 3], x2 = lg[20 + j] + bev[4 + (j >> 2)][j & 3], x3 = lg[28 + j] + bev[6 + (j >> 2)][j & 3]; el[j] = g == 0 ? x0 : g == 1 ? x1 : g == 2 ? x2 : x3; }
            int i0 = 0; float m0 = el[0];
#pragma unroll
            for (int j = 1; j < 8; ++j) if (el[j] > m0) { m0 = el[j]; i0 = j; }
            int i1 = -1; float m1 = -3.0e38f;
#pragma unroll
            for (int j = 0; j < 8; ++j) if (j != i0 && el[j] > m1) { m1 = el[j]; i1 = j; }
            const float e1 = fast_exp(m1 - m0); w0 = pg / (1.0f + e1); w1 = pg * e1 / (1.0f + e1);
            ea = g * 8 + i0; eb = g * 8 + i1;
            la = __hip_atomic_fetch_add(lcnt + ea, 1u, __ATOMIC_RELAXED, __HIP_MEMORY_SCOPE_WORKGROUP); lb = __hip_atomic_fetch_add(lcnt + eb, 1u, __ATOMIC_RELAXED, __HIP_MEMORY_SCOPE_WORKGROUP);
        }
    }
    __syncthreads();
    if (F.tid < 32) { const unsigned c = lcnt[F.tid]; lcnt[32 + F.tid] = c ? __hip_atomic_fetch_add(count + F.tid * CNT_STRIDE, c, RLX_AGENT) : 0u; }
    __syncthreads();
    if (have) { const unsigned ra = lcnt[32 + ea] + la, rb = lcnt[32 + eb] + lb;
        elist[(size_t)ea * NTOK + ra] = n; elist[(size_t)eb * NTOK + rb] = n;
        int* ti = tokinfo + (size_t)n * 8; ti[0] = ea; ti[1] = (int)ra; ti[2] = __float_as_int(w0); ti[3] = eb; ti[4] = (int)rb; ti[5] = __float_as_int(w1); }
    __syncthreads();
    const int gw = F.vcu * 8 + F.wave, NGW = F.G * 8;
    LAS float* scr = (LAS float*)(F.lds + F.wave * 16384);
    if (!DUMMY) {
        if (F.G == 256) {
            const int TW = (NTOK / 16 - 4 * 256) * 8;
            const int nr = F.vcu < 4 ? 20 : 24;
            for (int k = 0; k < nr; ++k) conv_expert_weights(F, l, k * NGW + gw, scr);
            const int w = gw - TW; if (w >= 0 && w < 4 * TW) conv_expert_weights(F, l, (20 + w / TW) * NGW + (w % TW), scr);
        } else for (int it = gw; it < 49152; it += NGW) conv_expert_weights(F, l, it, scr);
    }
}
__device__ __forceinline__ void moe_tables(Frame& F, int l) {
    LAS int* tb = (LAS int*)(F.lds + TBL_OFF);
    __syncthreads();
    if (F.tid < 64) { const unsigned* count = (const unsigned*)(F.ws + WS_CTL) + CW_COUNT + l * 32 * CNT_STRIDE; const int e = F.tid;
        const int cn = e < 32 ? (int)__hip_atomic_load(count + e * CNT_STRIDE, RLX_AGENT) : 0; const int tiles = (cn + 255) >> 8; int incl = tiles;
#pragma unroll
        for (int d = 1; d < 32; d <<= 1) { const int t = __shfl_up(incl, d); if (e >= d) incl += t; }
        if (e < 32) { tb[e] = incl - tiles; tb[40 + e] = cn; } if (e == 31) tb[32] = incl; }
    __syncthreads();
}
template <bool DUMMY> __device__ __forceinline__ void phase_final(Frame& F, int l) {
    float* H = (float*)(F.ws + WS_H); bf16* HB = (bf16*)(F.ws + (DUMMY ? WS_R45 : WS_HB)); float* Hout = DUMMY ? (float*)(F.ws + WS_R6) : H; unsigned char* H8 = F.ws + (DUMMY ? WS_R3 : WS_HB8); const unsigned char* yd = F.ws + WS_R1; const int* tokinfo = (const int*)(F.ws + WS_TOKINFO);
    const LAS int* tb = (const LAS int*)(F.lds + TBL_OFF);
    const float* g2 = F.I(I_LN2G) + (size_t)l * D; const float* b2 = F.I(I_LN2B) + (size_t)l * D; const float* g1 = F.I(I_LN1G) + (size_t)l * D; const float* b1 = F.I(I_LN1B) + (size_t)l * D; const float* stats = (const float*)(F.ws + WS_STATS);
    const int gw = F.vcu * 8 + F.wave, NGW = F.G * 8, lane = F.lane;
    for (int n = gw; n < NTOK; n += NGW) {
        const int t = n % LSEQ, b = n / LSEQ;
        if (!DUMMY && l == DEPTH - 1 && t < NMETA) continue;
        const int* ti = tokinfo + (size_t)n * 8; const int ea = ti[0], ra = ti[1], eb = ti[3], rb = ti[4]; const float w0 = __int_as_float(ti[2]) * (1.0f / YD_SCALE), w1 = __int_as_float(ti[5]) * (1.0f / YD_SCALE);
        const unsigned char* ya = yd + ((size_t)tb[ea] * 256 + ra) * D; const unsigned char* yb = yd + ((size_t)tb[eb] * 256 + rb) * D;
        f32x4 v[8]; load_row_f32(H + (size_t)n * D, v, lane);
        { float s = 0.f, q = 0.f;
          if (lane < 16) { const f32x4 t = *(const f32x4*)(stats + (size_t)n * 64 + 4 * lane); s = t[0] + t[2]; q = t[1] + t[3]; }
          s = wave_sum(s); q = wave_sum(q);
          const float mean = s * (1.f / D), rstd = 1.f / sqrtf(fmaxf(q * (1.f / D) - mean * mean, 0.f) + LN_EPS);
#pragma unroll
          for (int j = 0; j < 8; ++j) { const f32x4 gg = *(const f32x4*)(g1 + 4 * lane + 256 * j), bb = *(const f32x4*)(b1 + 4 * lane + 256 * j); v[j] = (v[j] - mean) * rstd * gg + bb; } }
#pragma unroll
        for (int j = 0; j < 8; ++j) { const unsigned a = *(const unsigned*)(ya + 4 * lane + 256 * j), c = *(const unsigned*)(yb + 4 * lane + 256 * j);
            const f32x2 a0 = __builtin_amdgcn_cvt_pk_f32_fp8((int)a, false), a1 = __builtin_amdgcn_cvt_pk_f32_fp8((int)a, true), c0 = __builtin_amdgcn_cvt_pk_f32_fp8((int)c, false), c1 = __builtin_amdgcn_cvt_pk_f32_fp8((int)c, true);
            v[j].x = v[j].x * ALPHA + w0 * a0.x + w1 * c0.x; v[j].y = v[j].y * ALPHA + w0 * a0.y + w1 * c0.y;
            v[j].z = v[j].z * ALPHA + w0 * a1.x + w1 * c1.x; v[j].w = v[j].w * ALPHA + w0 * a1.y + w1 * c1.y; }
        ln_regs(v, g2, b2, lane);
        if (!DUMMY && l == DEPTH - 1) store_row_f32(F.out + ((size_t)b * SEQ + (t - NMETA)) * D, v, lane);
        else { store_row_f32(Hout + (size_t)n * D, v, lane); store_row_bf16(HB + (size_t)n * D, v, lane); store_row_fp8(H8 + (size_t)n * D, v, lane); }
    }
}

constexpr int NPHASE = 1 + DEPTH * 11;
#define IN(k) (lo <= (k) && (k) < hi)
#define SEAM(k) do { if (IN(k) && IN((k) + 1)) { XcdBarrier b_ = bar; asm volatile("" : "+s"(b_.bar), "+s"(b_.x)); xcd_barrier(b_); } } while (0)
#define PH_BEGIN() F.z = opaque_s(0); F.ws = args.ws + F.z; F.vcu = vcu0 + F.z; F.tid = opaque_v(tid0); F.lane = F.tid & 63; F.wave = __builtin_amdgcn_readfirstlane(F.tid >> 6); const int bx = bx0 + F.z; (void)bx
template <int L> __device__ __forceinline__ void run_layer(Frame& F, const Args& args, const XcdBarrier& bar, const int lo, const int hi, const int bx0, const int vcu0, const int tid0) {
    constexpr int l = L; constexpr int pb = 1 + L * 11;
#define wl (F.ws + WS_WSMALL + (size_t)l * WL_BYTES)
        if (IN(pb + 0)) PREP(1) { PH_BEGIN();
            { PolA_<false> p; p.K = D; p.lda = D; p.ldb = D; p.A = F.ws + WS_HB; p.Bt = wl + WL_WIN; p.out = (bf16*)(F.ws + WS_R2); p.outc = p.out; p.G = F.G; p.c = bx;
              pg8::gemm_phase(F.lds, p, F.tid, F.ws); }
            { PolA_<true> p; p.K = D; p.lda = D; p.ldb = D; p.A = F.ws + WS_HB8; p.Bt = wl + WL_WIN8; p.out = (bf16*)(F.ws + WS_R1); p.outc = (bf16*)(F.ws + WS_R2); p.G = F.G; p.c = (F.G == 256) ? ((bx + A_LIGHT) & 255) : bx;
              pg8::gemm_phase(F.lds, p, F.tid, F.ws); } }
        SEAM(pb + 0);
        if (IN(pb + 1)) PREP(2) { PH_BEGIN();
            { PolW p; p.K = 256; p.lda = 1024; p.ldb = 256; p.pt = (const bf16*)(wl + WL_PROJ); p.wsc = (const bf16*)(F.ws + WS_WSC) + (size_t)l * 4 * 65536; p.wct = (bf16*)(F.ws + WS_WCT) + (size_t)l * D * 1024; p.G = F.G; p.c = (F.vcu + (F.G >> 1)) % F.G;
              pg8::gemm_phase(F.lds, p, F.tid, F.ws); }
            phase_delta_conv(F, l); phase_attn(F, l); }
        SEAM(pb + 1);
        if (IN(pb + 2)) PREP(3) { PH_BEGIN();
            PolC p; p.K = 256; p.lda = 1024; p.ldb = 256; p.delta = (const bf16*)(F.ws + WS_R45); p.xc = p.delta + (size_t)MP * 1024; p.pool_t = (const bf16*)(wl + WL_POOL); p.lru_t = (const bf16*)(wl + WL_LRU);
            p.mix = (bf16*)(F.ws + WS_R3); p.Abuf = (bf16*)(F.ws + WS_R6); p.Bbuf = p.Abuf + (size_t)MP * 1024; p.pool_scale = F.I(I_POOLS) + (size_t)l * 1024; p.ba = F.I(I_BA) + (size_t)l * 1024; p.bx = F.I(I_BX) + (size_t)l * 1024;
            p.sp8 = (const float*)(F.ws + WS_SP8) + (size_t)l * 1024; p.G = F.G; p.c = bx;
            pg8::gemm_phase(F.lds, p, F.tid, F.ws); tail_lru(F, l); }
        SEAM(pb + 2);
        if (IN(pb + 3)) PREP(4) { PH_BEGIN(); phase_lru_summ(F); }
        SEAM(pb + 3);
        if (IN(pb + 4)) PREP(5) { PH_BEGIN(); phase_lru_final(F); }
        SEAM(pb + 4);
        if (IN(pb + 5)) PREP(6) { PH_BEGIN();
            PolE p; p.K = 1024; p.lda = 3072; p.ldb = 1024; p.mix = (const bf16*)(F.ws + WS_R3); p.proj_t = (const bf16*)(wl + WL_PROJ); p.wct = (const bf16*)(F.ws + WS_WCT) + (size_t)l * D * 1024; p.gates = F.ws + WS_R1; p.merged = (bf16*)(F.ws + WS_R45); p.G = F.G; p.c = bx;
            p.t0 = 0; p.t1 = 512; pg8::gemm_phase(F.lds, p, F.tid, F.ws); tail_merge(F, l); }
        SEAM(pb + 5);
        if (IN(pb + 6)) PREP(7) { PH_BEGIN();
            PolF p; p.K = D; p.lda = D; p.ldb = D; p.A = (const bf16*)(F.ws + WS_R45); p.Bt = (const bf16*)(wl + WL_WOUT); p.H = (float*)(F.ws + WS_H); p.stats = (float*)(F.ws + WS_STATS); p.G = F.G; p.c = bx;
            p.t0 = 0; p.t1 = 512; pg8::gemm_phase(F.lds, p, F.tid, F.ws); tail_wout(F, l); }
        SEAM(pb + 6);
        if (IN(pb + 7)) PREP(8) { PH_BEGIN(); if (PROBE_G2) phase_ln1_router<true>(F, l); phase_ln1_router<false>(F, l); }
        SEAM(pb + 7);
        if (IN(pb + 8)) PREP(9) { PH_BEGIN();
            moe_tables(F, l);
            PolI p; p.K = D; p.lda = D; p.ldb = D; p.X = F.ws + WS_HB8; p.gu = F.ws + WS_R2 + EXPW_GU; p.elist = (const int*)(F.ws + WS_ELIST); p.hdn = F.ws + WS_R3;
            p.T.t = (const LAS int*)(F.lds + TBL_OFF); p.G = F.G; p.c = bx;
            pg8::gemm_phase(F.lds, p, F.tid, F.ws); }
        SEAM(pb + 8);
        if (IN(pb + 9)) PREP(10) { PH_BEGIN();
            moe_tables(F, l);
            PolJ p; p.K = DE; p.lda = DE; p.ldb = DE; p.hdn = F.ws + WS_R3; p.wd = F.ws + WS_R2 + EXPW_WD; p.yd = F.ws + WS_R1; p.T.t = (const LAS int*)(F.lds + TBL_OFF); p.G = F.G; p.c = bx;
            pg8::gemm_phase(F.lds, p, F.tid, F.ws); }
        SEAM(pb + 9);
        if (IN(pb + 10)) PREP(11) { PH_BEGIN(); moe_tables(F, l); if (PROBE_K2) phase_final<true>(F, l); phase_final<false>(F, l); }
        SEAM(pb + 10);
    }
#undef wl
__global__ void __launch_bounds__(512, 2) fwd(Args args) {
    extern __shared__ __attribute__((aligned(16))) unsigned char lds_raw[];
    Frame F; F.lds = (LAS unsigned char*)lds_raw; F.inp = args.in; F.z = 0; F.out = args.out; F.ws = args.ws;
    F.tid = threadIdx.x; F.lane = F.tid & 63; F.wave = __builtin_amdgcn_readfirstlane(F.tid >> 6);
    F.G = gridDim.x; { const int bx = blockIdx.x; F.vcu = (F.G % 8 == 0) ? (bx % 8) * (F.G / 8) + bx / 8 : bx; }
    volatile LAS unsigned* MISC = (volatile LAS unsigned*)(F.lds + MISC_OFF);
    for (int u = F.tid; u < (LDS_BYTES - MISC_OFF) / 4; u += 512) ((LAS unsigned*)(F.lds + MISC_OFF))[u] = 0u;
    __syncthreads();
    unsigned* ctl = (unsigned*)(F.ws + WS_CTL);
    XcdBarrier bar; bar.bar = ctl + CW_BAR; bar.x = 0; bar.st = nullptr;
    if (MK_ONE_LAUNCH) bar = xcd_barrier_post(ctl + CW_BAR, MISC + 8);
    const int lo = args.ph_lo, hi = args.ph_hi;
    const int bx0 = (int)blockIdx.x, vcu0 = F.vcu, tid0 = F.tid;

    if (IN(0)) PREP(0) { PH_BEGIN(); p0_prologue(F); } SEAM(0);

    run_layer<0>(F, args, bar, lo, hi, bx0, vcu0, tid0);
    run_layer<1>(F, args, bar, lo, hi, bx0, vcu0, tid0);
#undef IN
#undef SEAM
}

extern "C" void kernel_launch(void* const* d_in, const int* in_sizes, int n_in, void* d_out, int out_size, void* d_ws, size_t ws_size, hipStream_t stream) {
    static int grid = 0;
    if (grid == 0) {
        if (n_in != 30 || out_size != NB * SEQ * D || ws_size < WS_END) { fprintf(stderr, "kernel_launch: unexpected shapes (n_in %d, out %d, ws %zu)\n", n_in, out_size, ws_size); grid = -1; return; }
        int dev = 0, cus = 0, per_cu = 0;
        if (hipGetDevice(&dev) != hipSuccess || hipDeviceGetAttribute(&cus, hipDeviceAttributeMultiprocessorCount, dev) != hipSuccess) { grid = -1; return; }
        if (hipFuncSetAttribute((const void*)fwd, hipFuncAttributeMaxDynamicSharedMemorySize, LDS_BYTES) != hipSuccess) { fprintf(stderr, "kernel_launch: hipFuncSetAttribute failed\n"); grid = -1; return; }
        if (hipOccupancyMaxActiveBlocksPerMultiprocessor(&per_cu, (const void*)fwd, 512, LDS_BYTES) != hipSuccess || per_cu < 1) fprintf(stderr, "kernel_launch: occupancy query says %d\n", per_cu);
        (void)hipGetLastError();
        grid = cus;
    }
    if (grid < 0) return;
    (void)hipMemsetAsync((char*)d_ws + WS_CTL, 0, CTL_ZERO_BYTES, stream);
    Args a{};
    for (int i = 0; i < 30; ++i) a.in[i] = (const float*)d_in[i];
    a.out = (float*)d_out; a.ws = (unsigned char*)d_ws;
#if MK_ONE_LAUNCH
    a.ph_lo = 0; a.ph_hi = NPHASE;
    hipLaunchKernelGGL(fwd, dim3(grid), dim3(512), LDS_BYTES, stream, a);
#else
    for (int k = 0; k < NPHASE; ++k) { a.ph_lo = k; a.ph_hi = k + 1; hipLaunchKernelGGL(fwd, dim3(grid), dim3(512), LDS_BYTES, stream, a); }
#endif
}
```

```cpp
#include <hip/hip_runtime.h>
#include <cstdio>
#include <cstdint>

#define PROBE_MASK 0
#define PROBE_K2 0
#define PROBE_G2 0
#define PREP(k) for (int rep_ = 0; rep_ < (((PROBE_MASK) >> (k)) & 1) + 1; ++rep_)
#ifndef MK_ONE_LAUNCH
#define MK_ONE_LAUNCH 1
#endif

#define LAS __attribute__((address_space(3)))
#define GAS __attribute__((address_space(1)))
typedef unsigned short bf16;
typedef short bf16x8 __attribute__((ext_vector_type(8)));
typedef float f32x4 __attribute__((ext_vector_type(4)));
typedef float f32x2 __attribute__((ext_vector_type(2)));
typedef unsigned u32x4 __attribute__((ext_vector_type(4)));
typedef unsigned u32x2 __attribute__((ext_vector_type(2)));
typedef __bf16 bf16x2_t __attribute__((ext_vector_type(2)));
typedef int i32x4 __attribute__((ext_vector_type(4)));
typedef int i32x8 __attribute__((ext_vector_type(8)));
typedef GAS unsigned gu32;
#define RLX_AGENT __ATOMIC_RELAXED, __HIP_MEMORY_SCOPE_AGENT
#define LDS_WAIT() asm volatile("s_waitcnt lgkmcnt(0)" ::: "memory")
#define VM_WAIT() asm volatile("s_waitcnt vmcnt(0)" ::: "memory")

constexpr int D = 2048, NB = 4, SEQ = 4096, NMETA = 16, LSEQ = SEQ + NMETA, NTOK = NB * LSEQ  , MP = 16640  , NPANEL = 65, DEPTH = 2;
constexpr int CW = 4608  , GW = 6144, INC = CW + GW;
#ifndef A8_MASK
#define A8_MASK 0x3FE00u
#endif
constexpr int C_POOL = 0, C_Q = 1024, C_K = 2048, C_V = 2304, C_LX = 2560, C_LY = 3584;
constexpr int NEXP = 32, DE = 512, CAPT = 161, CAP = CAPT * 256, NCHUNK = (NTOK + 63) / 64  ;
constexpr float LN_EPS = 1e-5f, ALPHA = 1.41421356237f;

constexpr size_t MiB = 1u << 20;
constexpr size_t WS_CTL = 0, CTL_ZERO_BYTES = 1 * MiB;
constexpr size_t WS_SP8 = 1 * MiB;
constexpr size_t WS_TOKINFO = 2 * MiB;
constexpr size_t WS_ELIST = 3 * MiB;
constexpr size_t WS_SUMM = 6 * MiB;
constexpr size_t WS_WSMALL = 9 * MiB;
constexpr size_t WL_WIN8 = (size_t)CW * 2048 * 2;
constexpr size_t WL_BYTES = 66584576, WL_WIN = 0, WL_PROJ = 44040192, WL_WOUT = 56623104, WL_POOL = 65011712, WL_LRU = 65536000;
constexpr size_t WS_H = 136 * MiB;
constexpr size_t WS_HB = 266 * MiB;
constexpr size_t WS_R1 = 331 * MiB;
constexpr size_t WS_R2 = 526 * MiB;
constexpr size_t WS_R6 = 673 * MiB;
constexpr size_t WS_R3 = 803 * MiB;
constexpr size_t WS_R45 = 901 * MiB;
constexpr size_t WS_STATS = 966 * MiB;
constexpr size_t WS_WRT = 972 * MiB;
constexpr size_t WS_HB8 = 974 * MiB;
constexpr size_t WS_WSC = 1008 * MiB;
constexpr size_t WS_WCT = 1010 * MiB;
constexpr size_t WS_END = 1018 * MiB;
constexpr size_t EXPW_GU = 0, EXPW_WD = 67108864;
constexpr float W8_SCALE = 64.0f, HDN_SCALE = 8.0f, YD_SCALE = 16.0f;
static_assert(WS_WSMALL + 2 * WL_BYTES <= WS_H && WS_R2 + 201326592 <= WS_R3 && WS_R6 + 2ull * MP * 1024 * 4 <= WS_R3 && WS_R3 + (size_t)MP * 3072 * 2 <= WS_R45 && WS_R45 + (size_t)MP * 2048 * 2 <= WS_END, "ws map");
static_assert(WS_R1 + (size_t)MP * GW * 2 <= WS_R2 && (size_t)CAP * 2048 * 2 <= (size_t)MP * GW * 2 && WS_R2 + (size_t)MP * CW * 2 <= WS_R6, "ws map 2");
constexpr int CW_BAR = 4096;
constexpr int CW_COUNT = 16384, CNT_STRIDE = 32;

constexpr int RING_BYTES = 131072, MISC_OFF = RING_BYTES, TBL_OFF = RING_BYTES + 1024, LDS_BYTES = 147456;

__device__ __forceinline__ unsigned pk_bf16(float lo, float hi) { f32x2 v = {lo, hi}; bf16x2_t b = __builtin_convertvector(v, bf16x2_t); return __builtin_bit_cast(unsigned, b); }
__device__ __forceinline__ unsigned pk_fp8x4(float a, float b, float c, float d) { int w = 0; w = __builtin_amdgcn_cvt_pk_fp8_f32(a, b, w, false); w = __builtin_amdgcn_cvt_pk_fp8_f32(c, d, w, true); return (unsigned)w; }
__device__ __forceinline__ float bf2f(unsigned short b) { return __uint_as_float(((unsigned)b) << 16); }
__device__ __forceinline__ float bflo(unsigned w) { return __uint_as_float(w << 16); }
__device__ __forceinline__ float bfhi(unsigned w) { return __uint_as_float(w & 0xffff0000u); }
__device__ __forceinline__ float fast_exp(float x) { return __builtin_amdgcn_exp2f(x * 1.44269504089f); }
__device__ __forceinline__ float sigmoidf_(float x) { return __builtin_amdgcn_rcpf(1.0f + fast_exp(-x)); }
__device__ __forceinline__ unsigned pk_gate4(float a, float b, float c, float d) {
    unsigned r = __builtin_amdgcn_cvt_pk_u8_f32(a * 255.0f, 0u, 0u); r = __builtin_amdgcn_cvt_pk_u8_f32(b * 255.0f, 1u, r); r = __builtin_amdgcn_cvt_pk_u8_f32(c * 255.0f, 2u, r); return __builtin_amdgcn_cvt_pk_u8_f32(d * 255.0f, 3u, r); }
__device__ __forceinline__ float wave_sum(float v) {
#pragma unroll
    for (int o = 1; o < 64; o <<= 1) v += __shfl_xor(v, o);
    return v;
}
__device__ __forceinline__ float wave_max(float v) {
#pragma unroll
    for (int o = 1; o < 64; o <<= 1) v = fmaxf(v, __shfl_xor(v, o));
    return v;
}

namespace pg8 {
constexpr int BM = 256, BK = 64, HALF = 128, HTB = HALF * BK * 2, STAGE_BYTES = 8 * HTB;
__host__ __device__ __forceinline__ int lds_byte(int r, int c) { const int st = (r >> 4) * 2 + (c >> 5), rr = r & 15, cc = c & 31, ob = rr * 64 + cc * 2; return st * 1024 + (ob ^ (((ob >> 9) & 1) << 5)); }
__host__ __device__ __forceinline__ void stage_rc(int b, int& R, int& C) { const int st = b / 1024, sb = b % 1024, swz = sb ^ (((sb >> 9) & 1) << 5); R = (st >> 1) * 16 + swz / 64; C = (st & 1) * 32 + (swz % 64) / 2; }
__host__ __device__ __forceinline__ int perm32(int rho) { const int n = rho >> 4, i = rho & 15; return 8 * (i >> 2) + 4 * n + (i & 3); }
struct Unit { int pm, pn, z; };

template <class P, class = void> struct adj_trait { static constexpr bool v = false; };
template <class P> struct adj_trait<P, decltype((void)P::ADJ)> { static constexpr bool v = P::ADJ; };
template <class P> __host__ __device__ constexpr bool adj_b() { return adj_trait<P>::v; }
template <class P, bool TAIL = false>
__device__ __forceinline__ void gemm_phase(LAS unsigned char* lds, const P& p, const int tid, const unsigned char* wsbase) {
    const __amdgpu_buffer_rsrc_t rsrc = __builtin_amdgcn_make_buffer_rsrc((void*)wsbase, 0, 0xffffffffu, 0x00020000);
    const int wid = __builtin_amdgcn_readfirstlane(tid >> 6), lane = tid & 63, wr = wid >> 2, wc = wid & 3, fr = lane & 15, fq = lane >> 4;
    constexpr int ESZ = P::ESZ;
    const int K = p.K, nt = K * ESZ / 128, lda = p.lda, ldb = p.ldb;
    unsigned voffA[2], voffB[2]; int Rr[2], Cc[2];
#pragma unroll
    for (int i = 0; i < 2; ++i) { int R, C; stage_rc(tid * 16 + i * 8192, R, C); Rr[i] = R; Cc[i] = C; const int Rb = adj_b<P>() ? (64 * (R >> 5) + perm32(R & 31)) : (P::PERM ? ((R & ~31) + perm32(R & 31)) : R);
        voffA[i] = (unsigned)(R * lda * ESZ + C * 2); voffB[i] = (unsigned)(Rb * ldb * ESZ + C * 2); }
    const unsigned kstep = (unsigned)(BK * 2);
    const unsigned hstepA = (unsigned)(HALF * lda * ESZ), hstepB = (unsigned)((adj_b<P>() ? 32 : HALF) * ldb * ESZ);
    const unsigned ldsw0 = (unsigned)wid * 1024u; const unsigned ldsw = ldsw0;
    const int aoff = lds_byte(wr * 64 + fr, fq * 8), boff = lds_byte(wc * 32 + fr, fq * 8);
    auto opaque_tid = [&]() { int t_ = tid; asm volatile("" : "+v"(t_)); return t_; };
    unsigned vc[2][2];
#define PG8_SA(b, h) (((b) * 2 + (h)) * HTB)
#define PG8_SB(b, h) ((4 + (b) * 2 + (h)) * HTB)
#define PG8_GLDS(so, vo, ldsoff) __builtin_amdgcn_raw_ptr_buffer_load_lds(rsrc, (LAS void*)(lds + (ldsoff)), 16, (int)(vo), (int)(so), 0, 0)
#define PG8_STAGE_B(bufoff, gb) do { PG8_GLDS((gb), voffB[0], (bufoff) + ldsw); PG8_GLDS((gb), voffB[1], (bufoff) + ldsw + 8192); } while (0)
#define PG8_STAGE_A(bufoff, ga, h, NX) do { if constexpr (P::GATHER) { PG8_GLDS((ga), vc[h][0], (bufoff) + ldsw); PG8_GLDS((ga), vc[h][1], (bufoff) + ldsw + 8192); } \
        else { PG8_GLDS((ga) + (h) * hstepA, voffA[0], (bufoff) + ldsw); PG8_GLDS((ga) + (h) * hstepA, voffA[1], (bufoff) + ldsw + 8192); } } while (0)
#define PG8_LDA(dst, b, h) do { if constexpr (TAIL) { if ((h) == 1 || wr == 1) break; } _Pragma("unroll") for (int m = 0; m < 4; ++m) _Pragma("unroll") for (int k = 0; k < 2; ++k) dst[m][k] = *(const LAS bf16x8*)(lds + PG8_SA(b, h) + aoff + m * 2048 + k * 1024); } while (0)
#define PG8_LDB(dst, b, h) do { if constexpr (TAIL) { if (wr == 1) break; } _Pragma("unroll") for (int n = 0; n < 2; ++n) _Pragma("unroll") for (int k = 0; k < 2; ++k) dst[n][k] = *(const LAS bf16x8*)(lds + PG8_SB(b, h) + boff + n * 2048 + k * 1024); } while (0)
#define PG8_MMA(ai, bj, At, Bt) do { if constexpr (TAIL) { if ((ai) == 1 || wr == 1) break; } __builtin_amdgcn_s_setprio(1); _Pragma("unroll") for (int m = 0; m < 4; ++m) _Pragma("unroll") for (int n = 0; n < 2; ++n) { \
        if constexpr (ESZ == 2) { _Pragma("unroll") for (int k = 0; k < 2; ++k) acc[ai][bj][m][n] = __builtin_amdgcn_mfma_f32_16x16x32_bf16(Bt[n][k], At[m][k], acc[ai][bj][m][n], 0, 0, 0); } \
        else { const i32x8 b8_ = __builtin_shufflevector(__builtin_bit_cast(i32x4, Bt[n][0]), __builtin_bit_cast(i32x4, Bt[n][1]), 0, 1, 2, 3, 4, 5, 6, 7), a8_ = __builtin_shufflevector(__builtin_bit_cast(i32x4, At[m][0]), __builtin_bit_cast(i32x4, At[m][1]), 0, 1, 2, 3, 4, 5, 6, 7); \
               asm volatile("v_mfma_f32_16x16x128_f8f6f4 %0, %1, %2, %0" : "+v"(acc[ai][bj][m][n]) : "v"(b8_), "v"(a8_)); } } \
        __builtin_amdgcn_s_setprio(0); } while (0)
#define PG8_WAIT_V(n) asm volatile("s_waitcnt vmcnt(" #n ")" ::: "memory")
#define PG8_WAIT_L(n) asm volatile("s_waitcnt lgkmcnt(" #n ")" ::: "memory")
#define PG8_BAR __builtin_amdgcn_s_barrier()
#define PG8_SCHED __builtin_amdgcn_sched_barrier(0)
#define PG8_ROWOFFS(dst, u) do { _Pragma("unroll") for (int i_ = 0; i_ < 2; ++i_) { int R_, C_; stage_rc(opaque_tid() * 16 + i_ * 8192, R_, C_); _Pragma("unroll") for (int h_ = 0; h_ < 2; ++h_) dst[h_][i_] = (unsigned)(p.a_row(u, h_ * HALF + R_) * lda * ESZ + C_ * 2); } } while (0)
    Unit cur, nxt; int ui = 0;
    if (!p.next(0, cur)) return;
    f32x4 acc[2][2][4][2];
#pragma unroll
    for (int a = 0; a < 2; ++a)
#pragma unroll
        for (int b = 0; b < 2; ++b)
#pragma unroll
            for (int m = 0; m < 4; ++m)
#pragma unroll
                for (int n = 0; n < 2; ++n) acc[a][b][m][n] = (f32x4){0.f, 0.f, 0.f, 0.f};
    bf16x8 At[4][2], B0[2][2], B1[2][2];
    unsigned cA = (unsigned)((const unsigned char*)p.a_ptr(cur) - wsbase), cB = (unsigned)((const unsigned char*)p.b_ptr(cur) - wsbase);
    if constexpr (P::GATHER) { PG8_ROWOFFS(vc, cur); }
    PG8_STAGE_B(PG8_SB(0, 0), cB); PG8_STAGE_B(PG8_SB(0, 1), cB + hstepB); PG8_STAGE_A(PG8_SA(0, 0), cA, 0, false); PG8_STAGE_A(PG8_SA(0, 1), cA, 1, false);
    if (wr == 1) PG8_BAR;
    PG8_WAIT_V(2); PG8_BAR;
    PG8_STAGE_B(PG8_SB(1, 0), cB + kstep); PG8_STAGE_A(PG8_SA(1, 0), cA + kstep, 0, false); PG8_STAGE_B(PG8_SB(1, 1), cB + hstepB + kstep);
    PG8_WAIT_V(6); PG8_BAR;
    for (;;) {
        const bool has_next = p.next(ui + 1, nxt);
        const unsigned nA = has_next ? (unsigned)((const unsigned char*)p.a_ptr(nxt) - wsbase) : cA, nB = has_next ? (unsigned)((const unsigned char*)p.b_ptr(nxt) - wsbase) : cB;
        for (int t = 0; t < nt; t += 2) {
            const bool last = (t == nt - 2);
            unsigned ldsw = ldsw0; asm volatile("" : "+s"(ldsw));
            const unsigned a1 = cA + (unsigned)(t + 1) * kstep;
            const unsigned a2 = last ? nA : cA + (unsigned)(t + 2) * kstep, b2 = last ? nB : cB + (unsigned)(t + 2) * kstep;
            const unsigned a3 = a2 + kstep, b3 = b2 + kstep;
            unsigned vt[2][2];
            if constexpr (P::GATHER) { if (last && has_next) { PG8_ROWOFFS(vt, nxt); } }
            PG8_LDB(B0, 0, 0); PG8_LDB(B1, 0, 1); PG8_SCHED; PG8_LDA(At, 0, 0); PG8_STAGE_A(PG8_SA(1, 1), a1, 1, false);
            PG8_WAIT_V(8); PG8_WAIT_L(0); PG8_BAR; PG8_MMA(0, 0, At, B0); PG8_MMA(0, 1, At, B1); PG8_BAR; PG8_SCHED;
            if constexpr (P::GATHER) { if (last && has_next) {
#pragma unroll
                for (int h = 0; h < 2; ++h) { vc[h][0] = vt[h][0]; vc[h][1] = vt[h][1]; } } }
            PG8_LDA(At, 0, 1); PG8_STAGE_B(PG8_SB(0, 0), b2); PG8_STAGE_B(PG8_SB(0, 1), b2 + hstepB); PG8_STAGE_A(PG8_SA(0, 0), a2, 0, last);
            PG8_WAIT_V(8); PG8_WAIT_L(0); PG8_BAR; PG8_MMA(1, 0, At, B0); PG8_MMA(1, 1, At, B1); PG8_BAR; PG8_SCHED;
            PG8_LDB(B0, 1, 0); PG8_LDB(B1, 1, 1); PG8_SCHED; PG8_LDA(At, 1, 0); PG8_STAGE_A(PG8_SA(0, 1), a2, 1, last);
            PG8_WAIT_V(8); PG8_WAIT_L(0); PG8_BAR; PG8_MMA(0, 0, At, B0); PG8_MMA(0, 1, At, B1); PG8_BAR; PG8_SCHED;
            PG8_LDA(At, 1, 1); PG8_STAGE_B(PG8_SB(1, 0), b3); PG8_STAGE_B(PG8_SB(1, 1), b3 + hstepB); PG8_STAGE_A(PG8_SA(1, 0), a3, 0, last);
            PG8_WAIT_V(8); PG8_WAIT_L(0); PG8_BAR; PG8_MMA(1, 0, At, B0); PG8_MMA(1, 1, At, B1); PG8_BAR; PG8_SCHED;
        }
        if constexpr (ESZ == 1) asm volatile("s_nop 15\n\ts_nop 15" ::: "memory");
        if (wr == 0) PG8_BAR;
        bool zero;
        { int t2 = tid; asm volatile("" : "+v"(t2));
          const int l2 = t2 & 63, w2 = __builtin_amdgcn_readfirstlane(t2 >> 6); zero = p.template epi<TAIL>(acc, cur, w2 >> 2, w2 & 3, l2 & 15, l2 >> 4); }
        if (!has_next) break;
        if (zero) {
#pragma unroll
            for (int a = 0; a < 2; ++a)
#pragma unroll
                for (int b = 0; b < 2; ++b)
#pragma unroll
                    for (int m = 0; m < 4; ++m)
#pragma unroll
                        for (int n = 0; n < 2; ++n) acc[a][b][m][n] = (f32x4){0.f, 0.f, 0.f, 0.f};
        }
        cur = nxt; cA = nA; cB = nB; ++ui;
        if (wr == 1) PG8_BAR;
    }
    PG8_WAIT_V(0);
    PG8_BAR;
#undef PG8_SA
#undef PG8_SB
#undef PG8_GLDS
#undef PG8_STAGE_A
#undef PG8_STAGE_B
#undef PG8_LDA
#undef PG8_LDB
#undef PG8_MMA
#undef PG8_WAIT_V
#undef PG8_WAIT_L
#undef PG8_BAR
#undef PG8_SCHED
#undef PG8_ROWOFFS
}
}

#define XB_TMO      128
#define XB_XCNT(j)  (256  + 64 * (j))
#define XB_XSUB(j)  (1280 + 64 * (j))
#define XB_XGEN(j)  (2304 + 64 * (j))
#define XB_TOP      3328
#define XB_TOPGEN   3392
#define XCD_BAR_WORDS 3456
#define XB_SPIN_CAP (1u << 18)
__device__ __forceinline__ unsigned xb_ld(unsigned* p)              { return __hip_atomic_load(p, __ATOMIC_RELAXED, __HIP_MEMORY_SCOPE_AGENT); }
__device__ __forceinline__ unsigned xb_add(unsigned* p, unsigned v) { return __hip_atomic_fetch_add(p, v, __ATOMIC_RELAXED, __HIP_MEMORY_SCOPE_AGENT); }
__device__ __forceinline__ unsigned xb_xcc_id() { return (unsigned)__builtin_amdgcn_s_getreg((3 << 11) | 20) & 0xFu; }
#define XB_SPIN(cond, bar) do { unsigned _sp = 0; while (cond) { __builtin_amdgcn_s_sleep(1); \
    if ((++_sp & 255u) == 0u) { if (xb_ld(&(bar)[XB_TMO])) break; if (_sp > XB_SPIN_CAP) { atomicAdd(&(bar)[XB_TMO], 1u); break; } } } } while (0)
struct XcdBarrier { unsigned* bar; unsigned x; volatile LAS unsigned* st; };
__device__ __forceinline__ XcdBarrier xcd_barrier_post(unsigned* bar, volatile LAS unsigned* st) {
    XcdBarrier b; b.bar = bar; b.x = xb_xcc_id(); b.st = st;
    if (threadIdx.x == 0) (void)xb_add(&bar[XB_XCNT(b.x)], 1u);
    return b;
}
__device__ __forceinline__ void xcd_barrier_complete(unsigned* bar, unsigned x, unsigned& nloc, unsigned& nx) {
    const unsigned G = gridDim.x * gridDim.y * gridDim.z;
    unsigned sum, cnt, mine, sp = 0u;
    for (;;) {
        sum = 0u; cnt = 0u; mine = 0u;
#pragma unroll
        for (unsigned j = 0; j < 16; ++j) { const unsigned c = xb_ld(&bar[XB_XCNT(j)]); sum += c; cnt += (c > 0u) ? 1u : 0u; mine = (j == x) ? c : mine; }
        if (sum == G) break;
        __builtin_amdgcn_s_sleep(1);
        if ((++sp & 255u) == 0u) { if (xb_ld(&bar[XB_TMO])) break; if (sp > XB_SPIN_CAP) { atomicAdd(&bar[XB_TMO], 1u); break; } }
    }
    nloc = mine > 0u ? mine : 1u; nx = cnt > 0u ? cnt : 1u;
}
__device__ __forceinline__ void xcd_barrier(const XcdBarrier& b) {
    asm volatile("s_waitcnt vmcnt(0)" ::: "memory");
    __syncthreads();
    if (threadIdx.x == 0) {
        unsigned* bar = b.bar;
        __builtin_amdgcn_s_waitcnt(0);
        unsigned nloc = b.st[0], nx = b.st[1];
        if (nloc == 0u) { xcd_barrier_complete(bar, b.x, nloc, nx); b.st[0] = nloc; b.st[1] = nx; }
        const unsigned old = xb_add(&bar[XB_XSUB(b.x)], 1u);
        const unsigned gen = old / nloc;
        if (old + 1u == (gen + 1u) * nloc) {
            __builtin_amdgcn_fence(__ATOMIC_RELEASE, "agent");
            asm volatile("s_waitcnt vmcnt(0)" ::: "memory");
            const unsigned og = xb_add(&bar[XB_TOP], 1u);
            const unsigned tg = og / nx;
            if (og + 1u == (tg + 1u) * nx) xb_add(&bar[XB_TOPGEN], 1u);
            else XB_SPIN(xb_ld(&bar[XB_TOPGEN]) == tg, bar);
            __builtin_amdgcn_fence(__ATOMIC_ACQUIRE, "agent");
            xb_add(&bar[XB_XGEN(b.x)], 1u);
            asm volatile("s_waitcnt vmcnt(0)" ::: "memory");
        } else {
            XB_SPIN(xb_ld(&bar[XB_XGEN(b.x)]) == gen, bar);
            __builtin_amdgcn_fence(__ATOMIC_ACQUIRE, "agent");
            asm volatile("s_waitcnt vmcnt(0)" ::: "memory");
        }
    }
    __syncthreads();
}

struct Args { const float* in[30]; float* out; unsigned char* ws; int ph_lo, ph_hi; };
enum { I_X = 0, I_META, I_LNE_G, I_LNE_B, I_WIN, I_POOLW, I_POOLS, I_SINK, I_CONVW, I_CONVB, I_WA, I_BA, I_WX, I_BX, I_LAM, I_PPOOL, I_PATTN, I_PLRU, I_WOUT,
       I_LN1G, I_LN1B, I_RGW, I_RGB, I_REW, I_REB, I_EG, I_EU, I_ED, I_LN2G, I_LN2B };

struct Frame {
    LAS unsigned char* lds;
    const float* const* inp; float* out; unsigned char* ws;
    int tid, lane, wave, vcu, G, z;
    __device__ __forceinline__ const float* I(int k) const { return inp[k + z]; }
};
__device__ __forceinline__ int opaque_s(int x) { asm volatile("" : "+s"(x)); return x; }
__device__ __forceinline__ int opaque_v(int x) { asm volatile("" : "+v"(x)); return x; }

__device__ __forceinline__ void transpose_item(const float* W, int ldw, int k0, int n0, bf16* WT, int ldt, int drow0, LAS float* scr, int lane) {
    f32x4 v[8]; const int kr = lane >> 3, nq = (lane & 7) * 4;
#pragma unroll
    for (int i = 0; i < 8; ++i) v[i] = __builtin_nontemporal_load((const f32x4*)(W + (size_t)(k0 + 8 * i + kr) * ldw + n0 + nq));
#pragma unroll
    for (int i = 0; i < 8; ++i) { LAS float* d = scr + (8 * i + kr) * 33 + nq; d[0] = v[i][0]; d[1] = v[i][1]; d[2] = v[i][2]; d[3] = v[i][3]; }
    LDS_WAIT();
    const int c = lane & 7;
#pragma unroll
    for (int j = 0; j < 4; ++j) { const int n = (lane >> 3) + 8 * j; const LAS float* s = scr + (8 * c) * 33 + n;
        u32x4 o; o.x = pk_bf16(s[0 * 33], s[1 * 33]); o.y = pk_bf16(s[2 * 33], s[3 * 33]); o.z = pk_bf16(s[4 * 33], s[5 * 33]); o.w = pk_bf16(s[6 * 33], s[7 * 33]);
        *(u32x4*)(WT + (size_t)(drow0 + n) * ldt + k0 + 8 * c) = o; }
    LDS_WAIT();
}

__device__ __forceinline__ void transpose_item8(const float* W, int ldw, int k0, int n0, unsigned char* WT, int ldt, int drow0, float scale, LAS float* scr, int lane) {
    f32x4 v[8]; const int kr = lane >> 3, nq = (lane & 7) * 4;
#pragma unroll
    for (int i = 0; i < 8; ++i) v[i] = __builtin_nontemporal_load((const f32x4*)(W + (size_t)(k0 + 8 * i + kr) * ldw + n0 + nq));
#pragma unroll
    for (int i = 0; i < 8; ++i) { LAS float* d = scr + (8 * i + kr) * 33 + nq; d[0] = v[i][0]; d[1] = v[i][1]; d[2] = v[i][2]; d[3] = v[i][3]; }
    LDS_WAIT();
    const int c = lane & 3;
#pragma unroll
    for (int j = 0; j < 2; ++j) { const int n = (lane >> 2) + 16 * j; const LAS float* s = scr + (16 * c) * 33 + n;
        u32x4 o; o.x = pk_fp8x4(s[0 * 33] * scale, s[1 * 33] * scale, s[2 * 33] * scale, s[3 * 33] * scale); o.y = pk_fp8x4(s[4 * 33] * scale, s[5 * 33] * scale, s[6 * 33] * scale, s[7 * 33] * scale);
        o.z = pk_fp8x4(s[8 * 33] * scale, s[9 * 33] * scale, s[10 * 33] * scale, s[11 * 33] * scale); o.w = pk_fp8x4(s[12 * 33] * scale, s[13 * 33] * scale, s[14 * 33] * scale, s[15 * 33] * scale);
        *(u32x4*)(WT + (size_t)(drow0 + n) * ldt + k0 + 16 * c) = o; }
    LDS_WAIT();
}

__device__ __forceinline__ void ln_regs(f32x4 (&v)[8], const float* g, const float* b, int lane) {
    float s = 0.f;
#pragma unroll
    for (int j = 0; j < 8; ++j) s += (v[j].x + v[j].y) + (v[j].z + v[j].w);
    const float mean = wave_sum(s) * (1.f / D); float s2 = 0.f;
#pragma unroll
    for (int j = 0; j < 8; ++j) { v[j] = v[j] - mean; s2 += (v[j].x * v[j].x + v[j].y * v[j].y) + (v[j].z * v[j].z + v[j].w * v[j].w); }
    const float rstd = 1.f / sqrtf(wave_sum(s2) * (1.f / D) + LN_EPS);
#pragma unroll
    for (int j = 0; j < 8; ++j) { const f32x4 gg = *(const f32x4*)(g + 4 * lane + 256 * j), bb = *(const f32x4*)(b + 4 * lane + 256 * j); v[j] = v[j] * rstd * gg + bb; }
}
__device__ __forceinline__ void ln_regs_lds(f32x4 (&v)[8], const LAS float* g, const LAS float* b, int lane) {
    float s = 0.f;
#pragma unroll
    for (int j = 0; j < 8; ++j) s += (v[j].x + v[j].y) + (v[j].z + v[j].w);
    const float mean = wave_sum(s) * (1.f / D); float s2 = 0.f;
#pragma unroll
    for (int j = 0; j < 8; ++j) { v[j] = v[j] - mean; s2 += (v[j].x * v[j].x + v[j].y * v[j].y) + (v[j].z * v[j].z + v[j].w * v[j].w); }
    const float rstd = 1.f / sqrtf(wave_sum(s2) * (1.f / D) + LN_EPS);
#pragma unroll
    for (int j = 0; j < 8; ++j) { const f32x4 gg = *(const LAS f32x4*)(g + 4 * lane + 256 * j), bb = *(const LAS f32x4*)(b + 4 * lane + 256 * j); v[j] = v[j] * rstd * gg + bb; }
}
__device__ __forceinline__ void store_row_bf16(bf16* orow, const f32x4 (&v)[8], int lane) {
#pragma unroll
    for (int j = 0; j < 8; ++j) { u32x2 w; w.x = pk_bf16(v[j].x, v[j].y); w.y = pk_bf16(v[j].z, v[j].w); *(u32x2*)(orow + 4 * lane + 256 * j) = w; }
}
__device__ __forceinline__ void store_row_fp8(unsigned char* orow, const f32x4 (&v)[8], int lane) {
#pragma unroll
    for (int j = 0; j < 8; ++j) *(unsigned*)(orow + 4 * lane + 256 * j) = pk_fp8x4(v[j].x, v[j].y, v[j].z, v[j].w);
}
__device__ __forceinline__ void store_row_f32(float* orow, const f32x4 (&v)[8], int lane) {
#pragma unroll
    for (int j = 0; j < 8; ++j) *(f32x4*)(orow + 4 * lane + 256 * j) = v[j];
}
__device__ __forceinline__ void load_row_f32(const float* row, f32x4 (&v)[8], int lane) {
#pragma unroll
    for (int j = 0; j < 8; ++j) v[j] = *(const f32x4*)(row + 4 * lane + 256 * j);
}

__device__ __forceinline__ void conv_small_weights(Frame& F, int l, int it, LAS float* scr) {
    bf16* wl = (bf16*)(F.ws + WS_WSMALL + (size_t)l * WL_BYTES);
    int r = it;
    if (r < 10752) { const int kb = r / 336, nb = r % 336;
        if (nb < CW / 32) { const int t = nb >> 3;
            if (!((A8_MASK >> t) & 1u)) transpose_item(F.I(I_WIN) + (size_t)l * D * INC, INC, 64 * kb, 32 * nb, (bf16*)((char*)wl + WL_WIN), D, __builtin_popcount(~A8_MASK & ((1u << t) - 1u)) * 256 + (nb & 7) * 32, scr, F.lane);
            else { const int ct = __builtin_popcount(A8_MASK & ((1u << t) - 1u)); transpose_item8(F.I(I_WIN) + (size_t)l * D * INC, INC, 64 * kb, 32 * nb, (unsigned char*)wl + WL_WIN8, D, GW + ct * 256 + (nb & 7) * 32, W8_SCALE, scr, F.lane); } }
        else transpose_item8(F.I(I_WIN) + (size_t)l * D * INC, INC, 64 * kb, 32 * nb, (unsigned char*)wl + WL_WIN8, D, 32 * nb - CW, W8_SCALE, scr, F.lane);
        return; } r -= 10752;
    if (r < 3072) { const int pi = r / 1024, q = r % 1024, kb = q / 64, nb = q % 64;
        transpose_item(F.I(I_PPOOL + pi) + (size_t)l * 1024 * D, D, 64 * kb, 32 * nb, (bf16*)((char*)wl + WL_PROJ) + (size_t)pi * D * 1024, 1024, 32 * nb, scr, F.lane); return; } r -= 3072;
    if (r < 2048) { const int kb = r / 64, nb = r % 64; transpose_item(F.I(I_WOUT) + (size_t)l * D * D, D, 64 * kb, 32 * nb, (bf16*)((char*)wl + WL_WOUT), D, 32 * nb, scr, F.lane); return; } r -= 2048;
    if (r < 128) { const int g = r / 32, q = r % 32, kb = q / 8, nb = q % 8;
        transpose_item(F.I(I_POOLW) + ((size_t)l * 4 + g) * 65536, 256, 64 * kb, 32 * nb, (bf16*)((char*)wl + WL_POOL) + (size_t)g * 65536, 256, 32 * nb, scr, F.lane); return; } r -= 128;
    { const int which = r / 128, q0 = r % 128, blk = q0 / 32, q = q0 % 32, kb = q / 8, nb = q % 8, n0 = 32 * nb;
        const int drow0 = (blk * 2 + (n0 >> 7)) * 256 + 64 * ((n0 & 127) >> 5) + 32 * which;
        transpose_item(F.I(which ? I_WX : I_WA) + ((size_t)l * 4 + blk) * 65536, 256, 64 * kb, n0, (bf16*)((char*)wl + WL_LRU), 256, drow0, scr, F.lane); }
}
__device__ __forceinline__ void conv_expert_weights(Frame& F, int l, int it, LAS float* scr) {
    unsigned char* gu = F.ws + WS_R2 + EXPW_GU; unsigned char* wd = F.ws + WS_R2 + EXPW_WD;
    const int e = it / 1536, r = it % 1536;
    if (r < 1024) { const int which = r / 512, q = r % 512, kb = q / 16, nb = q % 16, n0 = 32 * nb;
        const int drow0 = (e * 4 + (n0 >> 7)) * 256 + which * 128 + (n0 & 127);
        transpose_item8(F.I(which ? I_EU : I_EG) + ((size_t)l * NEXP + e) * D * DE, DE, 64 * kb, n0, gu, D, drow0, W8_SCALE, scr, F.lane); }
    else { const int q = r - 1024, kb = q / 64, nb = q % 64;
        transpose_item8(F.I(I_ED) + ((size_t)l * NEXP + e) * DE * D, D, 64 * kb, 32 * nb, wd, DE, e * D + 32 * nb, W8_SCALE, scr, F.lane); }
}
__device__ __forceinline__ void p0_prologue(Frame& F) {
    LAS float* scr = (LAS float*)(F.lds + F.wave * 16384);
    const int gw = F.vcu * 8 + F.wave, NGW = F.G * 8;
    for (int it = gw; it < 2 * 16256; it += NGW) conv_small_weights(F, it / 16256, it % 16256, scr);
    float* H = (float*)(F.ws + WS_H); bf16* HB = (bf16*)(F.ws + WS_HB);
    for (int n = gw; n < MP; n += NGW) {
        if (n < NTOK) { const int b = n / LSEQ, t = n % LSEQ; const float* src = t < NMETA ? F.I(I_META) + (size_t)t * D : F.I(I_X) + ((size_t)b * SEQ + (t - NMETA)) * D;
            f32x4 v[8]; load_row_f32(src, v, F.lane); ln_regs(v, F.I(I_LNE_G), F.I(I_LNE_B), F.lane);
            store_row_f32(H + (size_t)n * D, v, F.lane); store_row_bf16(HB + (size_t)n * D, v, F.lane); store_row_fp8(F.ws + WS_HB8 + (size_t)n * D, v, F.lane); }
        else { f32x4 v[8];
#pragma unroll
            for (int j = 0; j < 8; ++j) v[j] = (f32x4){0.f, 0.f, 0.f, 0.f};
            store_row_f32(H + (size_t)n * D, v, F.lane); store_row_bf16(HB + (size_t)n * D, v, F.lane); store_row_fp8(F.ws + WS_HB8 + (size_t)n * D, v, F.lane); }
    }
    { bf16* wrt = (bf16*)(F.ws + WS_WRT);
      for (int i = F.vcu * 512 + F.tid; i < 2 * 48 * 2048; i += F.G * 512) { const int l = i / (48 * 2048), c = (i / 2048) % 48, k = i % 2048;
          const float w = c < 4 ? F.I(I_RGW)[((size_t)l * D + k) * 4 + c] : c < 36 ? F.I(I_REW)[((size_t)l * D + k) * 32 + (c - 4)] : 0.f;
          const unsigned hi = pk_bf16(w, 0.f) & 0xffffu; const float rem = w - __uint_as_float(hi << 16);
          wrt[((size_t)(l * 2 + 0) * 48 + c) * 2048 + k] = (bf16)hi; wrt[((size_t)(l * 2 + 1) * 48 + c) * 2048 + k] = (bf16)(pk_bf16(rem, 0.f) & 0xffffu); } }
    { bf16* wsc = (bf16*)(F.ws + WS_WSC);
      for (int i = F.vcu * 512 + F.tid; i < 2 * 4 * 65536; i += F.G * 512) { const int e = i & 255, lg = i >> 16;
          wsc[i] = (bf16)(pk_bf16(F.I(I_POOLW)[i] * F.I(I_POOLS)[(size_t)lg * 256 + e], 0.f) & 0xffffu); } }
    float* sp8 = (float*)(F.ws + WS_SP8);
    for (int i = F.vcu * 512 + F.tid; i < 2 * 1024; i += F.G * 512) { const float lam = F.I(I_LAM)[i]; sp8[i] = 8.0f * log1pf(expf(-lam)); }
}

using pg8::Unit;
__device__ __forceinline__ int xcd_order(int i, int G, int c, int NT) { if (G % (8 * NT)) return i * G + c; const int P = G / (8 * NT), x = c & 7, s = c >> 3; return i * G + (x * P + s / NT) * NT + (s % NT); }
constexpr int A8_NCT = __builtin_popcount(A8_MASK), A8_NN = 24 + A8_NCT, ABF_NN = 18 - A8_NCT;
constexpr int A_H = (NPANEL * ABF_NN) % 256, A_LIGHT = 256 - A_H, A_NF = NPANEL * A8_NN, A_X = (A_NF + 2 * A_H + 255) / 256;
__device__ __forceinline__ int nth_bit(unsigned m, int n) { for (int i = 0; i < n; ++i) m &= m - 1; return __builtin_ctz(m); }
template <bool GATE> struct PolA_ {
    static constexpr bool PERM = true, GATHER = false, ADJ = true; static constexpr int ESZ = GATE ? 1 : 2, NN = GATE ? A8_NN : ABF_NN;
    int K, lda, ldb; const unsigned char* A; const unsigned char* Bt; bf16* out; bf16* outc; int G, c;
    __device__ __forceinline__ bool next(int i, Unit& u) const { int L;
        if (GATE && G == 256) {
            if (i < A_X - 2) L = i * 256 + c; else if (i < A_X) { if (c >= A_LIGHT) return false; L = (A_X - 2) * 256 + (i - (A_X - 2)) * A_LIGHT + c; if (L >= A_NF) return false; } else return false;
        } else { L = i * G + c; if (L >= NPANEL * NN) return false; }
        const int nwg = NPANEL * NN, q = nwg / 8, r = nwg % 8, xcd = L % 8, off = L / 8; const int w = (xcd < r ? xcd * (q + 1) : r * (q + 1) + (xcd - r) * q) + off;
        const int nig = 8 * NN, gid = w / nig, fm = gid * 8, gsz = (NPANEL - fm) < 8 ? (NPANEL - fm) : 8;
        u.pm = fm + ((w % nig) % gsz); u.pn = (w % nig) / gsz; u.z = 0; return true; }
    __device__ __forceinline__ const char* a_ptr(const Unit& u) const { return (const char*)(A + (size_t)u.pm * 256 * lda * ESZ); }
    __device__ __forceinline__ const char* b_ptr(const Unit& u) const { return (const char*)(Bt + (size_t)u.pn * 256 * ldb * ESZ); }
    __device__ __forceinline__ int a_row(const Unit&, int) const { return 0; }
    template <bool T1> __device__ __forceinline__ bool epi(f32x4 (&acc)[2][2][4][2], const Unit& u, int wr, int wc, int fr, int fq) const {
        const int row0 = u.pm * 256 + wr * 64 + fr;
        if constexpr (!GATE) {
            const int tile = nth_bit(~A8_MASK & 0x3FFFFu, u.pn); const float sc = (tile >= 4 && tile < 8) ? 0.125f : 1.0f;
            bf16* base = out + (size_t)row0 * CW + tile * 256 + wc * 64 + 8 * fq;
#pragma unroll
            for (int ai = 0; ai < 2; ++ai)
#pragma unroll
                for (int m = 0; m < 4; ++m)
#pragma unroll
                    for (int bj = 0; bj < 2; ++bj) { const f32x4 v0 = acc[ai][bj][m][0] * sc, v1 = acc[ai][bj][m][1] * sc;
                        u32x4 w; w.x = pk_bf16(v0[0], v0[1]); w.y = pk_bf16(v0[2], v0[3]); w.z = pk_bf16(v1[0], v1[1]); w.w = pk_bf16(v1[2], v1[3]);
                        *(u32x4*)(base + (size_t)(ai * 128 + m * 16) * CW + bj * 32) = w; }
        } else if (u.pn < 24) {
            unsigned char* base = (unsigned char*)out + (size_t)row0 * GW + u.pn * 256 + wc * 64 + 8 * fq;
#pragma unroll
            for (int ai = 0; ai < 2; ++ai)
#pragma unroll
                for (int m = 0; m < 4; ++m)
#pragma unroll
                    for (int bj = 0; bj < 2; ++bj) { const f32x4 a0 = acc[ai][bj][m][0] * (1.0f / W8_SCALE), a1 = acc[ai][bj][m][1] * (1.0f / W8_SCALE);
                        u32x2 w; w.x = pk_gate4(sigmoidf_(a0[0]), sigmoidf_(a0[1]), sigmoidf_(a0[2]), sigmoidf_(a0[3])); w.y = pk_gate4(sigmoidf_(a1[0]), sigmoidf_(a1[1]), sigmoidf_(a1[2]), sigmoidf_(a1[3]));
                        *(u32x2*)(base + (size_t)(ai * 128 + m * 16) * GW + bj * 32) = w; }
        } else {
            const int tile = nth_bit(A8_MASK, u.pn - 24); const float sc = ((tile >= 4 && tile < 8) ? 0.125f : 1.0f) * (1.0f / W8_SCALE);
            bf16* base = outc + (size_t)row0 * CW + tile * 256 + wc * 64 + 8 * fq;
#pragma unroll
            for (int ai = 0; ai < 2; ++ai)
#pragma unroll
                for (int m = 0; m < 4; ++m)
#pragma unroll
                    for (int bj = 0; bj < 2; ++bj) { const f32x4 v0 = acc[ai][bj][m][0] * sc, v1 = acc[ai][bj][m][1] * sc;
                        u32x4 w; w.x = pk_bf16(v0[0], v0[1]); w.y = pk_bf16(v0[2], v0[3]); w.z = pk_bf16(v1[0], v1[1]); w.w = pk_bf16(v1[2], v1[3]);
                        *(u32x4*)(base + (size_t)(ai * 128 + m * 16) * CW + bj * 32) = w; }
        }
        return true;
    }
};
__device__ __forceinline__ void unpack8(const u32x4 v, float (&f)[8]);
struct PolW {
    static constexpr bool PERM = true, GATHER = false, ADJ = true; static constexpr int ESZ = 2;
    int K, lda, ldb; const bf16* pt; const bf16* wsc; bf16* wct; int G, c;
    __device__ __forceinline__ bool next(int i, Unit& u) const { const int L = i * G + c; if (L >= 32) return false; u.pm = L >> 2; u.pn = L & 3; u.z = 0; return true; }
    __device__ __forceinline__ const char* a_ptr(const Unit& u) const { return (const char*)(pt + (size_t)u.pm * 256 * 1024 + u.pn * 256); }
    __device__ __forceinline__ const char* b_ptr(const Unit& u) const { return (const char*)(wsc + (size_t)u.pn * 65536); }
    __device__ __forceinline__ int a_row(const Unit&, int) const { return 0; }
    template <bool T1> __device__ __forceinline__ bool epi(f32x4 (&acc)[2][2][4][2], const Unit& u, int wr, int wc, int fr, int fq) const {
        bf16* base = wct + (size_t)(u.pm * 256 + wr * 64 + fr) * 1024 + u.pn * 256 + wc * 64 + 8 * fq;
#pragma unroll
        for (int ai = 0; ai < 2; ++ai)
#pragma unroll
            for (int m = 0; m < 4; ++m)
#pragma unroll
                for (int bj = 0; bj < 2; ++bj) { const f32x4 v0 = acc[ai][bj][m][0], v1 = acc[ai][bj][m][1];
                    u32x4 w; w.x = pk_bf16(v0[0], v0[1]); w.y = pk_bf16(v0[2], v0[3]); w.z = pk_bf16(v1[0], v1[1]); w.w = pk_bf16(v1[2], v1[3]);
                    *(u32x4*)(base + (size_t)(ai * 128 + m * 16) * 1024 + bj * 32) = w; }
        return true;
    }
};
struct PolC {
    static constexpr bool PERM = true, GATHER = false, ADJ = true; static constexpr int ESZ = 2;
    int K, lda, ldb; const bf16* delta; const bf16* xc; const bf16* pool_t; const bf16* lru_t; bf16* mix; bf16* Abuf; bf16* Bbuf;
    const float* pool_scale; const float* ba; const float* bx; const float* sp8; int G, c;
    __device__ __forceinline__ bool next(int i, Unit& u) const { const int L = i * G + c; if (L >= 64 * 8) return false; u.pm = L >> 3; u.pn = 4 + (L & 7); u.z = 0; return true; }
    __device__ __forceinline__ const char* a_ptr(const Unit& u) const { return u.pn < 4 ? (const char*)(delta + (size_t)u.pm * 256 * 1024 + u.pn * 256) : (const char*)(xc + (size_t)u.pm * 256 * 1024 + ((u.pn - 4) >> 1) * 256); }
    __device__ __forceinline__ const char* b_ptr(const Unit& u) const { return u.pn < 4 ? (const char*)(pool_t + (size_t)u.pn * 65536) : (const char*)(lru_t + (size_t)(u.pn - 4) * 65536); }
    __device__ __forceinline__ int a_row(const Unit&, int) const { return 0; }
    __device__ __forceinline__ int rows(const Unit& u) const { return NTOK - u.pm * 256; }
    template <bool T1> __device__ __forceinline__ bool epi(f32x4 (&acc)[2][2][4][2], const Unit& u, int wr, int wc, int fr, int fq) const {
        const int row0 = u.pm * 256 + wr * 64 + fr;
        if (u.pn < 4) {
#pragma unroll
            for (int bj = 0; bj < 2; ++bj) { const int col = u.pn * 256 + wc * 64 + bj * 32 + 8 * fq; const f32x4 p0 = *(const f32x4*)(pool_scale + col), p1 = *(const f32x4*)(pool_scale + col + 4);
#pragma unroll
                for (int ai = 0; ai < 2; ++ai)
#pragma unroll
                    for (int m = 0; m < 4; ++m) { const f32x4 v0 = acc[ai][bj][m][0] * p0, v1 = acc[ai][bj][m][1] * p1; u32x4 w; w.x = pk_bf16(v0[0], v0[1]); w.y = pk_bf16(v0[2], v0[3]); w.z = pk_bf16(v1[0], v1[1]); w.w = pk_bf16(v1[2], v1[3]);
                        *(u32x4*)(mix + (size_t)(row0 + ai * 128 + m * 16) * 3072 + col) = w; } }
        } else {
            const int q = u.pn - 4, ch = (q >> 1) * 256 + (q & 1) * 128 + wc * 32 + 8 * fq;
            float vba[8], vbx[8], vsp[8];
            { const f32x4 t0 = *(const f32x4*)(ba + ch), t1 = *(const f32x4*)(ba + ch + 4), t2 = *(const f32x4*)(bx + ch), t3 = *(const f32x4*)(bx + ch + 4), t4 = *(const f32x4*)(sp8 + ch), t5 = *(const f32x4*)(sp8 + ch + 4);
#pragma unroll
              for (int j = 0; j < 4; ++j) { vba[j] = t0[j]; vba[4 + j] = t1[j]; vbx[j] = t2[j]; vbx[4 + j] = t3[j]; vsp[j] = t4[j]; vsp[4 + j] = t5[j]; } }
#pragma unroll
            for (int ai = 0; ai < 2; ++ai) { u32x4 xw[4];
#pragma unroll
                for (int m = 0; m < 4; ++m) xw[m] = *(const u32x4*)(xc + (size_t)(row0 + ai * 128 + m * 16) * 1024 + ch);
#pragma unroll
                for (int m = 0; m < 4; ++m) { const int row = row0 + ai * 128 + m * 16; float xv[8]; unpack8(xw[m], xv);
                    const bool t0 = (row % LSEQ) == 0; float av[8], bv[8];
#pragma unroll
                    for (int j = 0; j < 8; ++j) { const float ga = sigmoidf_(acc[ai][0][m][j >> 2][j & 3] + vba[j]), gx = sigmoidf_(acc[ai][1][m][j >> 2][j & 3] + vbx[j]);
                        const float a = fast_exp(-vsp[j] * ga); bv[j] = sqrtf(fmaxf(1.0f - a * a, 0.f)) * gx * xv[j]; av[j] = t0 ? 1.0f : 1.0f - a; }
                    u32x4 wa, wb; wa.x = pk_bf16(av[0], av[1]); wa.y = pk_bf16(av[2], av[3]); wa.z = pk_bf16(av[4], av[5]); wa.w = pk_bf16(av[6], av[7]);
                    wb.x = pk_bf16(bv[0], bv[1]); wb.y = pk_bf16(bv[2], bv[3]); wb.z = pk_bf16(bv[4], bv[5]); wb.w = pk_bf16(bv[6], bv[7]);
                    *(u32x4*)(Abuf + (size_t)row * 1024 + ch) = wa; *(u32x4*)(Bbuf + (size_t)row * 1024 + ch) = wb; } }
        }
        return true;
    }
};
struct PolE {
    static constexpr bool PERM = true, GATHER = false, ADJ = true; static constexpr int ESZ = 2;
    int K, lda, ldb; const bf16* mix; const bf16* proj_t; const bf16* wct; const unsigned char* gates; bf16* merged; int G, c;
    int t0, t1;
    __device__ __forceinline__ bool next(int i, Unit& u) const { const int ti = t0 + xcd_order(i / 3, G, c, 8); if (ti >= t1) return false; u.pm = ti >> 3; u.pn = ti & 7; u.z = i % 3; return true; }
    __device__ __forceinline__ const char* a_ptr(const Unit& u) const { return (const char*)(mix + (size_t)u.pm * 256 * 3072 + u.z * 1024); }
    __device__ __forceinline__ const char* b_ptr(const Unit& u) const { return u.z == 0 ? (const char*)(wct + (size_t)u.pn * 256 * 1024) : (const char*)(proj_t + (size_t)u.z * D * 1024 + (size_t)u.pn * 256 * 1024); }
    __device__ __forceinline__ int a_row(const Unit&, int) const { return 0; }
    static __device__ __forceinline__ void unpack_gate(const u32x2 w, float (&f)[8]) { f[0] = (float)(w.x & 255u); f[1] = (float)((w.x >> 8) & 255u); f[2] = (float)((w.x >> 16) & 255u); f[3] = (float)(w.x >> 24);
        f[4] = (float)(w.y & 255u); f[5] = (float)((w.y >> 8) & 255u); f[6] = (float)((w.y >> 16) & 255u); f[7] = (float)(w.y >> 24); }
    template <bool T1> __device__ __forceinline__ bool epi(f32x4 (&acc)[2][2][4][2], const Unit& u, int wr, int wc, int fr, int fq) const {
        const int row0 = u.pm * 256 + wr * 64 + fr, col0 = u.pn * 256 + wc * 64 + 8 * fq;
        const unsigned char* gbase = gates + (size_t)row0 * GW + u.z * D + col0; const bool fin = (u.z == 2); const int dofs = fin ? 0 : D;
        const u32x2 ones = (u32x2){0xffffffffu, 0xffffffffu};
#pragma unroll
        for (int ai = 0; ai < (T1 ? 1 : 2); ++ai)
#pragma unroll
            for (int mh = 0; mh < 2; ++mh) { u32x2 ga[2][2], gb[2][2];
#pragma unroll
                for (int mm = 0; mm < 2; ++mm)
#pragma unroll
                    for (int bj = 0; bj < 2; ++bj) { const unsigned char* gp = gbase + (size_t)(ai * 128 + (2 * mh + mm) * 16) * GW + bj * 32; ga[mm][bj] = *(const u32x2*)gp; gb[mm][bj] = *(const u32x2*)(gp + dofs); }
#pragma unroll
                for (int mm = 0; mm < 2; ++mm)
#pragma unroll
                    for (int bj = 0; bj < 2; ++bj) { const int m = 2 * mh + mm; float f[8], h[8]; unpack_gate(ga[mm][bj], f); const u32x2 gsel = fin ? ones : gb[mm][bj]; unpack_gate(gsel, h);
#pragma unroll
                        for (int j = 0; j < 8; ++j) f[j] = fmaxf(f[j], 1e-20f) * __builtin_amdgcn_rcpf(fmaxf(h[j], 1e-20f));
                        f32x4 v0 = acc[ai][bj][m][0], v1 = acc[ai][bj][m][1];
                        v0[0] *= f[0]; v0[1] *= f[1]; v0[2] *= f[2]; v0[3] *= f[3]; v1[0] *= f[4]; v1[1] *= f[5]; v1[2] *= f[6]; v1[3] *= f[7];
                        acc[ai][bj][m][0] = v0; acc[ai][bj][m][1] = v1; }
                if (fin) {
#pragma unroll
                    for (int mm = 0; mm < 2; ++mm)
#pragma unroll
                        for (int bj = 0; bj < 2; ++bj) { const int m = 2 * mh + mm; const f32x4 a0 = acc[ai][bj][m][0], a1 = acc[ai][bj][m][1];
                            u32x4 w; w.x = pk_bf16(a0[0], a0[1]); w.y = pk_bf16(a0[2], a0[3]); w.z = pk_bf16(a1[0], a1[1]); w.w = pk_bf16(a1[2], a1[3]);
                            *(u32x4*)(merged + (size_t)(row0 + ai * 128 + m * 16) * D + col0 + bj * 32) = w; } }
                __builtin_amdgcn_sched_barrier(0); }
        return fin;
    }
};
struct PolF {
    static constexpr bool PERM = false, GATHER = false; static constexpr int ESZ = 2;
    int K, lda, ldb; const bf16* A; const bf16* Bt; float* H; float* stats; int G, c;
    int t0, t1;
    __device__ __forceinline__ bool next(int i, Unit& u) const { const int ti = t0 + xcd_order(i, G, c, 8); if (ti >= t1) return false; u.pm = ti >> 3; u.pn = ti & 7; u.z = 0; return true; }
    __device__ __forceinline__ const char* a_ptr(const Unit& u) const { return (const char*)(A + (size_t)u.pm * 256 * lda); }
    __device__ __forceinline__ const char* b_ptr(const Unit& u) const { return (const char*)(Bt + (size_t)u.pn * 256 * ldb); }
    __device__ __forceinline__ int a_row(const Unit&, int) const { return 0; }
    template <bool T1> __device__ __forceinline__ bool epi(f32x4 (&acc)[2][2][4][2], const Unit& u, int wr, int wc, int fr, int fq) const {
        const int row0 = u.pm * 256 + wr * 64 + fr, col0 = u.pn * 256 + wc * 32 + 4 * fq;
#pragma unroll
        for (int ai = 0; ai < (T1 ? 1 : 2); ++ai)
#pragma unroll
            for (int m = 0; m < 4; ++m) { const int row = row0 + ai * 128 + m * 16; float* rp = H + (size_t)row * D + col0; float s = 0.f, q = 0.f;
#pragma unroll
                for (int bj = 0; bj < 2; ++bj)
#pragma unroll
                    for (int n = 0; n < 2; ++n) { const f32x4 h = *(const f32x4*)(rp + bj * 128 + n * 16); const f32x4 y = h * ALPHA + acc[ai][bj][m][n]; *(f32x4*)(rp + bj * 128 + n * 16) = y;
                        s += (y[0] + y[1]) + (y[2] + y[3]); q += (y[0] * y[0] + y[1] * y[1]) + (y[2] * y[2] + y[3] * y[3]); }
                s += __shfl_xor(s, 16); s += __shfl_xor(s, 32); q += __shfl_xor(q, 16); q += __shfl_xor(q, 32);
                if (fq == 0) *(f32x2*)(stats + (size_t)row * 64 + (u.pn * 4 + wc) * 2) = (f32x2){s, q}; }
        return true;
    }
};
struct MoeTbl { const LAS int* t; __device__ __forceinline__ int ct(int e) const { return __builtin_amdgcn_readfirstlane(t[e]); } __device__ __forceinline__ int cnt(int e) const { return __builtin_amdgcn_readfirstlane(t[40 + e]); } };
__device__ __forceinline__ int moe_find(const MoeTbl& T, int mt) { int e = 0;
#pragma unroll 1
    while (e < 31 && T.ct(e + 1) <= mt) ++e;
    return e; }
struct PolI {
    static constexpr bool PERM = true, GATHER = true; static constexpr int ESZ = 1;
    int K, lda, ldb; const unsigned char* X; const unsigned char* gu; const int* elist; unsigned char* hdn; MoeTbl T; int G, c;
    __device__ __forceinline__ bool next(int i, Unit& u) const { const int L = xcd_order(i, G, c, 4), tot = T.ct(32); if (L >= tot * 4) return false; u.pm = L >> 2; u.pn = L & 3; u.z = moe_find(T, u.pm); return true; }
    __device__ __forceinline__ const char* a_ptr(const Unit&) const { return (const char*)X; }
    __device__ __forceinline__ const char* b_ptr(const Unit& u) const { return (const char*)(gu + (size_t)(u.z * 4 + u.pn) * 256 * D); }
    __device__ __forceinline__ int a_row(const Unit& u, int r) const { const int j = (u.pm - T.ct(u.z)) * 256 + r; return j < T.cnt(u.z) ? elist[(size_t)u.z * NTOK + j] : 0; }
    template <bool T1> __device__ __forceinline__ bool epi(f32x4 (&acc)[2][2][4][2], const Unit& u, int wr, int wc, int fr, int fq) const {
        const int row0 = u.pm * 256 + wr * 64 + fr, col0 = u.pn * 128 + wc * 32 + 8 * fq;
#pragma unroll
        for (int ai = 0; ai < 2; ++ai)
#pragma unroll
            for (int m = 0; m < 4; ++m) { float o[8];
#pragma unroll
                for (int n = 0; n < 2; ++n)
#pragma unroll
                    for (int j = 0; j < 4; ++j) { const float g = acc[ai][0][m][n][j] * (1.0f / W8_SCALE), up = acc[ai][1][m][n][j] * (HDN_SCALE / W8_SCALE); o[4 * n + j] = fminf(fmaxf(g * sigmoidf_(g) * up, -440.f), 440.f); }
                u32x2 w; w.x = pk_fp8x4(o[0], o[1], o[2], o[3]); w.y = pk_fp8x4(o[4], o[5], o[6], o[7]);
                *(u32x2*)(hdn + (size_t)(row0 + ai * 128 + m * 16) * DE + col0) = w; }
        return true;
    }
};
struct PolJ {
    static constexpr bool PERM = true, GATHER = false, ADJ = true; static constexpr int ESZ = 1;
    int K, lda, ldb; const unsigned char* hdn; const unsigned char* wd; unsigned char* yd; MoeTbl T; int G, c;
    __device__ __forceinline__ bool next(int i, Unit& u) const { const int L = xcd_order(i, G, c, 8), tot = T.ct(32); if (L >= tot * 8) return false; u.pm = L >> 3; u.pn = L & 7; u.z = moe_find(T, u.pm); return true; }
    __device__ __forceinline__ const char* a_ptr(const Unit& u) const { return (const char*)(hdn + (size_t)u.pm * 256 * DE); }
    __device__ __forceinline__ const char* b_ptr(const Unit& u) const { return (const char*)(wd + ((size_t)u.z * D + (size_t)u.pn * 256) * DE); }
    __device__ __forceinline__ int a_row(const Unit&, int) const { return 0; }
    template <bool T1> __device__ __forceinline__ bool epi(f32x4 (&acc)[2][2][4][2], const Unit& u, int wr, int wc, int fr, int fq) const {
        const int row0 = u.pm * 256 + wr * 64 + fr, col0 = u.pn * 256 + wc * 64 + 8 * fq;
#pragma unroll
        for (int ai = 0; ai < 2; ++ai)
#pragma unroll
            for (int m = 0; m < 4; ++m)
#pragma unroll
                for (int bj = 0; bj < 2; ++bj) { const f32x4 v0 = acc[ai][bj][m][0] * (YD_SCALE / (W8_SCALE * HDN_SCALE)), v1 = acc[ai][bj][m][1] * (YD_SCALE / (W8_SCALE * HDN_SCALE));
#define YCL(x) __builtin_amdgcn_fmed3f((x), -448.0f, 448.0f)
                    u32x2 w; w.x = pk_fp8x4(YCL(v0[0]), YCL(v0[1]), YCL(v0[2]), YCL(v0[3])); w.y = pk_fp8x4(YCL(v1[0]), YCL(v1[1]), YCL(v1[2]), YCL(v1[3]));
#undef YCL
                    *(u32x2*)(yd + (size_t)(row0 + ai * 128 + m * 16) * D + col0 + bj * 32) = w; }
        return true;
    }
};

template <int NCB> __device__ __forceinline__ void skinny_mma(f32x4 (&acc)[4][NCB], const bf16* A, int lda, const bf16* Bt, int ldb, int k0, int k1, int lane) {
    const int fr = lane & 15, fq = lane >> 4;
#pragma unroll 2
    for (int k = k0; k < k1; k += 32) { bf16x8 a[4], b[NCB];
#pragma unroll
        for (int rb = 0; rb < 4; ++rb) a[rb] = *(const bf16x8*)(A + (size_t)(16 * rb + fr) * lda + k + 8 * fq);
#pragma unroll
        for (int cb = 0; cb < NCB; ++cb) b[cb] = *(const bf16x8*)(Bt + (size_t)(16 * cb + fr) * ldb + k + 8 * fq);
#pragma unroll
        for (int rb = 0; rb < 4; ++rb)
#pragma unroll
            for (int cb = 0; cb < NCB; ++cb) acc[rb][cb] = __builtin_amdgcn_mfma_f32_16x16x32_bf16(b[cb], a[rb], acc[rb][cb], 0, 0, 0); }
}
__device__ __forceinline__ void tail_merge(Frame& F, int l) {
    if (F.vcu >= 128) return;
    const bf16* mix = (const bf16*)(F.ws + WS_R3) + (size_t)16384 * 3072; const bf16* proj_t = (const bf16*)(F.ws + WS_WSMALL + (size_t)l * WL_BYTES + WL_PROJ); const bf16* wct = (const bf16*)(F.ws + WS_WCT) + (size_t)l * D * 1024;
    const unsigned char* gates = F.ws + WS_R1 + (size_t)16384 * GW; bf16* merged = (bf16*)(F.ws + WS_R45) + (size_t)16384 * D;
    const int c0 = F.vcu * 16, lane = F.lane, wave = F.wave, fr = lane & 15, fq = lane >> 4;
    LAS float* part = (LAS float*)F.lds;
#pragma unroll
    for (int seg = 0; seg < 3; ++seg) { f32x4 acc[4][1];
#pragma unroll
        for (int rb = 0; rb < 4; ++rb) acc[rb][0] = (f32x4){0.f, 0.f, 0.f, 0.f};
        skinny_mma<1>(acc, mix + seg * 1024, 3072, (seg == 0 ? wct : proj_t + (size_t)seg * D * 1024) + (size_t)c0 * 1024, 1024, wave * 128, wave * 128 + 128, lane);
#pragma unroll
        for (int rb = 0; rb < 4; ++rb) *(LAS f32x4*)(part + ((wave * 3 + seg) * 64 + 16 * rb + fr) * 16 + 4 * fq) = acc[rb][0]; }
    __syncthreads();
#pragma unroll
    for (int e2 = 0; e2 < 2; ++e2) { const int e = F.tid + 512 * e2, row = e >> 4, col = e & 15; float m = 0.f;
#pragma unroll
        for (int seg = 0; seg < 3; ++seg) { float s = 0.f;
#pragma unroll
            for (int w = 0; w < 8; ++w) s += part[((w * 3 + seg) * 64 + row) * 16 + col];
            m += (float)gates[(size_t)row * GW + seg * D + c0 + col] * (1.0f / 255.0f) * s; }
        merged[(size_t)row * D + c0 + col] = (bf16)(pk_bf16(m, 0.f) & 0xffffu); }
    __syncthreads();
}
__device__ __forceinline__ void tail_lru(Frame& F, int l) {
    if (F.vcu >= 64) return;
    const bf16* xc = (const bf16*)(F.ws + WS_R45) + (size_t)MP * 1024 + (size_t)16384 * 1024; const bf16* lru_t = (const bf16*)(F.ws + WS_WSMALL + (size_t)l * WL_BYTES + WL_LRU);
    bf16* Abuf = (bf16*)(F.ws + WS_R6) + (size_t)16384 * 1024; bf16* Bbuf = (bf16*)(F.ws + WS_R6) + (size_t)MP * 1024 + (size_t)16384 * 1024;
    const float* ba = F.I(I_BA) + (size_t)l * 1024; const float* bx = F.I(I_BX) + (size_t)l * 1024; const float* sp8 = (const float*)(F.ws + WS_SP8) + (size_t)l * 1024;
    const int ch0 = F.vcu * 16, blk = ch0 >> 8, cib = ch0 & 255, lane = F.lane, wave = F.wave, fr = lane & 15, fq = lane >> 4;
    const bf16* wrow = lru_t + (size_t)((blk * 2 + (cib >> 7)) * 256 + 64 * ((cib & 127) >> 5) + (cib & 31)) * 256;
    LAS float* part = (LAS float*)F.lds;
    { f32x4 acc[4][2];
#pragma unroll
      for (int rb = 0; rb < 4; ++rb) { acc[rb][0] = (f32x4){0.f, 0.f, 0.f, 0.f}; acc[rb][1] = acc[rb][0]; }
      const int k = wave * 32 + 8 * fq; bf16x8 a[4], b[2];
#pragma unroll
      for (int rb = 0; rb < 4; ++rb) a[rb] = *(const bf16x8*)(xc + (size_t)(16 * rb + fr) * 1024 + blk * 256 + k);
      b[0] = *(const bf16x8*)(wrow + (size_t)fr * 256 + k); b[1] = *(const bf16x8*)(wrow + (size_t)(32 + fr) * 256 + k);
#pragma unroll
      for (int rb = 0; rb < 4; ++rb)
#pragma unroll
          for (int cb = 0; cb < 2; ++cb) acc[rb][cb] = __builtin_amdgcn_mfma_f32_16x16x32_bf16(b[cb], a[rb], acc[rb][cb], 0, 0, 0);
#pragma unroll
      for (int rb = 0; rb < 4; ++rb)
#pragma unroll
          for (int cb = 0; cb < 2; ++cb) *(LAS f32x4*)(part + (wave * 64 + 16 * rb + fr) * 32 + 16 * cb + 4 * fq) = acc[rb][cb]; }
    __syncthreads();
#pragma unroll
    for (int e2 = 0; e2 < 2; ++e2) { const int e = F.tid + 512 * e2, row = e >> 4, cc = e & 15, ch = ch0 + cc; float ga = 0.f, gx = 0.f;
#pragma unroll
        for (int w = 0; w < 8; ++w) { ga += part[(w * 64 + row) * 32 + cc]; gx += part[(w * 64 + row) * 32 + 16 + cc]; }
        const float sa = sigmoidf_(ga + ba[ch]), sx = sigmoidf_(gx + bx[ch]), a = fast_exp(-sp8[ch] * sa), xv = bf2f(xc[(size_t)row * 1024 + ch]);
        const bool t0 = ((16384 + row) % LSEQ) == 0;
        Abuf[(size_t)row * 1024 + ch] = (bf16)(pk_bf16(t0 ? 1.0f : 1.0f - a, 0.f) & 0xffffu); Bbuf[(size_t)row * 1024 + ch] = (bf16)(pk_bf16(sqrtf(fmaxf(1.0f - a * a, 0.f)) * sx * xv, 0.f) & 0xffffu); }
    __syncthreads();
}
__device__ __forceinline__ void tail_wout(Frame& F, int l) {
    if (F.vcu >= 32) return;
    const bf16* merged = (const bf16*)(F.ws + WS_R45) + (size_t)16384 * D; const bf16* wo = (const bf16*)(F.ws + WS_WSMALL + (size_t)l * WL_BYTES + WL_WOUT);
    float* H = (float*)(F.ws + WS_H) + (size_t)16384 * D; float* stats = (float*)(F.ws + WS_STATS) + (size_t)16384 * 64;
    const int c0 = F.vcu * 64, lane = F.lane, wave = F.wave, fr = lane & 15, fq = lane >> 4;
    LAS float* part = (LAS float*)F.lds;
    { f32x4 acc[4][4];
#pragma unroll
      for (int rb = 0; rb < 4; ++rb)
#pragma unroll
          for (int cb = 0; cb < 4; ++cb) acc[rb][cb] = (f32x4){0.f, 0.f, 0.f, 0.f};
      skinny_mma<4>(acc, merged, D, wo + (size_t)c0 * D, D, wave * 256, wave * 256 + 256, lane);
#pragma unroll
      for (int rb = 0; rb < 4; ++rb)
#pragma unroll
          for (int cb = 0; cb < 4; ++cb) *(LAS f32x4*)(part + (wave * 64 + 16 * rb + fr) * 64 + 16 * cb + 4 * fq) = acc[rb][cb]; }
    __syncthreads();
    { const int row = F.tid >> 3, cs = (F.tid & 7) * 8; float s = 0.f, q = 0.f;
#pragma unroll
      for (int h4 = 0; h4 < 2; ++h4) { f32x4 a = (f32x4){0.f, 0.f, 0.f, 0.f};
#pragma unroll
          for (int w = 0; w < 8; ++w) a += *(const LAS f32x4*)(part + (w * 64 + row) * 64 + cs + 4 * h4);
          float* hp = H + (size_t)row * D + c0 + cs + 4 * h4; const f32x4 y = *(const f32x4*)hp * ALPHA + a; *(f32x4*)hp = y;
          s += (y[0] + y[1]) + (y[2] + y[3]); q += (y[0] * y[0] + y[1] * y[1]) + (y[2] * y[2] + y[3] * y[3]); }
      s += __shfl_xor(s, 1); s += __shfl_xor(s, 2); s += __shfl_xor(s, 4); q += __shfl_xor(q, 1); q += __shfl_xor(q, 2); q += __shfl_xor(q, 4);
      if ((F.tid & 7) == 0) *(f32x2*)(stats + (size_t)row * 64 + F.vcu * 2) = (f32x2){s, q}; }
    __syncthreads();
}

__device__ __forceinline__ void unpack8(const u32x4 v, float (&f)[8]) { f[0] = bflo(v.x); f[1] = bfhi(v.x); f[2] = bflo(v.y); f[3] = bfhi(v.y); f[4] = bflo(v.z); f[5] = bfhi(v.z); f[6] = bflo(v.w); f[7] = bfhi(v.w); }
template <int W> __device__ __forceinline__ void delta_conv_item(const bf16* cols, bf16* delta, bf16* xc, const float* cw, const float* cb, int n0, int t0, int c8) {
    u32x4 R[W + 7], X[11];
#pragma unroll
    for (int j = 0; j < W + 7; ++j) { const int dt = j - (W - 1); R[j] = (t0 + dt >= 0) ? *(const u32x4*)(cols + (size_t)(n0 + dt) * CW + C_POOL + c8) : (u32x4){0u, 0u, 0u, 0u}; }
#pragma unroll
    for (int j = 0; j < 11; ++j) { const int dt = j - 3; X[j] = (t0 + dt >= 0) ? *(const u32x4*)(cols + (size_t)(n0 + dt) * CW + C_LX + c8) : (u32x4){0u, 0u, 0u, 0u}; }
    float s[8];
#pragma unroll
    for (int q = 0; q < 8; ++q) s[q] = 0.f;
#pragma unroll
    for (int j = 0; j < W - 1; ++j) { float f[8]; unpack8(R[j], f);
#pragma unroll
        for (int q = 0; q < 8; ++q) s[q] += f[q]; }
#pragma unroll
    for (int i = 0; i < 8; ++i) { float fn[8]; unpack8(R[i + W - 1], fn);
#pragma unroll
        for (int q = 0; q < 8; ++q) s[q] += fn[q];
        const int t = t0 + i; const float inv = 1.0f / (float)((t + 1) < W ? (t + 1) : W); u32x4 o;
        o.x = pk_bf16(s[0] * inv - fn[0], s[1] * inv - fn[1]); o.y = pk_bf16(s[2] * inv - fn[2], s[3] * inv - fn[3]); o.z = pk_bf16(s[4] * inv - fn[4], s[5] * inv - fn[5]); o.w = pk_bf16(s[6] * inv - fn[6], s[7] * inv - fn[7]);
        *(u32x4*)(delta + (size_t)(n0 + i) * 3072 + c8) = o;
        float fo[8]; unpack8(R[i], fo);
#pragma unroll
        for (int q = 0; q < 8; ++q) s[q] -= fo[q]; }
    float w0[8], w1[8], w2[8], w3[8], bb[8];
#pragma unroll
    for (int q = 0; q < 8; ++q) { w0[q] = cw[c8 + q]; w1[q] = cw[1024 + c8 + q]; w2[q] = cw[2048 + c8 + q]; w3[q] = cw[3072 + c8 + q]; bb[q] = cb[c8 + q]; }
#pragma unroll
    for (int i = 0; i < 8; ++i) { float a[8], b[8], c[8], d[8]; unpack8(X[i], a); unpack8(X[i + 1], b); unpack8(X[i + 2], c); unpack8(X[i + 3], d); float r[8];
#pragma unroll
        for (int q = 0; q < 8; ++q) r[q] = bb[q] + a[q] * w0[q] + b[q] * w1[q] + c[q] * w2[q] + d[q] * w3[q];
        u32x4 o; o.x = pk_bf16(r[0], r[1]); o.y = pk_bf16(r[2], r[3]); o.z = pk_bf16(r[4], r[5]); o.w = pk_bf16(r[6], r[7]);
        *(u32x4*)(xc + (size_t)(n0 + i) * 1024 + c8) = o; }
}
__device__ __forceinline__ void phase_delta_conv(Frame& F, int l) {
    const bf16* cols = (const bf16*)(F.ws + WS_R2); bf16* delta = (bf16*)(F.ws + WS_R3); bf16* xc = (bf16*)(F.ws + WS_R45) + (size_t)MP * 1024;
    const float* cw = F.I(I_CONVW) + (size_t)l * 4 * 1024; const float* cb = F.I(I_CONVB) + (size_t)l * 1024;
    const int gw = F.vcu * 8 + F.wave, NGW = F.G * 8, lane = F.lane;
    const int total = (NTOK / 16) * 4, full = total / NGW;
    for (int k = 0; k <= full; ++k) { const int it = k * NGW + (k == full ? NGW - 1 - gw : gw); if (it >= total) break;
        const int g = it & 3, tp = it >> 2, n0 = (tp * 2 + (lane >> 5)) * 8, t0 = n0 % LSEQ, c8 = g * 256 + (lane & 31) * 8;
        if (g == 0) delta_conv_item<2>(cols, delta, xc, cw, cb, n0, t0, c8);
        else if (g == 1) delta_conv_item<4>(cols, delta, xc, cw, cb, n0, t0, c8);
        else if (g == 2) delta_conv_item<8>(cols, delta, xc, cw, cb, n0, t0, c8);
        else delta_conv_item<16>(cols, delta, xc, cw, cb, n0, t0, c8);
    }
}
typedef float f32x16 __attribute__((ext_vector_type(16)));
__device__ __forceinline__ void phase_attn(Frame& F, int l) {
    const bf16* cols = (const bf16*)(F.ws + WS_R2); bf16* mix = (bf16*)(F.ws + WS_R3);
    constexpr int KS_BYTES = 27648, BUF_BYTES = 27648 + 25088;
    const int tid = F.tid, lane = F.lane, wave = F.wave, r = lane & 31, h = lane >> 5, g = wave >> 1, qh = wave & 1;
    const int NU = NB * 4 * 65;
    u32x4 kreg[3], vreg[3];
#define ATT_FETCH(u_) do { const int qb_ = (u_) % 65, bk_ = (u_) / 65, kvh_ = bk_ & 3, b_ = bk_ >> 2, t0_ = qb_ * 64; const size_t nb_ = (size_t)b_ * LSEQ; \
        _Pragma("unroll") for (int i = 0; i < 3; ++i) { const int c = tid + 512 * i, key = c >> 3, dc = c & 7; int tc = t0_ - 128 + key; tc = tc < 0 ? 0 : (tc > LSEQ - 1 ? LSEQ - 1 : tc); \
            const bf16* src = cols + (nb_ + tc) * CW + kvh_ * 64 + dc * 8; kreg[i] = *(const u32x4*)(src + C_K); vreg[i] = *(const u32x4*)(src + C_V); } } while (0)
    int u = F.vcu, buf = 0;
    if (u < NU) ATT_FETCH(u);
    for (; u < NU; u += F.G, buf ^= 1) {
        LAS unsigned char* Ks = F.lds + buf * BUF_BYTES; LAS unsigned char* Vt = Ks + KS_BYTES;
        const int qb = u % 65, bk = u / 65, kvh = bk & 3, b = bk >> 2, t0 = qb * 64; const size_t nb = (size_t)b * LSEQ;
#pragma unroll
        for (int i = 0; i < 3; ++i) { const int c = tid + 512 * i, key = c >> 3, dc = c & 7; const u32x4 vv = vreg[i];
            *(LAS u32x4*)(Ks + key * 144 + dc * 16) = kreg[i];
            LAS unsigned short* vp = (LAS unsigned short*)(Vt + (8 * dc) * 392 + key * 2);
            vp[0 * 196] = (unsigned short)(vv.x & 0xffffu); vp[1 * 196] = (unsigned short)(vv.x >> 16); vp[2 * 196] = (unsigned short)(vv.y & 0xffffu); vp[3 * 196] = (unsigned short)(vv.y >> 16);
            vp[4 * 196] = (unsigned short)(vv.z & 0xffffu); vp[5 * 196] = (unsigned short)(vv.z >> 16); vp[6 * 196] = (unsigned short)(vv.w & 0xffffu); vp[7 * 196] = (unsigned short)(vv.w >> 16); }
        const int head = kvh * 4 + g, tq = t0 + 32 * qh + r, tqc = tq > LSEQ - 1 ? LSEQ - 1 : tq;
        bf16x8 qf[4];
        { const bf16* qp = cols + (nb + tqc) * CW + C_Q + head * 64 + 8 * h;
#pragma unroll
          for (int ks = 0; ks < 4; ++ks) qf[ks] = *(const bf16x8*)(qp + 16 * ks); }
        if (u + F.G < NU) ATT_FETCH(u + F.G);
        const float slope2 = exp2f(-0.5f * (float)(head + 1)) * 1.44269504089f, sink2 = F.I(I_SINK)[l * 16 + head] * 1.44269504089f;
        __syncthreads();
        f32x16 st[5];
#pragma unroll
        for (int jj = 0; jj < 5; ++jj) { f32x16 a;
#pragma unroll
            for (int i = 0; i < 16; ++i) a[i] = 0.f;
#pragma unroll
            for (int ks = 0; ks < 4; ++ks) { const bf16x8 kf = *(const LAS bf16x8*)(Ks + (32 * (qh + jj) + r) * 144 + (16 * ks + 8 * h) * 2); a = __builtin_amdgcn_mfma_f32_32x32x16_bf16(kf, qf[ks], a, 0, 0, 0); }
            st[jj] = a; }
        float m = sink2;
#pragma unroll
        for (int jj = 0; jj < 5; ++jj) { const int tsb = t0 - 128 + 32 * (qh + jj) + 4 * h, db = 128 - 32 * jj + r - 4 * h; const float dl = slope2 * (float)db; const bool edge = (jj == 0) || (jj == 4) || (t0 - 128 + 32 * (qh + jj) < 0);
            if (!edge) {
#pragma unroll
                for (int i = 0; i < 16; ++i) { const float v = __builtin_fmaf(st[jj][i], 1.44269504089f, __builtin_fmaf(slope2, (float)((i & 3) + 8 * (i >> 2)), -dl)); st[jj][i] = v; m = fmaxf(m, v); }
            } else {
#pragma unroll
                for (int i = 0; i < 16; ++i) { const int cr = (i & 3) + 8 * (i >> 2), dist = db - cr; const bool ok = dist >= 0 && dist < 128 && (tsb + cr) >= 0;
                    const float v = ok ? __builtin_fmaf(st[jj][i], 1.44269504089f, __builtin_fmaf(slope2, (float)cr, -dl)) : -1e30f; st[jj][i] = v; m = fmaxf(m, v); }
            } }
        m = fmaxf(m, __shfl_xor(m, 32));
        float sum = 0.f;
#pragma unroll
        for (int jj = 0; jj < 5; ++jj)
#pragma unroll
            for (int i = 0; i < 16; ++i) { const float pv = __builtin_amdgcn_exp2f(st[jj][i] - m); st[jj][i] = pv; sum += pv; }
        sum += __shfl_xor(sum, 32);
        const float inv = 1.0f / (sum + __builtin_amdgcn_exp2f(sink2 - m));
        f32x16 o[2];
#pragma unroll
        for (int i = 0; i < 16; ++i) { o[0][i] = 0.f; o[1][i] = 0.f; }
#pragma unroll
        for (int jj = 0; jj < 5; ++jj)
#pragma unroll
            for (int s = 0; s < 2; ++s) { u32x4 pw; pw.x = pk_bf16(st[jj][8 * s], st[jj][8 * s + 1]); pw.y = pk_bf16(st[jj][8 * s + 2], st[jj][8 * s + 3]); pw.z = pk_bf16(st[jj][8 * s + 4], st[jj][8 * s + 5]); pw.w = pk_bf16(st[jj][8 * s + 6], st[jj][8 * s + 7]);
                const bf16x8 pf = __builtin_bit_cast(bf16x8, pw);
#pragma unroll
                for (int db2 = 0; db2 < 2; ++db2) { const LAS unsigned char* vb = Vt + (32 * db2 + r) * 392 + (32 * (qh + jj) + 16 * s + 4 * h) * 2;
                    const u32x2 lo = *(const LAS u32x2*)vb, hi = *(const LAS u32x2*)(vb + 16); u32x4 vw; vw.x = lo.x; vw.y = lo.y; vw.z = hi.x; vw.w = hi.y;
                    o[db2] = __builtin_amdgcn_mfma_f32_32x32x16_bf16(__builtin_bit_cast(bf16x8, vw), pf, o[db2], 0, 0, 0); } }
        if (tq < LSEQ) { bf16* op = mix + (nb + tq) * 3072 + 1024 + head * 64 + 4 * h;
#pragma unroll
            for (int db2 = 0; db2 < 2; ++db2)
#pragma unroll
                for (int g4 = 0; g4 < 4; ++g4) { u32x2 w; w.x = pk_bf16(o[db2][4 * g4] * inv, o[db2][4 * g4 + 1] * inv); w.y = pk_bf16(o[db2][4 * g4 + 2] * inv, o[db2][4 * g4 + 3] * inv);
                    *(u32x2*)(op + 32 * db2 + 8 * g4) = w; } }
    }
#undef ATT_FETCH
    __syncthreads();
}
__device__ __forceinline__ void phase_lru_summ(Frame& F) {
    const bf16* Ab = (const bf16*)(F.ws + WS_R6); const bf16* Bb = Ab + (size_t)MP * 1024; float* summ = (float*)(F.ws + WS_SUMM);
    const int gt = ((F.tid >> 8) * F.G + F.vcu) * 256 + (F.tid & 255), NT = F.G * 512;
    for (int it = gt; it < NCHUNK * 256; it += NT) { const int ck = it >> 8, c = (it & 255) * 4, r0 = ck * 64, nr = (r0 + 64) <= NTOK ? 64 : NTOK - r0;
        f32x4 A = (f32x4){1.f, 1.f, 1.f, 1.f}, Bv = (f32x4){0.f, 0.f, 0.f, 0.f};
        const bf16* ap = Ab + (size_t)r0 * 1024 + c; const bf16* bp = Bb + (size_t)r0 * 1024 + c;
        for (int r = 0; r < nr; r += 16) { u32x2 aw[16], bw[16];
#pragma unroll
            for (int i = 0; i < 16; ++i) { aw[i] = *(const u32x2*)(ap + (size_t)(r + i) * 1024); bw[i] = *(const u32x2*)(bp + (size_t)(r + i) * 1024); }
#pragma unroll
            for (int i = 0; i < 16; ++i) { const f32x4 a = (f32x4){1.f - bflo(aw[i].x), 1.f - bfhi(aw[i].x), 1.f - bflo(aw[i].y), 1.f - bfhi(aw[i].y)}, b = (f32x4){bflo(bw[i].x), bfhi(bw[i].x), bflo(bw[i].y), bfhi(bw[i].y)};
                Bv = a * Bv + b; A = A * a; } }
        *(f32x4*)(summ + ((size_t)ck * 1024 + c) * 2) = A; *(f32x4*)(summ + ((size_t)ck * 1024 + c) * 2 + 4) = Bv; }
}
__device__ __forceinline__ void phase_lru_final(Frame& F) {
    const bf16* Ab = (const bf16*)(F.ws + WS_R6); const bf16* Bb = Ab + (size_t)MP * 1024; const float* summ = (const float*)(F.ws + WS_SUMM);
    const bf16* cols = (const bf16*)(F.ws + WS_R2); bf16* mix = (bf16*)(F.ws + WS_R3);
    const int gt = ((F.tid >> 8) * F.G + F.vcu) * 256 + (F.tid & 255), NT = F.G * 512;
    for (int it = gt; it < NCHUNK * 256; it += NT) { const int ck = it >> 8, c = (it & 255) * 4, r0 = ck * 64, nr = (r0 + 64) <= NTOK ? 64 : NTOK - r0;
        const int c0 = ((r0 / LSEQ) * LSEQ) / 64; f32x4 h = (f32x4){0.f, 0.f, 0.f, 0.f};
        int cc = c0;
        for (; cc + 16 <= ck; cc += 16) { f32x4 sa[16], sb[16];
#pragma unroll
            for (int i = 0; i < 16; ++i) { const float* sp = summ + ((size_t)(cc + i) * 1024 + c) * 2; sa[i] = *(const f32x4*)sp; sb[i] = *(const f32x4*)(sp + 4); }
#pragma unroll
            for (int i = 0; i < 16; ++i) h = sa[i] * h + sb[i]; }
        for (; cc + 4 <= ck; cc += 4) { f32x4 sa[4], sb[4];
#pragma unroll
            for (int i = 0; i < 4; ++i) { const float* sp = summ + ((size_t)(cc + i) * 1024 + c) * 2; sa[i] = *(const f32x4*)sp; sb[i] = *(const f32x4*)(sp + 4); }
#pragma unroll
            for (int i = 0; i < 4; ++i) h = sa[i] * h + sb[i]; }
        for (; cc < ck; ++cc) { const float* sp = summ + ((size_t)cc * 1024 + c) * 2; h = *(const f32x4*)sp * h + *(const f32x4*)(sp + 4); }
        const bf16* ap = Ab + (size_t)r0 * 1024 + c; const bf16* bp = Bb + (size_t)r0 * 1024 + c;
        for (int r = 0; r < nr; r += 16) { u32x2 aw[16], bw[16]; u32x2 yw[16];
#pragma unroll
            for (int i = 0; i < 16; ++i) { aw[i] = *(const u32x2*)(ap + (size_t)(r + i) * 1024); bw[i] = *(const u32x2*)(bp + (size_t)(r + i) * 1024); yw[i] = *(const u32x2*)(cols + (size_t)(r0 + r + i) * CW + C_LY + c); }
#pragma unroll
            for (int i = 0; i < 16; ++i) { const f32x4 a = (f32x4){1.f - bflo(aw[i].x), 1.f - bfhi(aw[i].x), 1.f - bflo(aw[i].y), 1.f - bfhi(aw[i].y)}, b = (f32x4){bflo(bw[i].x), bfhi(bw[i].x), bflo(bw[i].y), bfhi(bw[i].y)};
                h = a * h + b;
                const float y[4] = {bflo(yw[i].x), bfhi(yw[i].x), bflo(yw[i].y), bfhi(yw[i].y)}; float o[4];
#pragma unroll
                for (int j = 0; j < 4; ++j) o[j] = h[j] * y[j] * sigmoidf_(1.5957691216f * (y[j] + 0.044715f * y[j] * y[j] * y[j]));
                u32x2 w; w.x = pk_bf16(o[0], o[1]); w.y = pk_bf16(o[2], o[3]); *(u32x2*)(mix + (size_t)(r0 + r + i) * 3072 + 2048 + c) = w; } } }
}
template <int NG, bool DUMMY> __device__ __forceinline__ void ln1_groups(Frame& F, int l, int j0) {
    float* H = (float*)(F.ws + WS_H); float* Hout = DUMMY ? (float*)(F.ws + WS_R6) : H; unsigned char* HB8 = F.ws + (DUMMY ? WS_R3 : WS_HB8); const float* stats = (const float*)(F.ws + WS_STATS);
    const float* g1 = F.I(I_LN1G) + (size_t)l * D; const float* b1 = F.I(I_LN1B) + (size_t)l * D;
    const bf16* whi = (const bf16*)(F.ws + WS_WRT) + (size_t)(l * 2) * 48 * 2048; const bf16* wlo = whi + 48 * 2048;
    const int lane = F.lane, p = lane & 15, kg = lane >> 4, wave = F.wave;
    float mean[NG], rstd[NG]; size_t roff[NG]; f32x4 acc[NG][3];
#pragma unroll
    for (int j = 0; j < NG; ++j) { const int row = (F.vcu + (j0 + j) * F.G) * 16 + p; roff[j] = (size_t)row * D;
        float s = 0.f, q = 0.f; const f32x4* sp = (const f32x4*)(stats + (size_t)row * 64 + kg * 16);
#pragma unroll
        for (int i = 0; i < 4; ++i) { const f32x4 t = sp[i]; s += t[0] + t[2]; q += t[1] + t[3]; }
        s += __shfl_xor(s, 16); s += __shfl_xor(s, 32); q += __shfl_xor(q, 16); q += __shfl_xor(q, 32);
        mean[j] = s * (1.f / D); rstd[j] = 1.f / sqrtf(fmaxf(q * (1.f / D) - mean[j] * mean[j], 0.f) + LN_EPS);
#pragma unroll
        for (int cb = 0; cb < 3; ++cb) acc[j][cb] = (f32x4){0.f, 0.f, 0.f, 0.f}; }
#pragma unroll 2
    for (int ks = 0; ks < 8; ++ks) {
        const int col = wave * 256 + ks * 32 + kg * 8;
        f32x4 y0[NG], y1[NG];
#pragma unroll
        for (int j = 0; j < NG; ++j) { y0[j] = *(const f32x4*)(H + roff[j] + col); y1[j] = *(const f32x4*)(H + roff[j] + col + 4); }
        const f32x4 ga = *(const f32x4*)(g1 + col), gb = *(const f32x4*)(g1 + col + 4), ba = *(const f32x4*)(b1 + col), bb = *(const f32x4*)(b1 + col + 4);
        bf16x8 wh[3], wl[3];
#pragma unroll
        for (int cb = 0; cb < 3; ++cb) { wh[cb] = *(const bf16x8*)(whi + (size_t)(cb * 16 + p) * 2048 + col); wl[cb] = *(const bf16x8*)(wlo + (size_t)(cb * 16 + p) * 2048 + col); }
#pragma unroll
        for (int j = 0; j < NG; ++j) {
            const f32x4 h0 = (y0[j] - mean[j]) * rstd[j] * ga + ba, h1 = (y1[j] - mean[j]) * rstd[j] * gb + bb;
            u32x4 hi; hi.x = pk_bf16(h0[0], h0[1]); hi.y = pk_bf16(h0[2], h0[3]); hi.z = pk_bf16(h1[0], h1[1]); hi.w = pk_bf16(h1[2], h1[3]);
            { u32x2 w8; w8.x = pk_fp8x4(h0[0], h0[1], h0[2], h0[3]); w8.y = pk_fp8x4(h1[0], h1[1], h1[2], h1[3]); *(u32x2*)(HB8 + roff[j] + col) = w8; }
            u32x4 lo; lo.x = pk_bf16(h0[0] - bflo(hi.x), h0[1] - bfhi(hi.x)); lo.y = pk_bf16(h0[2] - bflo(hi.y), h0[3] - bfhi(hi.y));
            lo.z = pk_bf16(h1[0] - bflo(hi.z), h1[1] - bfhi(hi.z)); lo.w = pk_bf16(h1[2] - bflo(hi.w), h1[3] - bfhi(hi.w));
            const bf16x8 xh = __builtin_bit_cast(bf16x8, hi), xl = __builtin_bit_cast(bf16x8, lo);
#pragma unroll
            for (int cb = 0; cb < 3; ++cb) { acc[j][cb] = __builtin_amdgcn_mfma_f32_16x16x32_bf16(wh[cb], xh, acc[j][cb], 0, 0, 0);
                acc[j][cb] = __builtin_amdgcn_mfma_f32_16x16x32_bf16(wh[cb], xl, acc[j][cb], 0, 0, 0); acc[j][cb] = __builtin_amdgcn_mfma_f32_16x16x32_bf16(wl[cb], xh, acc[j][cb], 0, 0, 0); } }
    }
#pragma unroll
    for (int j = 0; j < NG; ++j) { LAS float* lgs = (LAS float*)(F.lds + (j0 + j) * 24576);
#pragma unroll
        for (int cb = 0; cb < 3; ++cb) *(LAS f32x4*)(lgs + (wave * 16 + p) * 48 + cb * 16 + kg * 4) = acc[j][cb]; }
}
template <bool DUMMY> __device__ __forceinline__ void phase_ln1_router(Frame& F, int l) {
    float* H = (float*)(F.ws + WS_H); float* Hout = DUMMY ? (float*)(F.ws + WS_R6) : H; unsigned char* HB8 = F.ws + (DUMMY ? WS_R3 : WS_HB8); const float* stats = (const float*)(F.ws + WS_STATS);
    int* tokinfo = (int*)(F.ws + (DUMMY ? WS_R45 + 4 * MiB : WS_TOKINFO)); int* elist = (int*)(F.ws + (DUMMY ? WS_R45 : WS_ELIST)); unsigned* count = (unsigned*)(F.ws + WS_CTL) + CW_COUNT + ((DUMMY ? 64 : 0) + l * 32) * CNT_STRIDE;
    const float* g1 = F.I(I_LN1G) + (size_t)l * D; const float* b1 = F.I(I_LN1B) + (size_t)l * D;
    const bf16* whi = (const bf16*)(F.ws + WS_WRT) + (size_t)(l * 2) * 48 * 2048; const bf16* wlo = whi + 48 * 2048;
    const float* bg = F.I(I_RGB) + l * 4; const float* be = F.I(I_REB) + l * 32;
    const int lane = F.lane, p = lane & 15, kg = lane >> 4, wave = F.wave;
    ln1_groups<4, DUMMY>(F, l, 0); if (F.vcu + 4 * F.G < NTOK / 16) ln1_groups<1, DUMMY>(F, l, 4);
    __syncthreads();
    LAS unsigned* lcnt = (LAS unsigned*)(F.lds + TBL_OFF + 512);
    if (F.tid < 64) lcnt[F.tid] = 0u;
    __syncthreads();
    int ea = 0, eb = 0, n = 0; unsigned la = 0u, lb = 0u; float w0 = 0.f, w1 = 0.f; bool have = false;
    { const int grp = F.vcu + wave * F.G;
        if (grp < NTOK / 16 && lane < 16) {
            const LAS float* lgs = (const LAS float*)(F.lds + wave * 24576);
            n = grp * 16 + lane; have = true; float lg[36];
            const f32x4 bgv = *(const f32x4*)bg; f32x4 bev[8];
#pragma unroll
            for (int i = 0; i < 8; ++i) bev[i] = *(const f32x4*)(be + 4 * i);
#pragma unroll
            for (int i = 0; i < 36; ++i) lg[i] = 0.f;
#pragma unroll 1
            for (int w = 0; w < 8; ++w) {
#pragma unroll
                for (int i4 = 0; i4 < 9; ++i4) { const f32x4 t = *(const LAS f32x4*)(lgs + (w * 16 + lane) * 48 + 4 * i4); lg[4 * i4] += t[0]; lg[4 * i4 + 1] += t[1]; lg[4 * i4 + 2] += t[2]; lg[4 * i4 + 3] += t[3]; } }
            float gl[4];
#pragma unroll
            for (int i = 0; i < 4; ++i) gl[i] = lg[i] + bgv[i];
            int g = 0; float gm = gl[0];
#pragma unroll
            for (int i = 1; i < 4; ++i) if (gl[i] > gm) { gm = gl[i]; g = i; }
            float gs = 0.f;
#pragma unroll
            for (int i = 0; i < 4; ++i) gs += fast_exp(gl[i] - gm);
            const float pg = 1.0f / gs;
            float el[8];
#pragma unroll
            for (int j = 0; j < 8; ++j) { const float x0 = lg[4 + j] + bev[j >> 2][j & 3], x1 = lg[12 + j] + bev[2 + (j >> 2)][j & 3], x2 = lg[20 + j] + bev[4 + (j >> 2)][j & 3], x3 = lg[28 + j] + bev[6 + (j >> 2)][j & 3]; el[j] = g == 0 ? x0 : g == 1 ? x1 : g == 2 ? x2 : x3; }
            int i0 = 0; float m0 = el[0];
#pragma unroll
            for (int j = 1; j < 8; ++j) if (el[j] > m0) { m0 = el[j]; i0 = j; }
            int i1 = -1; float m1 = -3.0e38f;
#pragma unroll
            for (int j = 0; j < 8; ++j) if (j != i0 && el[j] > m1) { m1 = el[j]; i1 = j; }
            const float e1 = fast_exp(m1 - m0); w0 = pg / (1.0f + e1); w1 = pg * e1 / (1.0f + e1);
            ea = g * 8 + i0; eb = g * 8 + i1;
            la = __hip_atomic_fetch_add(lcnt + ea, 1u, __ATOMIC_RELAXED, __HIP_MEMORY_SCOPE_WORKGROUP); lb = __hip_atomic_fetch_add(lcnt + eb, 1u, __ATOMIC_RELAXED, __HIP_MEMORY_SCOPE_WORKGROUP);
        }
    }
    __syncthreads();
    if (F.tid < 32) { const unsigned c = lcnt[F.tid]; lcnt[32 + F.tid] = c ? __hip_atomic_fetch_add(count + F.tid * CNT_STRIDE, c, RLX_AGENT) : 0u; }
    __syncthreads();
    if (have) { const unsigned ra = lcnt[32 + ea] + la, rb = lcnt[32 + eb] + lb;
        elist[(size_t)ea * NTOK + ra] = n; elist[(size_t)eb * NTOK + rb] = n;
        int* ti = tokinfo + (size_t)n * 8; ti[0] = ea; ti[1] = (int)ra; ti[2] = __float_as_int(w0); ti[3] = eb; ti[4] = (int)rb; ti[5] = __float_as_int(w1); }
    __syncthreads();
    const int gw = F.vcu * 8 + F.wave, NGW = F.G * 8;
    LAS float* scr = (LAS float*)(F.lds + F.wave * 16384);
    if (!DUMMY) {
        if (F.G == 256) {
            const int TW = (NTOK / 16 - 4 * 256) * 8;
            const int nr = F.vcu < 4 ? 20 : 24;
            for (int k = 0; k < nr; ++k) conv_expert_weights(F, l, k * NGW + gw, scr);
            const int w = gw - TW; if (w >= 0 && w < 4 * TW) conv_expert_weights(F, l, (20 + w / TW) * NGW + (w % TW), scr);
        } else for (int it = gw; it < 49152; it += NGW) conv_expert_weights(F, l, it, scr);
    }
}
__device__ __forceinline__ void moe_tables(Frame& F, int l) {
    LAS int* tb = (LAS int*)(F.lds + TBL_OFF);
    __syncthreads();
    if (F.tid < 64) { const unsigned* count = (const unsigned*)(F.ws + WS_CTL) + CW_COUNT + l * 32 * CNT_STRIDE; const int e = F.tid;
        const int cn = e < 32 ? (int)__hip_atomic_load(count + e * CNT_STRIDE, RLX_AGENT) : 0; const int tiles = (cn + 255) >> 8; int incl = tiles;
#pragma unroll
        for (int d = 1; d < 32; d <<= 1) { const int t = __shfl_up(incl, d); if (e >= d) incl += t; }
        if (e < 32) { tb[e] = incl - tiles; tb[40 + e] = cn; } if (e == 31) tb[32] = incl; }
    __syncthreads();
}
template <bool DUMMY> __device__ __forceinline__ void phase_final(Frame& F, int l) {
    float* H = (float*)(F.ws + WS_H); bf16* HB = (bf16*)(F.ws + (DUMMY ? WS_R45 : WS_HB)); float* Hout = DUMMY ? (float*)(F.ws + WS_R6) : H; unsigned char* H8 = F.ws + (DUMMY ? WS_R3 : WS_HB8); const unsigned char* yd = F.ws + WS_R1; const int* tokinfo = (const int*)(F.ws + WS_TOKINFO);
    const LAS int* tb = (const LAS int*)(F.lds + TBL_OFF);
    const float* g2 = F.I(I_LN2G) + (size_t)l * D; const float* b2 = F.I(I_LN2B) + (size_t)l * D; const float* g1 = F.I(I_LN1G) + (size_t)l * D; const float* b1 = F.I(I_LN1B) + (size_t)l * D; const float* stats = (const float*)(F.ws + WS_STATS);
    const int gw = F.vcu * 8 + F.wave, NGW = F.G * 8, lane = F.lane;
    LAS float* lv = (LAS float*)F.lds;
    { const int i4 = 4 * F.tid; *(LAS f32x4*)(lv + i4) = *(const f32x4*)(g1 + i4); *(LAS f32x4*)(lv + 2048 + i4) = *(const f32x4*)(b1 + i4); *(LAS f32x4*)(lv + 4096 + i4) = *(const f32x4*)(g2 + i4); *(LAS f32x4*)(lv + 6144 + i4) = *(const f32x4*)(b2 + i4); }
    __syncthreads();
    for (int n = gw; n < NTOK; n += NGW) {
        const int t = n % LSEQ, b = n / LSEQ;
        if (!DUMMY && l == DEPTH - 1 && t < NMETA) continue;
        const int* ti = tokinfo + (size_t)n * 8; const int ea = ti[0], ra = ti[1], eb = ti[3], rb = ti[4]; const float w0 = __int_as_float(ti[2]) * (1.0f / YD_SCALE), w1 = __int_as_float(ti[5]) * (1.0f / YD_SCALE);
        const unsigned char* ya = yd + ((size_t)tb[ea] * 256 + ra) * D; const unsigned char* yb = yd + ((size_t)tb[eb] * 256 + rb) * D;
        f32x4 v[8]; load_row_f32(H + (size_t)n * D, v, lane);
        { float s = 0.f, q = 0.f;
          if (lane < 16) { const f32x4 t = *(const f32x4*)(stats + (size_t)n * 64 + 4 * lane); s = t[0] + t[2]; q = t[1] + t[3]; }
          s = wave_sum(s); q = wave_sum(q);
          const float mean = s * (1.f / D), rstd = 1.f / sqrtf(fmaxf(q * (1.f / D) - mean * mean, 0.f) + LN_EPS);
#pragma unroll
          for (int j = 0; j < 8; ++j) { const f32x4 gg = *(const LAS f32x4*)(lv + 4 * lane + 256 * j), bb = *(const LAS f32x4*)(lv + 2048 + 4 * lane + 256 * j); v[j] = (v[j] - mean) * rstd * gg + bb; } }
#pragma unroll
        for (int j = 0; j < 8; ++j) { const unsigned a = *(const unsigned*)(ya + 4 * lane + 256 * j), c = *(const unsigned*)(yb + 4 * lane + 256 * j);
            const f32x2 a0 = __builtin_amdgcn_cvt_pk_f32_fp8((int)a, false), a1 = __builtin_amdgcn_cvt_pk_f32_fp8((int)a, true), c0 = __builtin_amdgcn_cvt_pk_f32_fp8((int)c, false), c1 = __builtin_amdgcn_cvt_pk_f32_fp8((int)c, true);
            v[j].x = v[j].x * ALPHA + w0 * a0.x + w1 * c0.x; v[j].y = v[j].y * ALPHA + w0 * a0.y + w1 * c0.y;
            v[j].z = v[j].z * ALPHA + w0 * a1.x + w1 * c1.x; v[j].w = v[j].w * ALPHA + w0 * a1.y + w1 * c1.y; }
        ln_regs_lds(v, lv + 4096, lv + 6144, lane);
        if (!DUMMY && l == DEPTH - 1) store_row_f32(F.out + ((size_t)b * SEQ + (t - NMETA)) * D, v, lane);
        else { store_row_f32(Hout + (size_t)n * D, v, lane); store_row_bf16(HB + (size_t)n * D, v, lane); store_row_fp8(H8 + (size_t)n * D, v, lane); }
    }
}

constexpr int NPHASE = 1 + DEPTH * 11;
#define IN(k) (lo <= (k) && (k) < hi)
#define SEAM(k) do { if (IN(k) && IN((k) + 1)) { XcdBarrier b_ = bar; asm volatile("" : "+s"(b_.bar), "+s"(b_.x)); xcd_barrier(b_); } } while (0)
#define PH_BEGIN() F.z = opaque_s(0); F.ws = args.ws + F.z; F.vcu = vcu0 + F.z; F.tid = opaque_v(tid0); F.lane = F.tid & 63; F.wave = __builtin_amdgcn_readfirstlane(F.tid >> 6); const int bx = bx0 + F.z; (void)bx
template <int L> __device__ __forceinline__ void run_layer(Frame& F, const Args& args, const XcdBarrier& bar, const int lo, const int hi, const int bx0, const int vcu0, const int tid0) {
    constexpr int l = L; constexpr int pb = 1 + L * 11;
#define wl (F.ws + WS_WSMALL + (size_t)l * WL_BYTES)
        if (IN(pb + 0)) PREP(1) { PH_BEGIN();
            { PolA_<false> p; p.K = D; p.lda = D; p.ldb = D; p.A = F.ws + WS_HB; p.Bt = wl + WL_WIN; p.out = (bf16*)(F.ws + WS_R2); p.outc = p.out; p.G = F.G; p.c = bx;
              pg8::gemm_phase(F.lds, p, F.tid, F.ws); }
            { PolA_<true> p; p.K = D; p.lda = D; p.ldb = D; p.A = F.ws + WS_HB8; p.Bt = wl + WL_WIN8; p.out = (bf16*)(F.ws + WS_R1); p.outc = (bf16*)(F.ws + WS_R2); p.G = F.G; p.c = (F.G == 256) ? ((bx + A_LIGHT) & 255) : bx;
              pg8::gemm_phase(F.lds, p, F.tid, F.ws); } }
        SEAM(pb + 0);
        if (IN(pb + 1)) PREP(2) { PH_BEGIN();
            { PolW p; p.K = 256; p.lda = 1024; p.ldb = 256; p.pt = (const bf16*)(wl + WL_PROJ); p.wsc = (const bf16*)(F.ws + WS_WSC) + (size_t)l * 4 * 65536; p.wct = (bf16*)(F.ws + WS_WCT) + (size_t)l * D * 1024; p.G = F.G; p.c = (F.vcu + (F.G >> 1)) % F.G;
              pg8::gemm_phase(F.lds, p, F.tid, F.ws); }
            phase_delta_conv(F, l); phase_attn(F, l); }
        SEAM(pb + 1);
        if (IN(pb + 2)) PREP(3) { PH_BEGIN();
            PolC p; p.K = 256; p.lda = 1024; p.ldb = 256; p.delta = (const bf16*)(F.ws + WS_R45); p.xc = p.delta + (size_t)MP * 1024; p.pool_t = (const bf16*)(wl + WL_POOL); p.lru_t = (const bf16*)(wl + WL_LRU);
            p.mix = (bf16*)(F.ws + WS_R3); p.Abuf = (bf16*)(F.ws + WS_R6); p.Bbuf = p.Abuf + (size_t)MP * 1024; p.pool_scale = F.I(I_POOLS) + (size_t)l * 1024; p.ba = F.I(I_BA) + (size_t)l * 1024; p.bx = F.I(I_BX) + (size_t)l * 1024;
            p.sp8 = (const float*)(F.ws + WS_SP8) + (size_t)l * 1024; p.G = F.G; p.c = bx;
            pg8::gemm_phase(F.lds, p, F.tid, F.ws); tail_lru(F, l); }
        SEAM(pb + 2);
        if (IN(pb + 3)) PREP(4) { PH_BEGIN(); phase_lru_summ(F); }
        SEAM(pb + 3);
        if (IN(pb + 4)) PREP(5) { PH_BEGIN(); phase_lru_final(F); }
        SEAM(pb + 4);
        if (IN(pb + 5)) PREP(6) { PH_BEGIN();
            PolE p; p.K = 1024; p.lda = 3072; p.ldb = 1024; p.mix = (const bf16*)(F.ws + WS_R3); p.proj_t = (const bf16*)(wl + WL_PROJ); p.wct = (const bf16*)(F.ws + WS_WCT) + (size_t)l * D * 1024; p.gates = F.ws + WS_R1; p.merged = (bf16*)(F.ws + WS_R45); p.G = F.G; p.c = bx;
            p.t0 = 0; p.t1 = 512; pg8::gemm_phase(F.lds, p, F.tid, F.ws); tail_merge(F, l); }
        SEAM(pb + 5);
        if (IN(pb + 6)) PREP(7) { PH_BEGIN();
            PolF p; p.K = D; p.lda = D; p.ldb = D; p.A = (const bf16*)(F.ws + WS_R45); p.Bt = (const bf16*)(wl + WL_WOUT); p.H = (float*)(F.ws + WS_H); p.stats = (float*)(F.ws + WS_STATS); p.G = F.G; p.c = bx;
            p.t0 = 0; p.t1 = 512; pg8::gemm_phase(F.lds, p, F.tid, F.ws); tail_wout(F, l); }
        SEAM(pb + 6);
        if (IN(pb + 7)) PREP(8) { PH_BEGIN(); if (PROBE_G2) phase_ln1_router<true>(F, l); phase_ln1_router<false>(F, l); }
        SEAM(pb + 7);
        if (IN(pb + 8)) PREP(9) { PH_BEGIN();
            moe_tables(F, l);
            PolI p; p.K = D; p.lda = D; p.ldb = D; p.X = F.ws + WS_HB8; p.gu = F.ws + WS_R2 + EXPW_GU; p.elist = (const int*)(F.ws + WS_ELIST); p.hdn = F.ws + WS_R3;
            p.T.t = (const LAS int*)(F.lds + TBL_OFF); p.G = F.G; p.c = bx;
            pg8::gemm_phase(F.lds, p, F.tid, F.ws); }
        SEAM(pb + 8);
        if (IN(pb + 9)) PREP(10) { PH_BEGIN();
            moe_tables(F, l);
            PolJ p; p.K = DE; p.lda = DE; p.ldb = DE; p.hdn = F.ws + WS_R3; p.wd = F.ws + WS_R2 + EXPW_WD; p.yd = F.ws + WS_R1; p.T.t = (const LAS int*)(F.lds + TBL_OFF); p.G = F.G; p.c = bx;
            pg8::gemm_phase(F.lds, p, F.tid, F.ws); }
        SEAM(pb + 9);
        if (IN(pb + 10)) PREP(11) { PH_BEGIN(); moe_tables(F, l); if (PROBE_K2) phase_final<true>(F, l); phase_final<false>(F, l); }
        SEAM(pb + 10);
    }
#undef wl
__global__ void __launch_bounds__(512, 2) fwd(Args args) {
    extern __shared__ __attribute__((aligned(16))) unsigned char lds_raw[];
    Frame F; F.lds = (LAS unsigned char*)lds_raw; F.inp = args.in; F.z = 0; F.out = args.out; F.ws = args.ws;
    F.tid = threadIdx.x; F.lane = F.tid & 63; F.wave = __builtin_amdgcn_readfirstlane(F.tid >> 6);
    F.G = gridDim.x; { const int bx = blockIdx.x; F.vcu = (F.G % 8 == 0) ? (bx % 8) * (F.G / 8) + bx / 8 : bx; }
    volatile LAS unsigned* MISC = (volatile LAS unsigned*)(F.lds + MISC_OFF);
    for (int u = F.tid; u < (LDS_BYTES - MISC_OFF) / 4; u += 512) ((LAS unsigned*)(F.lds + MISC_OFF))[u] = 0u;
    __syncthreads();
    unsigned* ctl = (unsigned*)(F.ws + WS_CTL);
    XcdBarrier bar; bar.bar = ctl + CW_BAR; bar.x = 0; bar.st = nullptr;
    if (MK_ONE_LAUNCH) bar = xcd_barrier_post(ctl + CW_BAR, MISC + 8);
    const int lo = args.ph_lo, hi = args.ph_hi;
    const int bx0 = (int)blockIdx.x, vcu0 = F.vcu, tid0 = F.tid;

    if (IN(0)) PREP(0) { PH_BEGIN(); p0_prologue(F); } SEAM(0);

    run_layer<0>(F, args, bar, lo, hi, bx0, vcu0, tid0);
    run_layer<1>(F, args, bar, lo, hi, bx0, vcu0, tid0);
#undef IN
#undef SEAM
}

extern "C" void kernel_launch(void* const* d_in, const int* in_sizes, int n_in, void* d_out, int out_size, void* d_ws, size_t ws_size, hipStream_t stream) {
    static int grid = 0;
    if (grid == 0) {
        if (n_in != 30 || out_size != NB * SEQ * D || ws_size < WS_END) { fprintf(stderr, "kernel_launch: unexpected shapes (n_in %d, out %d, ws %zu)\n", n_in, out_size, ws_size); grid = -1; return; }
        int dev = 0, cus = 0, per_cu = 0;
        if (hipGetDevice(&dev) != hipSuccess || hipDeviceGetAttribute(&cus, hipDeviceAttributeMultiprocessorCount, dev) != hipSuccess) { grid = -1; return; }
        if (hipFuncSetAttribute((const void*)fwd, hipFuncAttributeMaxDynamicSharedMemorySize, LDS_BYTES) != hipSuccess) { fprintf(stderr, "kernel_launch: hipFuncSetAttribute failed\n"); grid = -1; return; }
        if (hipOccupancyMaxActiveBlocksPerMultiprocessor(&per_cu, (const void*)fwd, 512, LDS_BYTES) != hipSuccess || per_cu < 1) fprintf(stderr, "kernel_launch: occupancy query says %d\n", per_cu);
        (void)hipGetLastError();
        grid = cus;
    }
    if (grid < 0) return;
    (void)hipMemsetAsync((char*)d_ws + WS_CTL, 0, CTL_ZERO_BYTES, stream);
    Args a{};
    for (int i = 0; i < 30; ++i) a.in[i] = (const float*)d_in[i];
    a.out = (float*)d_out; a.ws = (unsigned char*)d_ws;
#if MK_ONE_LAUNCH
    a.ph_lo = 0; a.ph_hi = NPHASE;
    hipLaunchKernelGGL(fwd, dim3(grid), dim3(512), LDS_BYTES, stream, a);
#else
    for (int k = 0; k < NPHASE; ++k) { a.ph_lo = k; a.ph_hi = k + 1; hipLaunchKernelGGL(fwd, dim3(grid), dim3(512), LDS_BYTES, stream, a); }
#endif
}
```

```cpp
#include <hip/hip_runtime.h>
#include <cstdio>
#include <cstdint>

#define PROBE_MASK 0
#define PROBE_K2 0
#define PROBE_G2 0
#define PREP(k) for (int rep_ = 0; rep_ < (((PROBE_MASK) >> (k)) & 1) + 1; ++rep_)
#ifndef MK_ONE_LAUNCH
#define MK_ONE_LAUNCH 1
#endif

#define LAS __attribute__((address_space(3)))
#define GAS __attribute__((address_space(1)))
typedef unsigned short bf16;
typedef short bf16x8 __attribute__((ext_vector_type(8)));
typedef float f32x4 __attribute__((ext_vector_type(4)));
typedef float f32x2 __attribute__((ext_vector_type(2)));
typedef unsigned u32x4 __attribute__((ext_vector_type(4)));
typedef unsigned u32x2 __attribute__((ext_vector_type(2)));
typedef __bf16 bf16x2_t __attribute__((ext_vector_type(2)));
typedef int i32x4 __attribute__((ext_vector_type(4)));
typedef int i32x8 __attribute__((ext_vector_type(8)));
typedef GAS unsigned gu32;
#define RLX_AGENT __ATOMIC_RELAXED, __HIP_MEMORY_SCOPE_AGENT
#define LDS_WAIT() asm volatile("s_waitcnt lgkmcnt(0)" ::: "memory")
#define VM_WAIT() asm volatile("s_waitcnt vmcnt(0)" ::: "memory")

constexpr int D = 2048, NB = 4, SEQ = 4096, NMETA = 16, LSEQ = SEQ + NMETA, NTOK = NB * LSEQ  , MP = 16640  , NPANEL = 65, DEPTH = 2;
constexpr int CW = 4608  , GW = 6144, INC = CW + GW;
#ifndef A8_MASK
#define A8_MASK 0x3FE00u
#endif
constexpr int C_POOL = 0, C_Q = 1024, C_K = 2048, C_V = 2304, C_LX = 2560, C_LY = 3584;
constexpr int NEXP = 32, DE = 512, CAPT = 161, CAP = CAPT * 256, NCHUNK = (NTOK + 63) / 64  ;
constexpr float LN_EPS = 1e-5f, ALPHA = 1.41421356237f;

constexpr size_t MiB = 1u << 20;
constexpr size_t WS_CTL = 0, CTL_ZERO_BYTES = 1 * MiB;
constexpr size_t WS_SP8 = 1 * MiB;
constexpr size_t WS_TOKINFO = 2 * MiB;
constexpr size_t WS_ELIST = 3 * MiB;
constexpr size_t WS_SUMM = 6 * MiB;
constexpr size_t WS_WSMALL = 9 * MiB;
constexpr size_t WL_WIN8 = (size_t)CW * 2048 * 2;
constexpr size_t WL_BYTES = 66584576, WL_WIN = 0, WL_PROJ = 44040192, WL_WOUT = 56623104, WL_POOL = 65011712, WL_LRU = 65536000;
constexpr size_t WS_H = 136 * MiB;
constexpr size_t WS_HB = 266 * MiB;
constexpr size_t WS_R1 = 331 * MiB;
constexpr size_t WS_R2 = 526 * MiB;
constexpr size_t WS_R6 = 673 * MiB;
constexpr size_t WS_R3 = 803 * MiB;
constexpr size_t WS_R45 = 901 * MiB;
constexpr size_t WS_STATS = 966 * MiB;
constexpr size_t WS_WRT = 972 * MiB;
constexpr size_t WS_HB8 = 974 * MiB;
constexpr size_t WS_WSC = 1008 * MiB;
constexpr size_t WS_WCT = 1010 * MiB;
constexpr size_t WS_END = 1018 * MiB;
constexpr size_t EXPW_GU = 0, EXPW_WD = 67108864;
constexpr float W8_SCALE = 64.0f, HDN_SCALE = 8.0f, YD_SCALE = 16.0f;
static_assert(WS_WSMALL + 2 * WL_BYTES <= WS_H && WS_R2 + 201326592 <= WS_R3 && WS_R6 + 2ull * MP * 1024 * 4 <= WS_R3 && WS_R3 + (size_t)MP * 3072 * 2 <= WS_R45 && WS_R45 + (size_t)MP * 2048 * 2 <= WS_END, "ws map");
static_assert(WS_R1 + (size_t)MP * GW * 2 <= WS_R2 && (size_t)CAP * 2048 * 2 <= (size_t)MP * GW * 2 && WS_R2 + (size_t)MP * CW * 2 <= WS_R6, "ws map 2");
constexpr int CW_BAR = 4096;
constexpr int CW_COUNT = 16384, CNT_STRIDE = 32;

constexpr int RING_BYTES = 131072, MISC_OFF = RING_BYTES, TBL_OFF = RING_BYTES + 1024, VEC_OFF = TBL_OFF + 2048  , LDS_BYTES = VEC_OFF + 16384;

__device__ __forceinline__ unsigned pk_bf16(float lo, float hi) { f32x2 v = {lo, hi}; bf16x2_t b = __builtin_convertvector(v, bf16x2_t); return __builtin_bit_cast(unsigned, b); }
__device__ __forceinline__ unsigned pk_fp8x4(float a, float b, float c, float d) { int w = 0; w = __builtin_amdgcn_cvt_pk_fp8_f32(a, b, w, false); w = __builtin_amdgcn_cvt_pk_fp8_f32(c, d, w, true); return (unsigned)w; }
__device__ __forceinline__ float bf2f(unsigned short b) { return __uint_as_float(((unsigned)b) << 16); }
__device__ __forceinline__ float bflo(unsigned w) { return __uint_as_float(w << 16); }
__device__ __forceinline__ float bfhi(unsigned w) { return __uint_as_float(w & 0xffff0000u); }
__device__ __forceinline__ float fast_exp(float x) { return __builtin_amdgcn_exp2f(x * 1.44269504089f); }
__device__ __forceinline__ float sigmoidf_(float x) { return __builtin_amdgcn_rcpf(1.0f + fast_exp(-x)); }
__device__ __forceinline__ unsigned pk_gate4(float a, float b, float c, float d) {
    unsigned r = __builtin_amdgcn_cvt_pk_u8_f32(a * 255.0f, 0u, 0u); r = __builtin_amdgcn_cvt_pk_u8_f32(b * 255.0f, 1u, r); r = __builtin_amdgcn_cvt_pk_u8_f32(c * 255.0f, 2u, r); return __builtin_amdgcn_cvt_pk_u8_f32(d * 255.0f, 3u, r); }
__device__ __forceinline__ float wave_sum(float v) {
#pragma unroll
    for (int o = 1; o < 64; o <<= 1) v += __shfl_xor(v, o);
    return v;
}
__device__ __forceinline__ float wave_max(float v) {
#pragma unroll
    for (int o = 1; o < 64; o <<= 1) v = fmaxf(v, __shfl_xor(v, o));
    return v;
}

namespace pg8 {
constexpr int BM = 256, BK = 64, HALF = 128, HTB = HALF * BK * 2, STAGE_BYTES = 8 * HTB;
__host__ __device__ __forceinline__ int lds_byte(int r, int c) { const int st = (r >> 4) * 2 + (c >> 5), rr = r & 15, cc = c & 31, ob = rr * 64 + cc * 2; return st * 1024 + (ob ^ (((ob >> 9) & 1) << 5)); }
__host__ __device__ __forceinline__ void stage_rc(int b, int& R, int& C) { const int st = b / 1024, sb = b % 1024, swz = sb ^ (((sb >> 9) & 1) << 5); R = (st >> 1) * 16 + swz / 64; C = (st & 1) * 32 + (swz % 64) / 2; }
__host__ __device__ __forceinline__ int perm32(int rho) { const int n = rho >> 4, i = rho & 15; return 8 * (i >> 2) + 4 * n + (i & 3); }
struct Unit { int pm, pn, z; };

template <class P, class = void> struct adj_trait { static constexpr bool v = false; };
template <class P> struct adj_trait<P, decltype((void)P::ADJ)> { static constexpr bool v = P::ADJ; };
template <class P> __host__ __device__ constexpr bool adj_b() { return adj_trait<P>::v; }
template <class P, bool TAIL = false>
__device__ __forceinline__ void gemm_phase(LAS unsigned char* lds, const P& p, const int tid, const unsigned char* wsbase) {
    const __amdgpu_buffer_rsrc_t rsrc = __builtin_amdgcn_make_buffer_rsrc((void*)wsbase, 0, 0xffffffffu, 0x00020000);
    const int wid = __builtin_amdgcn_readfirstlane(tid >> 6), lane = tid & 63, wr = wid >> 2, wc = wid & 3, fr = lane & 15, fq = lane >> 4;
    constexpr int ESZ = P::ESZ;
    const int K = p.K, nt = K * ESZ / 128, lda = p.lda, ldb = p.ldb;
    unsigned voffA[2], voffB[2]; int Rr[2], Cc[2];
#pragma unroll
    for (int i = 0; i < 2; ++i) { int R, C; stage_rc(tid * 16 + i * 8192, R, C); Rr[i] = R; Cc[i] = C; const int Rb = adj_b<P>() ? (64 * (R >> 5) + perm32(R & 31)) : (P::PERM ? ((R & ~31) + perm32(R & 31)) : R);
        voffA[i] = (unsigned)(R * lda * ESZ + C * 2); voffB[i] = (unsigned)(Rb * ldb * ESZ + C * 2); }
    const unsigned kstep = (unsigned)(BK * 2);
    const unsigned hstepA = (unsigned)(HALF * lda * ESZ), hstepB = (unsigned)((adj_b<P>() ? 32 : HALF) * ldb * ESZ);
    const unsigned ldsw0 = (unsigned)wid * 1024u; const unsigned ldsw = ldsw0;
    const int aoff = lds_byte(wr * 64 + fr, fq * 8), boff = lds_byte(wc * 32 + fr, fq * 8);
    auto opaque_tid = [&]() { int t_ = tid; asm volatile("" : "+v"(t_)); return t_; };
    unsigned vc[2][2];
#define PG8_SA(b, h) (((b) * 2 + (h)) * HTB)
#define PG8_SB(b, h) ((4 + (b) * 2 + (h)) * HTB)
#define PG8_GLDS(so, vo, ldsoff) __builtin_amdgcn_raw_ptr_buffer_load_lds(rsrc, (LAS void*)(lds + (ldsoff)), 16, (int)(vo), (int)(so), 0, 0)
#define PG8_STAGE_B(bufoff, gb) do { PG8_GLDS((gb), voffB[0], (bufoff) + ldsw); PG8_GLDS((gb), voffB[1], (bufoff) + ldsw + 8192); } while (0)
#define PG8_STAGE_A(bufoff, ga, h, NX) do { if constexpr (P::GATHER) { PG8_GLDS((ga), vc[h][0], (bufoff) + ldsw); PG8_GLDS((ga), vc[h][1], (bufoff) + ldsw + 8192); } \
        else { PG8_GLDS((ga) + (h) * hstepA, voffA[0], (bufoff) + ldsw); PG8_GLDS((ga) + (h) * hstepA, voffA[1], (bufoff) + ldsw + 8192); } } while (0)
#define PG8_LDA(dst, b, h) do { if constexpr (TAIL) { if ((h) == 1 || wr == 1) break; } _Pragma("unroll") for (int m = 0; m < 4; ++m) _Pragma("unroll") for (int k = 0; k < 2; ++k) dst[m][k] = *(const LAS bf16x8*)(lds + PG8_SA(b, h) + aoff + m * 2048 + k * 1024); } while (0)
#define PG8_LDB(dst, b, h) do { if constexpr (TAIL) { if (wr == 1) break; } _Pragma("unroll") for (int n = 0; n < 2; ++n) _Pragma("unroll") for (int k = 0; k < 2; ++k) dst[n][k] = *(const LAS bf16x8*)(lds + PG8_SB(b, h) + boff + n * 2048 + k * 1024); } while (0)
#define PG8_MMA(ai, bj, At, Bt) do { if constexpr (TAIL) { if ((ai) == 1 || wr == 1) break; } __builtin_amdgcn_s_setprio(1); _Pragma("unroll") for (int m = 0; m < 4; ++m) _Pragma("unroll") for (int n = 0; n < 2; ++n) { \
        if constexpr (ESZ == 2) { _Pragma("unroll") for (int k = 0; k < 2; ++k) acc[ai][bj][m][n] = __builtin_amdgcn_mfma_f32_16x16x32_bf16(Bt[n][k], At[m][k], acc[ai][bj][m][n], 0, 0, 0); } \
        else { const i32x8 b8_ = __builtin_shufflevector(__builtin_bit_cast(i32x4, Bt[n][0]), __builtin_bit_cast(i32x4, Bt[n][1]), 0, 1, 2, 3, 4, 5, 6, 7), a8_ = __builtin_shufflevector(__builtin_bit_cast(i32x4, At[m][0]), __builtin_bit_cast(i32x4, At[m][1]), 0, 1, 2, 3, 4, 5, 6, 7); \
               asm volatile("v_mfma_f32_16x16x128_f8f6f4 %0, %1, %2, %0" : "+v"(acc[ai][bj][m][n]) : "v"(b8_), "v"(a8_)); } } \
        __builtin_amdgcn_s_setprio(0); } while (0)
#define PG8_WAIT_V(n) asm volatile("s_waitcnt vmcnt(" #n ")" ::: "memory")
#define PG8_WAIT_L(n) asm volatile("s_waitcnt lgkmcnt(" #n ")" ::: "memory")
#define PG8_BAR __builtin_amdgcn_s_barrier()
#define PG8_SCHED __builtin_amdgcn_sched_barrier(0)
#define PG8_ROWOFFS(dst, u) do { _Pragma("unroll") for (int i_ = 0; i_ < 2; ++i_) { int R_, C_; stage_rc(opaque_tid() * 16 + i_ * 8192, R_, C_); _Pragma("unroll") for (int h_ = 0; h_ < 2; ++h_) dst[h_][i_] = (unsigned)(p.a_row(u, h_ * HALF + R_) * lda * ESZ + C_ * 2); } } while (0)
    Unit cur, nxt; int ui = 0;
    if (!p.next(0, cur)) return;
    f32x4 acc[2][2][4][2];
#pragma unroll
    for (int a = 0; a < 2; ++a)
#pragma unroll
        for (int b = 0; b < 2; ++b)
#pragma unroll
            for (int m = 0; m < 4; ++m)
#pragma unroll
                for (int n = 0; n < 2; ++n) acc[a][b][m][n] = (f32x4){0.f, 0.f, 0.f, 0.f};
    bf16x8 At[4][2], B0[2][2], B1[2][2];
    unsigned cA = (unsigned)((const unsigned char*)p.a_ptr(cur) - wsbase), cB = (unsigned)((const unsigned char*)p.b_ptr(cur) - wsbase);
    if constexpr (P::GATHER) { PG8_ROWOFFS(vc, cur); }
    PG8_STAGE_B(PG8_SB(0, 0), cB); PG8_STAGE_B(PG8_SB(0, 1), cB + hstepB); PG8_STAGE_A(PG8_SA(0, 0), cA, 0, false); PG8_STAGE_A(PG8_SA(0, 1), cA, 1, false);
    if (wr == 1) PG8_BAR;
    PG8_WAIT_V(2); PG8_BAR;
    PG8_STAGE_B(PG8_SB(1, 0), cB + kstep); PG8_STAGE_A(PG8_SA(1, 0), cA + kstep, 0, false); PG8_STAGE_B(PG8_SB(1, 1), cB + hstepB + kstep);
    PG8_WAIT_V(6); PG8_BAR;
    for (;;) {
        const bool has_next = p.next(ui + 1, nxt);
        const unsigned nA = has_next ? (unsigned)((const unsigned char*)p.a_ptr(nxt) - wsbase) : cA, nB = has_next ? (unsigned)((const unsigned char*)p.b_ptr(nxt) - wsbase) : cB;
        for (int t = 0; t < nt; t += 2) {
            const bool last = (t == nt - 2);
            unsigned ldsw = ldsw0; asm volatile("" : "+s"(ldsw));
            const unsigned a1 = cA + (unsigned)(t + 1) * kstep;
            const unsigned a2 = last ? nA : cA + (unsigned)(t + 2) * kstep, b2 = last ? nB : cB + (unsigned)(t + 2) * kstep;
            const unsigned a3 = a2 + kstep, b3 = b2 + kstep;
            unsigned vt[2][2];
            if constexpr (P::GATHER) { if (last && has_next) { PG8_ROWOFFS(vt, nxt); } }
            PG8_LDB(B0, 0, 0); PG8_LDB(B1, 0, 1); PG8_SCHED; PG8_LDA(At, 0, 0); PG8_STAGE_A(PG8_SA(1, 1), a1, 1, false);
            PG8_WAIT_V(8); PG8_WAIT_L(0); PG8_BAR; PG8_MMA(0, 0, At, B0); PG8_MMA(0, 1, At, B1); PG8_BAR; PG8_SCHED;
            if constexpr (P::GATHER) { if (last && has_next) {
#pragma unroll
                for (int h = 0; h < 2; ++h) { vc[h][0] = vt[h][0]; vc[h][1] = vt[h][1]; } } }
            PG8_LDA(At, 0, 1); PG8_STAGE_B(PG8_SB(0, 0), b2); PG8_STAGE_B(PG8_SB(0, 1), b2 + hstepB); PG8_STAGE_A(PG8_SA(0, 0), a2, 0, last);
            PG8_WAIT_V(8); PG8_WAIT_L(0); PG8_BAR; PG8_MMA(1, 0, At, B0); PG8_MMA(1, 1, At, B1); PG8_BAR; PG8_SCHED;
            PG8_LDB(B0, 1, 0); PG8_LDB(B1, 1, 1); PG8_SCHED; PG8_LDA(At, 1, 0); PG8_STAGE_A(PG8_SA(0, 1), a2, 1, last);
            PG8_WAIT_V(8); PG8_WAIT_L(0); PG8_BAR; PG8_MMA(0, 0, At, B0); PG8_MMA(0, 1, At, B1); PG8_BAR; PG8_SCHED;
            PG8_LDA(At, 1, 1); PG8_STAGE_B(PG8_SB(1, 0), b3); PG8_STAGE_B(PG8_SB(1, 1), b3 + hstepB); PG8_STAGE_A(PG8_SA(1, 0), a3, 0, last);
            PG8_WAIT_V(8); PG8_WAIT_L(0); PG8_BAR; PG8_MMA(1, 0, At, B0); PG8_MMA(1, 1, At, B1); PG8_BAR; PG8_SCHED;
        }
        if constexpr (ESZ == 1) asm volatile("s_nop 15\n\ts_nop 15" ::: "memory");
        if (wr == 0) PG8_BAR;
        bool zero;
        { int t2 = tid; asm volatile("" : "+v"(t2));
          const int l2 = t2 & 63, w2 = __builtin_amdgcn_readfirstlane(t2 >> 6); zero = p.template epi<TAIL>(acc, cur, w2 >> 2, w2 & 3, l2 & 15, l2 >> 4); }
        if (!has_next) break;
        if (zero) {
#pragma unroll
            for (int a = 0; a < 2; ++a)
#pragma unroll
                for (int b = 0; b < 2; ++b)
#pragma unroll
                    for (int m = 0; m < 4; ++m)
#pragma unroll
                        for (int n = 0; n < 2; ++n) acc[a][b][m][n] = (f32x4){0.f, 0.f, 0.f, 0.f};
        }
        cur = nxt; cA = nA; cB = nB; ++ui;
        if (wr == 1) PG8_BAR;
    }
    PG8_WAIT_V(0);
    PG8_BAR;
#undef PG8_SA
#undef PG8_SB
#undef PG8_GLDS
#undef PG8_STAGE_A
#undef PG8_STAGE_B
#undef PG8_LDA
#undef PG8_LDB
#undef PG8_MMA
#undef PG8_WAIT_V
#undef PG8_WAIT_L
#undef PG8_BAR
#undef PG8_SCHED
#undef PG8_ROWOFFS
}
}

#define XB_TMO      128
#define XB_XCNT(j)  (256  + 64 * (j))
#define XB_XSUB(j)  (1280 + 64 * (j))
#define XB_XGEN(j)  (2304 + 64 * (j))
#define XB_TOP      3328
#define XB_TOPGEN   3392
#define XCD_BAR_WORDS 3456
#define XB_SPIN_CAP (1u << 18)
__device__ __forceinline__ unsigned xb_ld(unsigned* p)              { return __hip_atomic_load(p, __ATOMIC_RELAXED, __HIP_MEMORY_SCOPE_AGENT); }
__device__ __forceinline__ unsigned xb_add(unsigned* p, unsigned v) { return __hip_atomic_fetch_add(p, v, __ATOMIC_RELAXED, __HIP_MEMORY_SCOPE_AGENT); }
__device__ __forceinline__ unsigned xb_xcc_id() { return (unsigned)__builtin_amdgcn_s_getreg((3 << 11) | 20) & 0xFu; }
#define XB_SPIN(cond, bar) do { unsigned _sp = 0; while (cond) { __builtin_amdgcn_s_sleep(1); \
    if ((++_sp & 255u) == 0u) { if (xb_ld(&(bar)[XB_TMO])) break; if (_sp > XB_SPIN_CAP) { atomicAdd(&(bar)[XB_TMO], 1u); break; } } } } while (0)
struct XcdBarrier { unsigned* bar; unsigned x; volatile LAS unsigned* st; };
__device__ __forceinline__ XcdBarrier xcd_barrier_post(unsigned* bar, volatile LAS unsigned* st) {
    XcdBarrier b; b.bar = bar; b.x = xb_xcc_id(); b.st = st;
    if (threadIdx.x == 0) (void)xb_add(&bar[XB_XCNT(b.x)], 1u);
    return b;
}
__device__ __forceinline__ void xcd_barrier_complete(unsigned* bar, unsigned x, unsigned& nloc, unsigned& nx) {
    const unsigned G = gridDim.x * gridDim.y * gridDim.z;
    unsigned sum, cnt, mine, sp = 0u;
    for (;;) {
        sum = 0u; cnt = 0u; mine = 0u;
#pragma unroll
        for (unsigned j = 0; j < 16; ++j) { const unsigned c = xb_ld(&bar[XB_XCNT(j)]); sum += c; cnt += (c > 0u) ? 1u : 0u; mine = (j == x) ? c : mine; }
        if (sum == G) break;
        __builtin_amdgcn_s_sleep(1);
        if ((++sp & 255u) == 0u) { if (xb_ld(&bar[XB_TMO])) break; if (sp > XB_SPIN_CAP) { atomicAdd(&bar[XB_TMO], 1u); break; } }
    }
    nloc = mine > 0u ? mine : 1u; nx = cnt > 0u ? cnt : 1u;
}
__device__ __forceinline__ void xcd_barrier(const XcdBarrier& b) {
    asm volatile("s_waitcnt vmcnt(0)" ::: "memory");
    __syncthreads();
    if (threadIdx.x == 0) {
        unsigned* bar = b.bar;
        __builtin_amdgcn_s_waitcnt(0);
        unsigned nloc = b.st[0], nx = b.st[1];
        if (nloc == 0u) { xcd_barrier_complete(bar, b.x, nloc, nx); b.st[0] = nloc; b.st[1] = nx; }
        const unsigned old = xb_add(&bar[XB_XSUB(b.x)], 1u);
        const unsigned gen = old / nloc;
        if (old + 1u == (gen + 1u) * nloc) {
            __builtin_amdgcn_fence(__ATOMIC_RELEASE, "agent");
            asm volatile("s_waitcnt vmcnt(0)" ::: "memory");
            const unsigned og = xb_add(&bar[XB_TOP], 1u);
            const unsigned tg = og / nx;
            if (og + 1u == (tg + 1u) * nx) xb_add(&bar[XB_TOPGEN], 1u);
            else XB_SPIN(xb_ld(&bar[XB_TOPGEN]) == tg, bar);
            __builtin_amdgcn_fence(__ATOMIC_ACQUIRE, "agent");
            xb_add(&bar[XB_XGEN(b.x)], 1u);
            asm volatile("s_waitcnt vmcnt(0)" ::: "memory");
        } else {
            XB_SPIN(xb_ld(&bar[XB_XGEN(b.x)]) == gen, bar);
            __builtin_amdgcn_fence(__ATOMIC_ACQUIRE, "agent");
            asm volatile("s_waitcnt vmcnt(0)" ::: "memory");
        }
    }
    __syncthreads();
}

struct Args { const float* in[30]; float* out; unsigned char* ws; int ph_lo, ph_hi; };
enum { I_X = 0, I_META, I_LNE_G, I_LNE_B, I_WIN, I_POOLW, I_POOLS, I_SINK, I_CONVW, I_CONVB, I_WA, I_BA, I_WX, I_BX, I_LAM, I_PPOOL, I_PATTN, I_PLRU, I_WOUT,
       I_LN1G, I_LN1B, I_RGW, I_RGB, I_REW, I_REB, I_EG, I_EU, I_ED, I_LN2G, I_LN2B };

struct Frame {
    LAS unsigned char* lds;
    const float* const* inp; float* out; unsigned char* ws;
    int tid, lane, wave, vcu, G, z;
    __device__ __forceinline__ const float* I(int k) const { return inp[k + z]; }
};
__device__ __forceinline__ int opaque_s(int x) { asm volatile("" : "+s"(x)); return x; }
__device__ __forceinline__ int opaque_v(int x) { asm volatile("" : "+v"(x)); return x; }

__device__ __forceinline__ void transpose_item(const float* W, int ldw, int k0, int n0, bf16* WT, int ldt, int drow0, LAS float* scr, int lane) {
    f32x4 v[8]; const int kr = lane >> 3, nq = (lane & 7) * 4;
#pragma unroll
    for (int i = 0; i < 8; ++i) v[i] = __builtin_nontemporal_load((const f32x4*)(W + (size_t)(k0 + 8 * i + kr) * ldw + n0 + nq));
#pragma unroll
    for (int i = 0; i < 8; ++i) { LAS float* d = scr + (8 * i + kr) * 33 + nq; d[0] = v[i][0]; d[1] = v[i][1]; d[2] = v[i][2]; d[3] = v[i][3]; }
    LDS_WAIT();
    const int c = lane & 7;
#pragma unroll
    for (int j = 0; j < 4; ++j) { const int n = (lane >> 3) + 8 * j; const LAS float* s = scr + (8 * c) * 33 + n;
        u32x4 o; o.x = pk_bf16(s[0 * 33], s[1 * 33]); o.y = pk_bf16(s[2 * 33], s[3 * 33]); o.z = pk_bf16(s[4 * 33], s[5 * 33]); o.w = pk_bf16(s[6 * 33], s[7 * 33]);
        *(u32x4*)(WT + (size_t)(drow0 + n) * ldt + k0 + 8 * c) = o; }
    LDS_WAIT();
}

__device__ __forceinline__ void transpose_item8(const float* W, int ldw, int k0, int n0, unsigned char* WT, int ldt, int drow0, float scale, LAS float* scr, int lane) {
    f32x4 v[8]; const int kr = lane >> 3, nq = (lane & 7) * 4;
#pragma unroll
    for (int i = 0; i < 8; ++i) v[i] = __builtin_nontemporal_load((const f32x4*)(W + (size_t)(k0 + 8 * i + kr) * ldw + n0 + nq));
#pragma unroll
    for (int i = 0; i < 8; ++i) { LAS float* d = scr + (8 * i + kr) * 33 + nq; d[0] = v[i][0]; d[1] = v[i][1]; d[2] = v[i][2]; d[3] = v[i][3]; }
    LDS_WAIT();
    const int c = lane & 3;
#pragma unroll
    for (int j = 0; j < 2; ++j) { const int n = (lane >> 2) + 16 * j; const LAS float* s = scr + (16 * c) * 33 + n;
        u32x4 o; o.x = pk_fp8x4(s[0 * 33] * scale, s[1 * 33] * scale, s[2 * 33] * scale, s[3 * 33] * scale); o.y = pk_fp8x4(s[4 * 33] * scale, s[5 * 33] * scale, s[6 * 33] * scale, s[7 * 33] * scale);
        o.z = pk_fp8x4(s[8 * 33] * scale, s[9 * 33] * scale, s[10 * 33] * scale, s[11 * 33] * scale); o.w = pk_fp8x4(s[12 * 33] * scale, s[13 * 33] * scale, s[14 * 33] * scale, s[15 * 33] * scale);
        *(u32x4*)(WT + (size_t)(drow0 + n) * ldt + k0 + 16 * c) = o; }
    LDS_WAIT();
}

__device__ __forceinline__ void ln_regs(f32x4 (&v)[8], const float* g, const float* b, int lane) {
    float s = 0.f;
#pragma unroll
    for (int j = 0; j < 8; ++j) s += (v[j].x + v[j].y) + (v[j].z + v[j].w);
    const float mean = wave_sum(s) * (1.f / D); float s2 = 0.f;
#pragma unroll
    for (int j = 0; j < 8; ++j) { v[j] = v[j] - mean; s2 += (v[j].x * v[j].x + v[j].y * v[j].y) + (v[j].z * v[j].z + v[j].w * v[j].w); }
    const float rstd = 1.f / sqrtf(wave_sum(s2) * (1.f / D) + LN_EPS);
#pragma unroll
    for (int j = 0; j < 8; ++j) { const f32x4 gg = *(const f32x4*)(g + 4 * lane + 256 * j), bb = *(const f32x4*)(b + 4 * lane + 256 * j); v[j] = v[j] * rstd * gg + bb; }
}
__device__ __forceinline__ void ln_regs_lds(f32x4 (&v)[8], const LAS float* g, const LAS float* b, int lane) {
    float s = 0.f;
#pragma unroll
    for (int j = 0; j < 8; ++j) s += (v[j].x + v[j].y) + (v[j].z + v[j].w);
    const float mean = wave_sum(s) * (1.f / D); float s2 = 0.f;
#pragma unroll
    for (int j = 0; j < 8; ++j) { v[j] = v[j] - mean; s2 += (v[j].x * v[j].x + v[j].y * v[j].y) + (v[j].z * v[j].z + v[j].w * v[j].w); }
    const float rstd = 1.f / sqrtf(wave_sum(s2) * (1.f / D) + LN_EPS);
#pragma unroll
    for (int j = 0; j < 8; ++j) { const f32x4 gg = *(const LAS f32x4*)(g + 4 * lane + 256 * j), bb = *(const LAS f32x4*)(b + 4 * lane + 256 * j); v[j] = v[j] * rstd * gg + bb; }
}
__device__ __forceinline__ void store_row_bf16(bf16* orow, const f32x4 (&v)[8], int lane) {
#pragma unroll
    for (int j = 0; j < 8; ++j) { u32x2 w; w.x = pk_bf16(v[j].x, v[j].y); w.y = pk_bf16(v[j].z, v[j].w); *(u32x2*)(orow + 4 * lane + 256 * j) = w; }
}
__device__ __forceinline__ void store_row_fp8(unsigned char* orow, const f32x4 (&v)[8], int lane) {
#pragma unroll
    for (int j = 0; j < 8; ++j) *(unsigned*)(orow + 4 * lane + 256 * j) = pk_fp8x4(v[j].x, v[j].y, v[j].z, v[j].w);
}
__device__ __forceinline__ void store_row_f32(float* orow, const f32x4 (&v)[8], int lane) {
#pragma unroll
    for (int j = 0; j < 8; ++j) *(f32x4*)(orow + 4 * lane + 256 * j) = v[j];
}
__device__ __forceinline__ void load_row_f32(const float* row, f32x4 (&v)[8], int lane) {
#pragma unroll
    for (int j = 0; j < 8; ++j) v[j] = *(const f32x4*)(row + 4 * lane + 256 * j);
}

__device__ __forceinline__ void conv_small_weights(Frame& F, int l, int it, LAS float* scr) {
    bf16* wl = (bf16*)(F.ws + WS_WSMALL + (size_t)l * WL_BYTES);
    int r = it;
    if (r < 10752) { const int kb = r / 336, nb = r % 336;
        if (nb < CW / 32) { const int t = nb >> 3;
            if (!((A8_MASK >> t) & 1u)) transpose_item(F.I(I_WIN) + (size_t)l * D * INC, INC, 64 * kb, 32 * nb, (bf16*)((char*)wl + WL_WIN), D, __builtin_popcount(~A8_MASK & ((1u << t) - 1u)) * 256 + (nb & 7) * 32, scr, F.lane);
            else { const int ct = __builtin_popcount(A8_MASK & ((1u << t) - 1u)); transpose_item8(F.I(I_WIN) + (size_t)l * D * INC, INC, 64 * kb, 32 * nb, (unsigned char*)wl + WL_WIN8, D, GW + ct * 256 + (nb & 7) * 32, W8_SCALE, scr, F.lane); } }
        else transpose_item8(F.I(I_WIN) + (size_t)l * D * INC, INC, 64 * kb, 32 * nb, (unsigned char*)wl + WL_WIN8, D, 32 * nb - CW, W8_SCALE, scr, F.lane);
        return; } r -= 10752;
    if (r < 3072) { const int pi = r / 1024, q = r % 1024, kb = q / 64, nb = q % 64;
        transpose_item(F.I(I_PPOOL + pi) + (size_t)l * 1024 * D, D, 64 * kb, 32 * nb, (bf16*)((char*)wl + WL_PROJ) + (size_t)pi * D * 1024, 1024, 32 * nb, scr, F.lane); return; } r -= 3072;
    if (r < 2048) { const int kb = r / 64, nb = r % 64; transpose_item(F.I(I_WOUT) + (size_t)l * D * D, D, 64 * kb, 32 * nb, (bf16*)((char*)wl + WL_WOUT), D, 32 * nb, scr, F.lane); return; } r -= 2048;
    if (r < 128) { const int g = r / 32, q = r % 32, kb = q / 8, nb = q % 8;
        transpose_item(F.I(I_POOLW) + ((size_t)l * 4 + g) * 65536, 256, 64 * kb, 32 * nb, (bf16*)((char*)wl + WL_POOL) + (size_t)g * 65536, 256, 32 * nb, scr, F.lane); return; } r -= 128;
    { const int which = r / 128, q0 = r % 128, blk = q0 / 32, q = q0 % 32, kb = q / 8, nb = q % 8, n0 = 32 * nb;
        const int drow0 = (blk * 2 + (n0 >> 7)) * 256 + 64 * ((n0 & 127) >> 5) + 32 * which;
        transpose_item(F.I(which ? I_WX : I_WA) + ((size_t)l * 4 + blk) * 65536, 256, 64 * kb, n0, (bf16*)((char*)wl + WL_LRU), 256, drow0, scr, F.lane); }
}
__device__ __forceinline__ void conv_expert_weights(Frame& F, int l, int it, LAS float* scr) {
    unsigned char* gu = F.ws + WS_R2 + EXPW_GU; unsigned char* wd = F.ws + WS_R2 + EXPW_WD;
    const int e = it / 1536, r = it % 1536;
    if (r < 1024) { const int which = r / 512, q = r % 512, kb = q / 16, nb = q % 16, n0 = 32 * nb;
        const int drow0 = (e * 4 + (n0 >> 7)) * 256 + which * 128 + (n0 & 127);
        transpose_item8(F.I(which ? I_EU : I_EG) + ((size_t)l * NEXP + e) * D * DE, DE, 64 * kb, n0, gu, D, drow0, W8_SCALE, scr, F.lane); }
    else { const int q = r - 1024, kb = q / 64, nb = q % 64;
        transpose_item8(F.I(I_ED) + ((size_t)l * NEXP + e) * DE * D, D, 64 * kb, 32 * nb, wd, DE, e * D + 32 * nb, W8_SCALE, scr, F.lane); }
}
__device__ __forceinline__ void p0_prologue(Frame& F) {
    LAS float* scr = (LAS float*)(F.lds + F.wave * 16384);
    const int gw = F.vcu * 8 + F.wave, NGW = F.G * 8;
    LAS float* lv = (LAS float*)(F.lds + VEC_OFF);
    { const int i4 = 4 * F.tid; *(LAS f32x4*)(lv + i4) = *(const f32x4*)(F.I(I_LNE_G) + i4); *(LAS f32x4*)(lv + 2048 + i4) = *(const f32x4*)(F.I(I_LNE_B) + i4); }
    __syncthreads();
    for (int it = gw; it < 2 * 16256; it += NGW) conv_small_weights(F, it / 16256, it % 16256, scr);
    float* H = (float*)(F.ws + WS_H); bf16* HB = (bf16*)(F.ws + WS_HB);
    for (int n = gw; n < MP; n += NGW) {
        if (n < NTOK) { const int b = n / LSEQ, t = n % LSEQ; const float* src = t < NMETA ? F.I(I_META) + (size_t)t * D : F.I(I_X) + ((size_t)b * SEQ + (t - NMETA)) * D;
            f32x4 v[8]; load_row_f32(src, v, F.lane); ln_regs_lds(v, lv, lv + 2048, F.lane);
            store_row_f32(H + (size_t)n * D, v, F.lane); store_row_bf16(HB + (size_t)n * D, v, F.lane); store_row_fp8(F.ws + WS_HB8 + (size_t)n * D, v, F.lane); }
        else { f32x4 v[8];
#pragma unroll
            for (int j = 0; j < 8; ++j) v[j] = (f32x4){0.f, 0.f, 0.f, 0.f};
            store_row_f32(H + (size_t)n * D, v, F.lane); store_row_bf16(HB + (size_t)n * D, v, F.lane); store_row_fp8(F.ws + WS_HB8 + (size_t)n * D, v, F.lane); }
    }
    { bf16* wrt = (bf16*)(F.ws + WS_WRT);
      for (int i = F.vcu * 512 + F.tid; i < 2 * 48 * 2048; i += F.G * 512) { const int l = i / (48 * 2048), c = (i / 2048) % 48, k = i % 2048;
          const float w = c < 4 ? F.I(I_RGW)[((size_t)l * D + k) * 4 + c] : c < 36 ? F.I(I_REW)[((size_t)l * D + k) * 32 + (c - 4)] : 0.f;
          const unsigned hi = pk_bf16(w, 0.f) & 0xffffu; const float rem = w - __uint_as_float(hi << 16);
          wrt[((size_t)(l * 2 + 0) * 48 + c) * 2048 + k] = (bf16)hi; wrt[((size_t)(l * 2 + 1) * 48 + c) * 2048 + k] = (bf16)(pk_bf16(rem, 0.f) & 0xffffu); } }
    { bf16* wsc = (bf16*)(F.ws + WS_WSC);
      for (int i = F.vcu * 512 + F.tid; i < 2 * 4 * 65536; i += F.G * 512) { const int e = i & 255, lg = i >> 16;
          wsc[i] = (bf16)(pk_bf16(F.I(I_POOLW)[i] * F.I(I_POOLS)[(size_t)lg * 256 + e], 0.f) & 0xffffu); } }
    float* sp8 = (float*)(F.ws + WS_SP8);
    for (int i = F.vcu * 512 + F.tid; i < 2 * 1024; i += F.G * 512) { const float lam = F.I(I_LAM)[i]; sp8[i] = 8.0f * log1pf(expf(-lam)); }
}

using pg8::Unit;
__device__ __forceinline__ int xcd_order(int i, int G, int c, int NT) { if (G % (8 * NT)) return i * G + c; const int P = G / (8 * NT), x = c & 7, s = c >> 3; return i * G + (x * P + s / NT) * NT + (s % NT); }
constexpr int A8_NCT = __builtin_popcount(A8_MASK), A8_NN = 24 + A8_NCT, ABF_NN = 18 - A8_NCT;
constexpr int A_H = (NPANEL * ABF_NN) % 256, A_LIGHT = 256 - A_H, A_NF = NPANEL * A8_NN, A_X = (A_NF + 2 * A_H + 255) / 256;
__device__ __forceinline__ int nth_bit(unsigned m, int n) { for (int i = 0; i < n; ++i) m &= m - 1; return __builtin_ctz(m); }
template <bool GATE> struct PolA_ {
    static constexpr bool PERM = true, GATHER = false, ADJ = true; static constexpr int ESZ = GATE ? 1 : 2, NN = GATE ? A8_NN : ABF_NN;
    int K, lda, ldb; const unsigned char* A; const unsigned char* Bt; bf16* out; bf16* outc; int G, c;
    __device__ __forceinline__ bool next(int i, Unit& u) const { int L;
        if (GATE && G == 256) {
            if (i < A_X - 2) L = i * 256 + c; else if (i < A_X) { if (c >= A_LIGHT) return false; L = (A_X - 2) * 256 + (i - (A_X - 2)) * A_LIGHT + c; if (L >= A_NF) return false; } else return false;
        } else { L = i * G + c; if (L >= NPANEL * NN) return false; }
        const int nwg = NPANEL * NN, q = nwg / 8, r = nwg % 8, xcd = L % 8, off = L / 8; const int w = (xcd < r ? xcd * (q + 1) : r * (q + 1) + (xcd - r) * q) + off;
        const int nig = 8 * NN, gid = w / nig, fm = gid * 8, gsz = (NPANEL - fm) < 8 ? (NPANEL - fm) : 8;
        u.pm = fm + ((w % nig) % gsz); u.pn = (w % nig) / gsz; u.z = 0; return true; }
    __device__ __forceinline__ const char* a_ptr(const Unit& u) const { return (const char*)(A + (size_t)u.pm * 256 * lda * ESZ); }
    __device__ __forceinline__ const char* b_ptr(const Unit& u) const { return (const char*)(Bt + (size_t)u.pn * 256 * ldb * ESZ); }
    __device__ __forceinline__ int a_row(const Unit&, int) const { return 0; }
    template <bool T1> __device__ __forceinline__ bool epi(f32x4 (&acc)[2][2][4][2], const Unit& u, int wr, int wc, int fr, int fq) const {
        const int row0 = u.pm * 256 + wr * 64 + fr;
        if constexpr (!GATE) {
            const int tile = nth_bit(~A8_MASK & 0x3FFFFu, u.pn); const float sc = (tile >= 4 && tile < 8) ? 0.125f : 1.0f;
            bf16* base = out + (size_t)row0 * CW + tile * 256 + wc * 64 + 8 * fq;
#pragma unroll
            for (int ai = 0; ai < 2; ++ai)
#pragma unroll
                for (int m = 0; m < 4; ++m)
#pragma unroll
                    for (int bj = 0; bj < 2; ++bj) { const f32x4 v0 = acc[ai][bj][m][0] * sc, v1 = acc[ai][bj][m][1] * sc;
                        u32x4 w; w.x = pk_bf16(v0[0], v0[1]); w.y = pk_bf16(v0[2], v0[3]); w.z = pk_bf16(v1[0], v1[1]); w.w = pk_bf16(v1[2], v1[3]);
                        *(u32x4*)(base + (size_t)(ai * 128 + m * 16) * CW + bj * 32) = w; }
        } else if (u.pn < 24) {
            unsigned char* base = (unsigned char*)out + (size_t)row0 * GW + u.pn * 256 + wc * 64 + 8 * fq;
#pragma unroll
            for (int ai = 0; ai < 2; ++ai)
#pragma unroll
                for (int m = 0; m < 4; ++m)
#pragma unroll
                    for (int bj = 0; bj < 2; ++bj) { const f32x4 a0 = acc[ai][bj][m][0] * (1.0f / W8_SCALE), a1 = acc[ai][bj][m][1] * (1.0f / W8_SCALE);
                        u32x2 w; w.x = pk_gate4(sigmoidf_(a0[0]), sigmoidf_(a0[1]), sigmoidf_(a0[2]), sigmoidf_(a0[3])); w.y = pk_gate4(sigmoidf_(a1[0]), sigmoidf_(a1[1]), sigmoidf_(a1[2]), sigmoidf_(a1[3]));
                        *(u32x2*)(base + (size_t)(ai * 128 + m * 16) * GW + bj * 32) = w; }
        } else {
            const int tile = nth_bit(A8_MASK, u.pn - 24); const float sc = ((tile >= 4 && tile < 8) ? 0.125f : 1.0f) * (1.0f / W8_SCALE);
            bf16* base = outc + (size_t)row0 * CW + tile * 256 + wc * 64 + 8 * fq;
#pragma unroll
            for (int ai = 0; ai < 2; ++ai)
#pragma unroll
                for (int m = 0; m < 4; ++m)
#pragma unroll
                    for (int bj = 0; bj < 2; ++bj) { const f32x4 v0 = acc[ai][bj][m][0] * sc, v1 = acc[ai][bj][m][1] * sc;
                        u32x4 w; w.x = pk_bf16(v0[0], v0[1]); w.y = pk_bf16(v0[2], v0[3]); w.z = pk_bf16(v1[0], v1[1]); w.w = pk_bf16(v1[2], v1[3]);
                        *(u32x4*)(base + (size_t)(ai * 128 + m * 16) * CW + bj * 32) = w; }
        }
        return true;
    }
};
__device__ __forceinline__ void unpack8(const u32x4 v, float (&f)[8]);
struct PolW {
    static constexpr bool PERM = true, GATHER = false, ADJ = true; static constexpr int ESZ = 2;
    int K, lda, ldb; const bf16* pt; const bf16* wsc; bf16* wct; int G, c;
    __device__ __forceinline__ bool next(int i, Unit& u) const { const int L = i * G + c; if (L >= 32) return false; u.pm = L >> 2; u.pn = L & 3; u.z = 0; return true; }
    __device__ __forceinline__ const char* a_ptr(const Unit& u) const { return (const char*)(pt + (size_t)u.pm * 256 * 1024 + u.pn * 256); }
    __device__ __forceinline__ const char* b_ptr(const Unit& u) const { return (const char*)(wsc + (size_t)u.pn * 65536); }
    __device__ __forceinline__ int a_row(const Unit&, int) const { return 0; }
    template <bool T1> __device__ __forceinline__ bool epi(f32x4 (&acc)[2][2][4][2], const Unit& u, int wr, int wc, int fr, int fq) const {
        bf16* base = wct + (size_t)(u.pm * 256 + wr * 64 + fr) * 1024 + u.pn * 256 + wc * 64 + 8 * fq;
#pragma unroll
        for (int ai = 0; ai < 2; ++ai)
#pragma unroll
            for (int m = 0; m < 4; ++m)
#pragma unroll
                for (int bj = 0; bj < 2; ++bj) { const f32x4 v0 = acc[ai][bj][m][0], v1 = acc[ai][bj][m][1];
                    u32x4 w; w.x = pk_bf16(v0[0], v0[1]); w.y = pk_bf16(v0[2], v0[3]); w.z = pk_bf16(v1[0], v1[1]); w.w = pk_bf16(v1[2], v1[3]);
                    *(u32x4*)(base + (size_t)(ai * 128 + m * 16) * 1024 + bj * 32) = w; }
        return true;
    }
};
struct PolC {
    static constexpr bool PERM = true, GATHER = false, ADJ = true; static constexpr int ESZ = 2;
    int K, lda, ldb; const bf16* delta; const bf16* xc; const bf16* pool_t; const bf16* lru_t; bf16* mix; bf16* Abuf; bf16* Bbuf;
    const float* pool_scale; const float* ba; const float* bx; const float* sp8; int G, c;
    __device__ __forceinline__ bool next(int i, Unit& u) const { const int L = i * G + c; if (L >= 64 * 8) return false; u.pm = L >> 3; u.pn = 4 + (L & 7); u.z = 0; return true; }
    __device__ __forceinline__ const char* a_ptr(const Unit& u) const { return u.pn < 4 ? (const char*)(delta + (size_t)u.pm * 256 * 1024 + u.pn * 256) : (const char*)(xc + (size_t)u.pm * 256 * 1024 + ((u.pn - 4) >> 1) * 256); }
    __device__ __forceinline__ const char* b_ptr(const Unit& u) const { return u.pn < 4 ? (const char*)(pool_t + (size_t)u.pn * 65536) : (const char*)(lru_t + (size_t)(u.pn - 4) * 65536); }
    __device__ __forceinline__ int a_row(const Unit&, int) const { return 0; }
    __device__ __forceinline__ int rows(const Unit& u) const { return NTOK - u.pm * 256; }
    template <bool T1> __device__ __forceinline__ bool epi(f32x4 (&acc)[2][2][4][2], const Unit& u, int wr, int wc, int fr, int fq) const {
        const int row0 = u.pm * 256 + wr * 64 + fr;
        if (u.pn < 4) {
#pragma unroll
            for (int bj = 0; bj < 2; ++bj) { const int col = u.pn * 256 + wc * 64 + bj * 32 + 8 * fq; const f32x4 p0 = *(const f32x4*)(pool_scale + col), p1 = *(const f32x4*)(pool_scale + col + 4);
#pragma unroll
                for (int ai = 0; ai < 2; ++ai)
#pragma unroll
                    for (int m = 0; m < 4; ++m) { const f32x4 v0 = acc[ai][bj][m][0] * p0, v1 = acc[ai][bj][m][1] * p1; u32x4 w; w.x = pk_bf16(v0[0], v0[1]); w.y = pk_bf16(v0[2], v0[3]); w.z = pk_bf16(v1[0], v1[1]); w.w = pk_bf16(v1[2], v1[3]);
                        *(u32x4*)(mix + (size_t)(row0 + ai * 128 + m * 16) * 3072 + col) = w; } }
        } else {
            const int q = u.pn - 4, ch = (q >> 1) * 256 + (q & 1) * 128 + wc * 32 + 8 * fq;
            float vba[8], vbx[8], vsp[8];
            { const f32x4 t0 = *(const f32x4*)(ba + ch), t1 = *(const f32x4*)(ba + ch + 4), t2 = *(const f32x4*)(bx + ch), t3 = *(const f32x4*)(bx + ch + 4), t4 = *(const f32x4*)(sp8 + ch), t5 = *(const f32x4*)(sp8 + ch + 4);
#pragma unroll
              for (int j = 0; j < 4; ++j) { vba[j] = t0[j]; vba[4 + j] = t1[j]; vbx[j] = t2[j]; vbx[4 + j] = t3[j]; vsp[j] = t4[j]; vsp[4 + j] = t5[j]; } }
#pragma unroll
            for (int ai = 0; ai < 2; ++ai) { u32x4 xw[4];
#pragma unroll
                for (int m = 0; m < 4; ++m) xw[m] = *(const u32x4*)(xc + (size_t)(row0 + ai * 128 + m * 16) * 1024 + ch);
#pragma unroll
                for (int m = 0; m < 4; ++m) { const int row = row0 + ai * 128 + m * 16; float xv[8]; unpack8(xw[m], xv);
                    const bool t0 = (row % LSEQ) == 0; float av[8], bv[8];
#pragma unroll
                    for (int j = 0; j < 8; ++j) { const float ga = sigmoidf_(acc[ai][0][m][j >> 2][j & 3] + vba[j]), gx = sigmoidf_(acc[ai][1][m][j >> 2][j & 3] + vbx[j]);
                        const float a = fast_exp(-vsp[j] * ga); bv[j] = sqrtf(fmaxf(1.0f - a * a, 0.f)) * gx * xv[j]; av[j] = t0 ? 1.0f : 1.0f - a; }
                    u32x4 wa, wb; wa.x = pk_bf16(av[0], av[1]); wa.y = pk_bf16(av[2], av[3]); wa.z = pk_bf16(av[4], av[5]); wa.w = pk_bf16(av[6], av[7]);
                    wb.x = pk_bf16(bv[0], bv[1]); wb.y = pk_bf16(bv[2], bv[3]); wb.z = pk_bf16(bv[4], bv[5]); wb.w = pk_bf16(bv[6], bv[7]);
                    *(u32x4*)(Abuf + (size_t)row * 1024 + ch) = wa; *(u32x4*)(Bbuf + (size_t)row * 1024 + ch) = wb; } }
        }
        return true;
    }
};
struct PolE {
    static constexpr bool PERM = true, GATHER = false, ADJ = true; static constexpr int ESZ = 2;
    int K, lda, ldb; const bf16* mix; const bf16* proj_t; const bf16* wct; const unsigned char* gates; bf16* merged; int G, c;
    int t0, t1;
    __device__ __forceinline__ bool next(int i, Unit& u) const { const int ti = t0 + xcd_order(i / 3, G, c, 8); if (ti >= t1) return false; u.pm = ti >> 3; u.pn = ti & 7; u.z = i % 3; return true; }
    __device__ __forceinline__ const char* a_ptr(const Unit& u) const { return (const char*)(mix + (size_t)u.pm * 256 * 3072 + u.z * 1024); }
    __device__ __forceinline__ const char* b_ptr(const Unit& u) const { return u.z == 0 ? (const char*)(wct + (size_t)u.pn * 256 * 1024) : (const char*)(proj_t + (size_t)u.z * D * 1024 + (size_t)u.pn * 256 * 1024); }
    __device__ __forceinline__ int a_row(const Unit&, int) const { return 0; }
    static __device__ __forceinline__ void unpack_gate(const u32x2 w, float (&f)[8]) { f[0] = (float)(w.x & 255u); f[1] = (float)((w.x >> 8) & 255u); f[2] = (float)((w.x >> 16) & 255u); f[3] = (float)(w.x >> 24);
        f[4] = (float)(w.y & 255u); f[5] = (float)((w.y >> 8) & 255u); f[6] = (float)((w.y >> 16) & 255u); f[7] = (float)(w.y >> 24); }
    template <bool T1> __device__ __forceinline__ bool epi(f32x4 (&acc)[2][2][4][2], const Unit& u, int wr, int wc, int fr, int fq) const {
        const int row0 = u.pm * 256 + wr * 64 + fr, col0 = u.pn * 256 + wc * 64 + 8 * fq;
        const unsigned char* gbase = gates + (size_t)row0 * GW + u.z * D + col0; const bool fin = (u.z == 2); const int dofs = fin ? 0 : D;
        const u32x2 ones = (u32x2){0xffffffffu, 0xffffffffu};
#pragma unroll
        for (int ai = 0; ai < (T1 ? 1 : 2); ++ai)
#pragma unroll
            for (int mh = 0; mh < 2; ++mh) { u32x2 ga[2][2], gb[2][2];
#pragma unroll
                for (int mm = 0; mm < 2; ++mm)
#pragma unroll
                    for (int bj = 0; bj < 2; ++bj) { const unsigned char* gp = gbase + (size_t)(ai * 128 + (2 * mh + mm) * 16) * GW + bj * 32; ga[mm][bj] = *(const u32x2*)gp; gb[mm][bj] = *(const u32x2*)(gp + dofs); }
#pragma unroll
                for (int mm = 0; mm < 2; ++mm)
#pragma unroll
                    for (int bj = 0; bj < 2; ++bj) { const int m = 2 * mh + mm; float f[8], h[8]; unpack_gate(ga[mm][bj], f); const u32x2 gsel = fin ? ones : gb[mm][bj]; unpack_gate(gsel, h);
#pragma unroll
                        for (int j = 0; j < 8; ++j) f[j] = fmaxf(f[j], 1e-20f) * __builtin_amdgcn_rcpf(fmaxf(h[j], 1e-20f));
                        f32x4 v0 = acc[ai][bj][m][0], v1 = acc[ai][bj][m][1];
                        v0[0] *= f[0]; v0[1] *= f[1]; v0[2] *= f[2]; v0[3] *= f[3]; v1[0] *= f[4]; v1[1] *= f[5]; v1[2] *= f[6]; v1[3] *= f[7];
                        acc[ai][bj][m][0] = v0; acc[ai][bj][m][1] = v1; }
                if (fin) {
#pragma unroll
                    for (int mm = 0; mm < 2; ++mm)
#pragma unroll
                        for (int bj = 0; bj < 2; ++bj) { const int m = 2 * mh + mm; const f32x4 a0 = acc[ai][bj][m][0], a1 = acc[ai][bj][m][1];
                            u32x4 w; w.x = pk_bf16(a0[0], a0[1]); w.y = pk_bf16(a0[2], a0[3]); w.z = pk_bf16(a1[0], a1[1]); w.w = pk_bf16(a1[2], a1[3]);
                            *(u32x4*)(merged + (size_t)(row0 + ai * 128 + m * 16) * D + col0 + bj * 32) = w; } }
                __builtin_amdgcn_sched_barrier(0); }
        return fin;
    }
};
struct PolF {
    static constexpr bool PERM = false, GATHER = false; static constexpr int ESZ = 2;
    int K, lda, ldb; const bf16* A; const bf16* Bt; float* H; float* stats; int G, c;
    int t0, t1;
    __device__ __forceinline__ bool next(int i, Unit& u) const { const int ti = t0 + xcd_order(i, G, c, 8); if (ti >= t1) return false; u.pm = ti >> 3; u.pn = ti & 7; u.z = 0; return true; }
    __device__ __forceinline__ const char* a_ptr(const Unit& u) const { return (const char*)(A + (size_t)u.pm * 256 * lda); }
    __device__ __forceinline__ const char* b_ptr(const Unit& u) const { return (const char*)(Bt + (size_t)u.pn * 256 * ldb); }
    __device__ __forceinline__ int a_row(const Unit&, int) const { return 0; }
    template <bool T1> __device__ __forceinline__ bool epi(f32x4 (&acc)[2][2][4][2], const Unit& u, int wr, int wc, int fr, int fq) const {
        const int row0 = u.pm * 256 + wr * 64 + fr, col0 = u.pn * 256 + wc * 32 + 4 * fq;
#pragma unroll
        for (int ai = 0; ai < (T1 ? 1 : 2); ++ai)
#pragma unroll
            for (int m = 0; m < 4; ++m) { const int row = row0 + ai * 128 + m * 16; float* rp = H + (size_t)row * D + col0; float s = 0.f, q = 0.f;
#pragma unroll
                for (int bj = 0; bj < 2; ++bj)
#pragma unroll
                    for (int n = 0; n < 2; ++n) { const f32x4 h = *(const f32x4*)(rp + bj * 128 + n * 16); const f32x4 y = h * ALPHA + acc[ai][bj][m][n]; *(f32x4*)(rp + bj * 128 + n * 16) = y;
                        s += (y[0] + y[1]) + (y[2] + y[3]); q += (y[0] * y[0] + y[1] * y[1]) + (y[2] * y[2] + y[3] * y[3]); }
                s += __shfl_xor(s, 16); s += __shfl_xor(s, 32); q += __shfl_xor(q, 16); q += __shfl_xor(q, 32);
                if (fq == 0) *(f32x2*)(stats + (size_t)row * 64 + (u.pn * 4 + wc) * 2) = (f32x2){s, q}; }
        return true;
    }
};
struct MoeTbl { const LAS int* t; __device__ __forceinline__ int ct(int e) const { return __builtin_amdgcn_readfirstlane(t[e]); } __device__ __forceinline__ int cnt(int e) const { return __builtin_amdgcn_readfirstlane(t[40 + e]); } };
__device__ __forceinline__ int moe_find(const MoeTbl& T, int mt) { int e = 0;
#pragma unroll 1
    while (e < 31 && T.ct(e + 1) <= mt) ++e;
    return e; }
struct PolI {
    static constexpr bool PERM = true, GATHER = true; static constexpr int ESZ = 1;
    int K, lda, ldb; const unsigned char* X; const unsigned char* gu; const int* elist; unsigned char* hdn; MoeTbl T; int G, c;
    __device__ __forceinline__ bool next(int i, Unit& u) const { const int L = xcd_order(i, G, c, 4), tot = T.ct(32); if (L >= tot * 4) return false; u.pm = L >> 2; u.pn = L & 3; u.z = moe_find(T, u.pm); return true; }
    __device__ __forceinline__ const char* a_ptr(const Unit&) const { return (const char*)X; }
    __device__ __forceinline__ const char* b_ptr(const Unit& u) const { return (const char*)(gu + (size_t)(u.z * 4 + u.pn) * 256 * D); }
    __device__ __forceinline__ int a_row(const Unit& u, int r) const { const int j = (u.pm - T.ct(u.z)) * 256 + r; return j < T.cnt(u.z) ? elist[(size_t)u.z * NTOK + j] : 0; }
    template <bool T1> __device__ __forceinline__ bool epi(f32x4 (&acc)[2][2][4][2], const Unit& u, int wr, int wc, int fr, int fq) const {
        const int row0 = u.pm * 256 + wr * 64 + fr, col0 = u.pn * 128 + wc * 32 + 8 * fq;
#pragma unroll
        for (int ai = 0; ai < 2; ++ai)
#pragma unroll
            for (int m = 0; m < 4; ++m) { float o[8];
#pragma unroll
                for (int n = 0; n < 2; ++n)
#pragma unroll
                    for (int j = 0; j < 4; ++j) { const float g = acc[ai][0][m][n][j] * (1.0f / W8_SCALE), up = acc[ai][1][m][n][j] * (HDN_SCALE / W8_SCALE); o[4 * n + j] = fminf(fmaxf(g * sigmoidf_(g) * up, -440.f), 440.f); }
                u32x2 w; w.x = pk_fp8x4(o[0], o[1], o[2], o[3]); w.y = pk_fp8x4(o[4], o[5], o[6], o[7]);
                *(u32x2*)(hdn + (size_t)(row0 + ai * 128 + m * 16) * DE + col0) = w; }
        return true;
    }
};
struct PolJ {
    static constexpr bool PERM = true, GATHER = false, ADJ = true; static constexpr int ESZ = 1;
    int K, lda, ldb; const unsigned char* hdn; const unsigned char* wd; unsigned char* yd; MoeTbl T; int G, c;
    __device__ __forceinline__ bool next(int i, Unit& u) const { const int L = xcd_order(i, G, c, 8), tot = T.ct(32); if (L >= tot * 8) return false; u.pm = L >> 3; u.pn = L & 7; u.z = moe_find(T, u.pm); return true; }
    __device__ __forceinline__ const char* a_ptr(const Unit& u) const { return (const char*)(hdn + (size_t)u.pm * 256 * DE); }
    __device__ __forceinline__ const char* b_ptr(const Unit& u) const { return (const char*)(wd + ((size_t)u.z * D + (size_t)u.pn * 256) * DE); }
    __device__ __forceinline__ int a_row(const Unit&, int) const { return 0; }
    template <bool T1> __device__ __forceinline__ bool epi(f32x4 (&acc)[2][2][4][2], const Unit& u, int wr, int wc, int fr, int fq) const {
        const int row0 = u.pm * 256 + wr * 64 + fr, col0 = u.pn * 256 + wc * 64 + 8 * fq;
#pragma unroll
        for (int ai = 0; ai < 2; ++ai)
#pragma unroll
            for (int m = 0; m < 4; ++m)
#pragma unroll
                for (int bj = 0; bj < 2; ++bj) { const f32x4 v0 = acc[ai][bj][m][0] * (YD_SCALE / (W8_SCALE * HDN_SCALE)), v1 = acc[ai][bj][m][1] * (YD_SCALE / (W8_SCALE * HDN_SCALE));
#define YCL(x) __builtin_amdgcn_fmed3f((x), -448.0f, 448.0f)
                    u32x2 w; w.x = pk_fp8x4(YCL(v0[0]), YCL(v0[1]), YCL(v0[2]), YCL(v0[3])); w.y = pk_fp8x4(YCL(v1[0]), YCL(v1[1]), YCL(v1[2]), YCL(v1[3]));
#undef YCL
                    *(u32x2*)(yd + (size_t)(row0 + ai * 128 + m * 16) * D + col0 + bj * 32) = w; }
        return true;
    }
};

template <int NCB> __device__ __forceinline__ void skinny_mma(f32x4 (&acc)[4][NCB], const bf16* A, int lda, const bf16* Bt, int ldb, int k0, int k1, int lane) {
    const int fr = lane & 15, fq = lane >> 4;
#pragma unroll 2
    for (int k = k0; k < k1; k += 32) { bf16x8 a[4], b[NCB];
#pragma unroll
        for (int rb = 0; rb < 4; ++rb) a[rb] = *(const bf16x8*)(A + (size_t)(16 * rb + fr) * lda + k + 8 * fq);
#pragma unroll
        for (int cb = 0; cb < NCB; ++cb) b[cb] = *(const bf16x8*)(Bt + (size_t)(16 * cb + fr) * ldb + k + 8 * fq);
#pragma unroll
        for (int rb = 0; rb < 4; ++rb)
#pragma unroll
            for (int cb = 0; cb < NCB; ++cb) acc[rb][cb] = __builtin_amdgcn_mfma_f32_16x16x32_bf16(b[cb], a[rb], acc[rb][cb], 0, 0, 0); }
}
__device__ __forceinline__ void tail_merge(Frame& F, int l) {
    if (F.vcu >= 128) return;
    const bf16* mix = (const bf16*)(F.ws + WS_R3) + (size_t)16384 * 3072; const bf16* proj_t = (const bf16*)(F.ws + WS_WSMALL + (size_t)l * WL_BYTES + WL_PROJ); const bf16* wct = (const bf16*)(F.ws + WS_WCT) + (size_t)l * D * 1024;
    const unsigned char* gates = F.ws + WS_R1 + (size_t)16384 * GW; bf16* merged = (bf16*)(F.ws + WS_R45) + (size_t)16384 * D;
    const int c0 = F.vcu * 16, lane = F.lane, wave = F.wave, fr = lane & 15, fq = lane >> 4;
    LAS float* part = (LAS float*)F.lds;
#pragma unroll
    for (int seg = 0; seg < 3; ++seg) { f32x4 acc[4][1];
#pragma unroll
        for (int rb = 0; rb < 4; ++rb) acc[rb][0] = (f32x4){0.f, 0.f, 0.f, 0.f};
        skinny_mma<1>(acc, mix + seg * 1024, 3072, (seg == 0 ? wct : proj_t + (size_t)seg * D * 1024) + (size_t)c0 * 1024, 1024, wave * 128, wave * 128 + 128, lane);
#pragma unroll
        for (int rb = 0; rb < 4; ++rb) *(LAS f32x4*)(part + ((wave * 3 + seg) * 64 + 16 * rb + fr) * 16 + 4 * fq) = acc[rb][0]; }
    __syncthreads();
#pragma unroll
    for (int e2 = 0; e2 < 2; ++e2) { const int e = F.tid + 512 * e2, row = e >> 4, col = e & 15; float m = 0.f;
#pragma unroll
        for (int seg = 0; seg < 3; ++seg) { float s = 0.f;
#pragma unroll
            for (int w = 0; w < 8; ++w) s += part[((w * 3 + seg) * 64 + row) * 16 + col];
            m += (float)gates[(size_t)row * GW + seg * D + c0 + col] * (1.0f / 255.0f) * s; }
        merged[(size_t)row * D + c0 + col] = (bf16)(pk_bf16(m, 0.f) & 0xffffu); }
    __syncthreads();
}
__device__ __forceinline__ void tail_lru(Frame& F, int l) {
    if (F.vcu >= 64) return;
    const bf16* xc = (const bf16*)(F.ws + WS_R45) + (size_t)MP * 1024 + (size_t)16384 * 1024; const bf16* lru_t = (const bf16*)(F.ws + WS_WSMALL + (size_t)l * WL_BYTES + WL_LRU);
    bf16* Abuf = (bf16*)(F.ws + WS_R6) + (size_t)16384 * 1024; bf16* Bbuf = (bf16*)(F.ws + WS_R6) + (size_t)MP * 1024 + (size_t)16384 * 1024;
    const float* ba = F.I(I_BA) + (size_t)l * 1024; const float* bx = F.I(I_BX) + (size_t)l * 1024; const float* sp8 = (const float*)(F.ws + WS_SP8) + (size_t)l * 1024;
    const int ch0 = F.vcu * 16, blk = ch0 >> 8, cib = ch0 & 255, lane = F.lane, wave = F.wave, fr = lane & 15, fq = lane >> 4;
    const bf16* wrow = lru_t + (size_t)((blk * 2 + (cib >> 7)) * 256 + 64 * ((cib & 127) >> 5) + (cib & 31)) * 256;
    LAS float* part = (LAS float*)F.lds;
    { f32x4 acc[4][2];
#pragma unroll
      for (int rb = 0; rb < 4; ++rb) { acc[rb][0] = (f32x4){0.f, 0.f, 0.f, 0.f}; acc[rb][1] = acc[rb][0]; }
      const int k = wave * 32 + 8 * fq; bf16x8 a[4], b[2];
#pragma unroll
      for (int rb = 0; rb < 4; ++rb) a[rb] = *(const bf16x8*)(xc + (size_t)(16 * rb + fr) * 1024 + blk * 256 + k);
      b[0] = *(const bf16x8*)(wrow + (size_t)fr * 256 + k); b[1] = *(const bf16x8*)(wrow + (size_t)(32 + fr) * 256 + k);
#pragma unroll
      for (int rb = 0; rb < 4; ++rb)
#pragma unroll
          for (int cb = 0; cb < 2; ++cb) acc[rb][cb] = __builtin_amdgcn_mfma_f32_16x16x32_bf16(b[cb], a[rb], acc[rb][cb], 0, 0, 0);
#pragma unroll
      for (int rb = 0; rb < 4; ++rb)
#pragma unroll
          for (int cb = 0; cb < 2; ++cb) *(LAS f32x4*)(part + (wave * 64 + 16 * rb + fr) * 32 + 16 * cb + 4 * fq) = acc[rb][cb]; }
    __syncthreads();
#pragma unroll
    for (int e2 = 0; e2 < 2; ++e2) { const int e = F.tid + 512 * e2, row = e >> 4, cc = e & 15, ch = ch0 + cc; float ga = 0.f, gx = 0.f;
#pragma unroll
        for (int w = 0; w < 8; ++w) { ga += part[(w * 64 + row) * 32 + cc]; gx += part[(w * 64 + row) * 32 + 16 + cc]; }
        const float sa = sigmoidf_(ga + ba[ch]), sx = sigmoidf_(gx + bx[ch]), a = fast_exp(-sp8[ch] * sa), xv = bf2f(xc[(size_t)row * 1024 + ch]);
        const bool t0 = ((16384 + row) % LSEQ) == 0;
        Abuf[(size_t)row * 1024 + ch] = (bf16)(pk_bf16(t0 ? 1.0f : 1.0f - a, 0.f) & 0xffffu); Bbuf[(size_t)row * 1024 + ch] = (bf16)(pk_bf16(sqrtf(fmaxf(1.0f - a * a, 0.f)) * sx * xv, 0.f) & 0xffffu); }
    __syncthreads();
}
__device__ __forceinline__ void tail_wout(Frame& F, int l) {
    if (F.vcu >= 32) return;
    const bf16* merged = (const bf16*)(F.ws + WS_R45) + (size_t)16384 * D; const bf16* wo = (const bf16*)(F.ws + WS_WSMALL + (size_t)l * WL_BYTES + WL_WOUT);
    float* H = (float*)(F.ws + WS_H) + (size_t)16384 * D; float* stats = (float*)(F.ws + WS_STATS) + (size_t)16384 * 64;
    const int c0 = F.vcu * 64, lane = F.lane, wave = F.wave, fr = lane & 15, fq = lane >> 4;
    LAS float* part = (LAS float*)F.lds;
    { f32x4 acc[4][4];
#pragma unroll
      for (int rb = 0; rb < 4; ++rb)
#pragma unroll
          for (int cb = 0; cb < 4; ++cb) acc[rb][cb] = (f32x4){0.f, 0.f, 0.f, 0.f};
      skinny_mma<4>(acc, merged, D, wo + (size_t)c0 * D, D, wave * 256, wave * 256 + 256, lane);
#pragma unroll
      for (int rb = 0; rb < 4; ++rb)
#pragma unroll
          for (int cb = 0; cb < 4; ++cb) *(LAS f32x4*)(part + (wave * 64 + 16 * rb + fr) * 64 + 16 * cb + 4 * fq) = acc[rb][cb]; }
    __syncthreads();
    { const int row = F.tid >> 3, cs = (F.tid & 7) * 8; float s = 0.f, q = 0.f;
#pragma unroll
      for (int h4 = 0; h4 < 2; ++h4) { f32x4 a = (f32x4){0.f, 0.f, 0.f, 0.f};
#pragma unroll
          for (int w = 0; w < 8; ++w) a += *(const LAS f32x4*)(part + (w * 64 + row) * 64 + cs + 4 * h4);
          float* hp = H + (size_t)row * D + c0 + cs + 4 * h4; const f32x4 y = *(const f32x4*)hp * ALPHA + a; *(f32x4*)hp = y;
          s += (y[0] + y[1]) + (y[2] + y[3]); q += (y[0] * y[0] + y[1] * y[1]) + (y[2] * y[2] + y[3] * y[3]); }
      s += __shfl_xor(s, 1); s += __shfl_xor(s, 2); s += __shfl_xor(s, 4); q += __shfl_xor(q, 1); q += __shfl_xor(q, 2); q += __shfl_xor(q, 4);
      if ((F.tid & 7) == 0) *(f32x2*)(stats + (size_t)row * 64 + F.vcu * 2) = (f32x2){s, q}; }
    __syncthreads();
}

__device__ __forceinline__ void unpack8(const u32x4 v, float (&f)[8]) { f[0] = bflo(v.x); f[1] = bfhi(v.x); f[2] = bflo(v.y); f[3] = bfhi(v.y); f[4] = bflo(v.z); f[5] = bfhi(v.z); f[6] = bflo(v.w); f[7] = bfhi(v.w); }
template <int W> __device__ __forceinline__ void delta_conv_item(const bf16* cols, bf16* delta, bf16* xc, const float* cw, const float* cb, int n0, int t0, int c8) {
    u32x4 R[W + 7], X[11];
#pragma unroll
    for (int j = 0; j < W + 7; ++j) { const int dt = j - (W - 1); R[j] = (t0 + dt >= 0) ? *(const u32x4*)(cols + (size_t)(n0 + dt) * CW + C_POOL + c8) : (u32x4){0u, 0u, 0u, 0u}; }
#pragma unroll
    for (int j = 0; j < 11; ++j) { const int dt = j - 3; X[j] = (t0 + dt >= 0) ? *(const u32x4*)(cols + (size_t)(n0 + dt) * CW + C_LX + c8) : (u32x4){0u, 0u, 0u, 0u}; }
    float s[8];
#pragma unroll
    for (int q = 0; q < 8; ++q) s[q] = 0.f;
#pragma unroll
    for (int j = 0; j < W - 1; ++j) { float f[8]; unpack8(R[j], f);
#pragma unroll
        for (int q = 0; q < 8; ++q) s[q] += f[q]; }
#pragma unroll
    for (int i = 0; i < 8; ++i) { float fn[8]; unpack8(R[i + W - 1], fn);
#pragma unroll
        for (int q = 0; q < 8; ++q) s[q] += fn[q];
        const int t = t0 + i; const float inv = 1.0f / (float)((t + 1) < W ? (t + 1) : W); u32x4 o;
        o.x = pk_bf16(s[0] * inv - fn[0], s[1] * inv - fn[1]); o.y = pk_bf16(s[2] * inv - fn[2], s[3] * inv - fn[3]); o.z = pk_bf16(s[4] * inv - fn[4], s[5] * inv - fn[5]); o.w = pk_bf16(s[6] * inv - fn[6], s[7] * inv - fn[7]);
        *(u32x4*)(delta + (size_t)(n0 + i) * 3072 + c8) = o;
        float fo[8]; unpack8(R[i], fo);
#pragma unroll
        for (int q = 0; q < 8; ++q) s[q] -= fo[q]; }
    float w0[8], w1[8], w2[8], w3[8], bb[8];
#pragma unroll
    for (int q = 0; q < 8; ++q) { w0[q] = cw[c8 + q]; w1[q] = cw[1024 + c8 + q]; w2[q] = cw[2048 + c8 + q]; w3[q] = cw[3072 + c8 + q]; bb[q] = cb[c8 + q]; }
#pragma unroll
    for (int i = 0; i < 8; ++i) { float a[8], b[8], c[8], d[8]; unpack8(X[i], a); unpack8(X[i + 1], b); unpack8(X[i + 2], c); unpack8(X[i + 3], d); float r[8];
#pragma unroll
        for (int q = 0; q < 8; ++q) r[q] = bb[q] + a[q] * w0[q] + b[q] * w1[q] + c[q] * w2[q] + d[q] * w3[q];
        u32x4 o; o.x = pk_bf16(r[0], r[1]); o.y = pk_bf16(r[2], r[3]); o.z = pk_bf16(r[4], r[5]); o.w = pk_bf16(r[6], r[7]);
        *(u32x4*)(xc + (size_t)(n0 + i) * 1024 + c8) = o; }
}
__device__ __forceinline__ void phase_delta_conv(Frame& F, int l) {
    const bf16* cols = (const bf16*)(F.ws + WS_R2); bf16* delta = (bf16*)(F.ws + WS_R3); bf16* xc = (bf16*)(F.ws + WS_R45) + (size_t)MP * 1024;
    const float* cw = F.I(I_CONVW) + (size_t)l * 4 * 1024; const float* cb = F.I(I_CONVB) + (size_t)l * 1024;
    const int gw = F.vcu * 8 + F.wave, NGW = F.G * 8, lane = F.lane;
    const int total = (NTOK / 16) * 4, full = total / NGW;
    for (int k = 0; k <= full; ++k) { const int it = k * NGW + (k == full ? NGW - 1 - gw : gw); if (it >= total) break;
        const int g = it & 3, tp = it >> 2, n0 = (tp * 2 + (lane >> 5)) * 8, t0 = n0 % LSEQ, c8 = g * 256 + (lane & 31) * 8;
        if (g == 0) delta_conv_item<2>(cols, delta, xc, cw, cb, n0, t0, c8);
        else if (g == 1) delta_conv_item<4>(cols, delta, xc, cw, cb, n0, t0, c8);
        else if (g == 2) delta_conv_item<8>(cols, delta, xc, cw, cb, n0, t0, c8);
        else delta_conv_item<16>(cols, delta, xc, cw, cb, n0, t0, c8);
    }
}
typedef float f32x16 __attribute__((ext_vector_type(16)));
__device__ __forceinline__ void phase_attn(Frame& F, int l) {
    const bf16* cols = (const bf16*)(F.ws + WS_R2); bf16* mix = (bf16*)(F.ws + WS_R3);
    constexpr int KS_BYTES = 27648, BUF_BYTES = 27648 + 25088;
    const int tid = F.tid, lane = F.lane, wave = F.wave, r = lane & 31, h = lane >> 5, g = wave >> 1, qh = wave & 1;
    const int NU = NB * 4 * 65;
    u32x4 kreg[3], vreg[3];
#define ATT_FETCH(u_) do { const int qb_ = (u_) % 65, bk_ = (u_) / 65, kvh_ = bk_ & 3, b_ = bk_ >> 2, t0_ = qb_ * 64; const size_t nb_ = (size_t)b_ * LSEQ; \
        _Pragma("unroll") for (int i = 0; i < 3; ++i) { const int c = tid + 512 * i, key = c >> 3, dc = c & 7; int tc = t0_ - 128 + key; tc = tc < 0 ? 0 : (tc > LSEQ - 1 ? LSEQ - 1 : tc); \
            const bf16* src = cols + (nb_ + tc) * CW + kvh_ * 64 + dc * 8; kreg[i] = *(const u32x4*)(src + C_K); vreg[i] = *(const u32x4*)(src + C_V); } } while (0)
    int u = F.vcu, buf = 0;
    if (u < NU) ATT_FETCH(u);
    for (; u < NU; u += F.G, buf ^= 1) {
        LAS unsigned char* Ks = F.lds + buf * BUF_BYTES; LAS unsigned char* Vt = Ks + KS_BYTES;
        const int qb = u % 65, bk = u / 65, kvh = bk & 3, b = bk >> 2, t0 = qb * 64; const size_t nb = (size_t)b * LSEQ;
#pragma unroll
        for (int i = 0; i < 3; ++i) { const int c = tid + 512 * i, key = c >> 3, dc = c & 7; const u32x4 vv = vreg[i];
            *(LAS u32x4*)(Ks + key * 144 + dc * 16) = kreg[i];
            LAS unsigned short* vp = (LAS unsigned short*)(Vt + (8 * dc) * 392 + key * 2);
            vp[0 * 196] = (unsigned short)(vv.x & 0xffffu); vp[1 * 196] = (unsigned short)(vv.x >> 16); vp[2 * 196] = (unsigned short)(vv.y & 0xffffu); vp[3 * 196] = (unsigned short)(vv.y >> 16);
            vp[4 * 196] = (unsigned short)(vv.z & 0xffffu); vp[5 * 196] = (unsigned short)(vv.z >> 16); vp[6 * 196] = (unsigned short)(vv.w & 0xffffu); vp[7 * 196] = (unsigned short)(vv.w >> 16); }
        const int head = kvh * 4 + g, tq = t0 + 32 * qh + r, tqc = tq > LSEQ - 1 ? LSEQ - 1 : tq;
        bf16x8 qf[4];
        { const bf16* qp = cols + (nb + tqc) * CW + C_Q + head * 64 + 8 * h;
#pragma unroll
          for (int ks = 0; ks < 4; ++ks) qf[ks] = *(const bf16x8*)(qp + 16 * ks); }
        if (u + F.G < NU) ATT_FETCH(u + F.G);
        const float slope2 = exp2f(-0.5f * (float)(head + 1)) * 1.44269504089f, sink2 = F.I(I_SINK)[l * 16 + head] * 1.44269504089f;
        __syncthreads();
        f32x16 st[5];
#pragma unroll
        for (int jj = 0; jj < 5; ++jj) { f32x16 a;
#pragma unroll
            for (int i = 0; i < 16; ++i) a[i] = 0.f;
#pragma unroll
            for (int ks = 0; ks < 4; ++ks) { const bf16x8 kf = *(const LAS bf16x8*)(Ks + (32 * (qh + jj) + r) * 144 + (16 * ks + 8 * h) * 2); a = __builtin_amdgcn_mfma_f32_32x32x16_bf16(kf, qf[ks], a, 0, 0, 0); }
            st[jj] = a; }
        float m = sink2;
#pragma unroll
        for (int jj = 0; jj < 5; ++jj) { const int tsb = t0 - 128 + 32 * (qh + jj) + 4 * h, db = 128 - 32 * jj + r - 4 * h; const float dl = slope2 * (float)db; const bool edge = (jj == 0) || (jj == 4) || (t0 - 128 + 32 * (qh + jj) < 0);
            if (!edge) {
#pragma unroll
                for (int i = 0; i < 16; ++i) { const float v = __builtin_fmaf(st[jj][i], 1.44269504089f, __builtin_fmaf(slope2, (float)((i & 3) + 8 * (i >> 2)), -dl)); st[jj][i] = v; m = fmaxf(m, v); }
            } else {
#pragma unroll
                for (int i = 0; i < 16; ++i) { const int cr = (i & 3) + 8 * (i >> 2), dist = db - cr; const bool ok = dist >= 0 && dist < 128 && (tsb + cr) >= 0;
                    const float v = ok ? __builtin_fmaf(st[jj][i], 1.44269504089f, __builtin_fmaf(slope2, (float)cr, -dl)) : -1e30f; st[jj][i] = v; m = fmaxf(m, v); }
            } }
        m = fmaxf(m, __shfl_xor(m, 32));
        float sum = 0.f;
#pragma unroll
        for (int jj = 0; jj < 5; ++jj)
#pragma unroll
            for (int i = 0; i < 16; ++i) { const float pv = __builtin_amdgcn_exp2f(st[jj][i] - m); st[jj][i] = pv; sum += pv; }
        sum += __shfl_xor(sum, 32);
        const float inv = 1.0f / (sum + __builtin_amdgcn_exp2f(sink2 - m));
        f32x16 o[2];
#pragma unroll
        for (int i = 0; i < 16; ++i) { o[0][i] = 0.f; o[1][i] = 0.f; }
#pragma unroll
        for (int jj = 0; jj < 5; ++jj)
#pragma unroll
            for (int s = 0; s < 2; ++s) { u32x4 pw; pw.x = pk_bf16(st[jj][8 * s], st[jj][8 * s + 1]); pw.y = pk_bf16(st[jj][8 * s + 2], st[jj][8 * s + 3]); pw.z = pk_bf16(st[jj][8 * s + 4], st[jj][8 * s + 5]); pw.w = pk_bf16(st[jj][8 * s + 6], st[jj][8 * s + 7]);
                const bf16x8 pf = __builtin_bit_cast(bf16x8, pw);
#pragma unroll
                for (int db2 = 0; db2 < 2; ++db2) { const LAS unsigned char* vb = Vt + (32 * db2 + r) * 392 + (32 * (qh + jj) + 16 * s + 4 * h) * 2;
                    const u32x2 lo = *(const LAS u32x2*)vb, hi = *(const LAS u32x2*)(vb + 16); u32x4 vw; vw.x = lo.x; vw.y = lo.y; vw.z = hi.x; vw.w = hi.y;
                    o[db2] = __builtin_amdgcn_mfma_f32_32x32x16_bf16(__builtin_bit_cast(bf16x8, vw), pf, o[db2], 0, 0, 0); } }
        if (tq < LSEQ) { bf16* op = mix + (nb + tq) * 3072 + 1024 + head * 64 + 4 * h;
#pragma unroll
            for (int db2 = 0; db2 < 2; ++db2)
#pragma unroll
                for (int g4 = 0; g4 < 4; ++g4) { u32x2 w; w.x = pk_bf16(o[db2][4 * g4] * inv, o[db2][4 * g4 + 1] * inv); w.y = pk_bf16(o[db2][4 * g4 + 2] * inv, o[db2][4 * g4 + 3] * inv);
                    *(u32x2*)(op + 32 * db2 + 8 * g4) = w; } }
    }
#undef ATT_FETCH
    __syncthreads();
}
__device__ __forceinline__ void phase_lru_summ(Frame& F) {
    const bf16* Ab = (const bf16*)(F.ws + WS_R6); const bf16* Bb = Ab + (size_t)MP * 1024; float* summ = (float*)(F.ws + WS_SUMM);
    const int gt = ((F.tid >> 8) * F.G + F.vcu) * 256 + (F.tid & 255), NT = F.G * 512;
    for (int it = gt; it < NCHUNK * 256; it += NT) { const int ck = it >> 8, c = (it & 255) * 4, r0 = ck * 64, nr = (r0 + 64) <= NTOK ? 64 : NTOK - r0;
        f32x4 A = (f32x4){1.f, 1.f, 1.f, 1.f}, Bv = (f32x4){0.f, 0.f, 0.f, 0.f};
        const bf16* ap = Ab + (size_t)r0 * 1024 + c; const bf16* bp = Bb + (size_t)r0 * 1024 + c;
        for (int r = 0; r < nr; r += 16) { u32x2 aw[16], bw[16];
#pragma unroll
            for (int i = 0; i < 16; ++i) { aw[i] = *(const u32x2*)(ap + (size_t)(r + i) * 1024); bw[i] = *(const u32x2*)(bp + (size_t)(r + i) * 1024); }
#pragma unroll
            for (int i = 0; i < 16; ++i) { const f32x4 a = (f32x4){1.f - bflo(aw[i].x), 1.f - bfhi(aw[i].x), 1.f - bflo(aw[i].y), 1.f - bfhi(aw[i].y)}, b = (f32x4){bflo(bw[i].x), bfhi(bw[i].x), bflo(bw[i].y), bfhi(bw[i].y)};
                Bv = a * Bv + b; A = A * a; } }
        *(f32x4*)(summ + ((size_t)ck * 1024 + c) * 2) = A; *(f32x4*)(summ + ((size_t)ck * 1024 + c) * 2 + 4) = Bv; }
}
__device__ __forceinline__ void phase_lru_final(Frame& F) {
    const bf16* Ab = (const bf16*)(F.ws + WS_R6); const bf16* Bb = Ab + (size_t)MP * 1024; const float* summ = (const float*)(F.ws + WS_SUMM);
    const bf16* cols = (const bf16*)(F.ws + WS_R2); bf16* mix = (bf16*)(F.ws + WS_R3);
    const int gt = ((F.tid >> 8) * F.G + F.vcu) * 256 + (F.tid & 255), NT = F.G * 512;
    for (int it = gt; it < NCHUNK * 256; it += NT) { const int ck = it >> 8, c = (it & 255) * 4, r0 = ck * 64, nr = (r0 + 64) <= NTOK ? 64 : NTOK - r0;
        const int c0 = ((r0 / LSEQ) * LSEQ) / 64; f32x4 h = (f32x4){0.f, 0.f, 0.f, 0.f};
        int cc = c0;
        for (; cc + 16 <= ck; cc += 16) { f32x4 sa[16], sb[16];
#pragma unroll
            for (int i = 0; i < 16; ++i) { const float* sp = summ + ((size_t)(cc + i) * 1024 + c) * 2; sa[i] = *(const f32x4*)sp; sb[i] = *(const f32x4*)(sp + 4); }
#pragma unroll
            for (int i = 0; i < 16; ++i) h = sa[i] * h + sb[i]; }
        for (; cc + 4 <= ck; cc += 4) { f32x4 sa[4], sb[4];
#pragma unroll
            for (int i = 0; i < 4; ++i) { const float* sp = summ + ((size_t)(cc + i) * 1024 + c) * 2; sa[i] = *(const f32x4*)sp; sb[i] = *(const f32x4*)(sp + 4); }
#pragma unroll
            for (int i = 0; i < 4; ++i) h = sa[i] * h + sb[i]; }
        for (; cc < ck; ++cc) { const float* sp = summ + ((size_t)cc * 1024 + c) * 2; h = *(const f32x4*)sp * h + *(const f32x4*)(sp + 4); }
        const bf16* ap = Ab + (size_t)r0 * 1024 + c; const bf16* bp = Bb + (size_t)r0 * 1024 + c;
        for (int r = 0; r < nr; r += 16) { u32x2 aw[16], bw[16]; u32x2 yw[16];
#pragma unroll
            for (int i = 0; i < 16; ++i) { aw[i] = *(const u32x2*)(ap + (size_t)(r + i) * 1024); bw[i] = *(const u32x2*)(bp + (size_t)(r + i) * 1024); yw[i] = *(const u32x2*)(cols + (size_t)(r0 + r + i) * CW + C_LY + c); }
#pragma unroll
            for (int i = 0; i < 16; ++i) { const f32x4 a = (f32x4){1.f - bflo(aw[i].x), 1.f - bfhi(aw[i].x), 1.f - bflo(aw[i].y), 1.f - bfhi(aw[i].y)}, b = (f32x4){bflo(bw[i].x), bfhi(bw[i].x), bflo(bw[i].y), bfhi(bw[i].y)};
                h = a * h + b;
                const float y[4] = {bflo(yw[i].x), bfhi(yw[i].x), bflo(yw[i].y), bfhi(yw[i].y)}; float o[4];
#pragma unroll
                for (int j = 0; j < 4; ++j) o[j] = h[j] * y[j] * sigmoidf_(1.5957691216f * (y[j] + 0.044715f * y[j] * y[j] * y[j]));
                u32x2 w; w.x = pk_bf16(o[0], o[1]); w.y = pk_bf16(o[2], o[3]); *(u32x2*)(mix + (size_t)(r0 + r + i) * 3072 + 2048 + c) = w; } } }
}
template <int NG, bool DUMMY> __device__ __forceinline__ void ln1_groups(Frame& F, int l, int j0) {
    float* H = (float*)(F.ws + WS_H); float* Hout = DUMMY ? (float*)(F.ws + WS_R6) : H; unsigned char* HB8 = F.ws + (DUMMY ? WS_R3 : WS_HB8); const float* stats = (const float*)(F.ws + WS_STATS);
    const float* g1 = F.I(I_LN1G) + (size_t)l * D; const float* b1 = F.I(I_LN1B) + (size_t)l * D;
    const bf16* whi = (const bf16*)(F.ws + WS_WRT) + (size_t)(l * 2) * 48 * 2048; const bf16* wlo = whi + 48 * 2048;
    const int lane = F.lane, p = lane & 15, kg = lane >> 4, wave = F.wave;
    float mean[NG], rstd[NG]; size_t roff[NG]; f32x4 acc[NG][3];
#pragma unroll
    for (int j = 0; j < NG; ++j) { const int row = (F.vcu + (j0 + j) * F.G) * 16 + p; roff[j] = (size_t)row * D;
        float s = 0.f, q = 0.f; const f32x4* sp = (const f32x4*)(stats + (size_t)row * 64 + kg * 16);
#pragma unroll
        for (int i = 0; i < 4; ++i) { const f32x4 t = sp[i]; s += t[0] + t[2]; q += t[1] + t[3]; }
        s += __shfl_xor(s, 16); s += __shfl_xor(s, 32); q += __shfl_xor(q, 16); q += __shfl_xor(q, 32);
        mean[j] = s * (1.f / D); rstd[j] = 1.f / sqrtf(fmaxf(q * (1.f / D) - mean[j] * mean[j], 0.f) + LN_EPS);
#pragma unroll
        for (int cb = 0; cb < 3; ++cb) acc[j][cb] = (f32x4){0.f, 0.f, 0.f, 0.f}; }
#pragma unroll 2
    for (int ks = 0; ks < 8; ++ks) {
        const int col = wave * 256 + ks * 32 + kg * 8;
        f32x4 y0[NG], y1[NG];
#pragma unroll
        for (int j = 0; j < NG; ++j) { y0[j] = *(const f32x4*)(H + roff[j] + col); y1[j] = *(const f32x4*)(H + roff[j] + col + 4); }
        const LAS float* lv = (const LAS float*)(F.lds + VEC_OFF);
        const f32x4 ga = *(const LAS f32x4*)(lv + col), gb = *(const LAS f32x4*)(lv + col + 4), ba = *(const LAS f32x4*)(lv + 2048 + col), bb = *(const LAS f32x4*)(lv + 2048 + col + 4);
        bf16x8 wh[3], wl[3];
#pragma unroll
        for (int cb = 0; cb < 3; ++cb) { wh[cb] = *(const bf16x8*)(whi + (size_t)(cb * 16 + p) * 2048 + col); wl[cb] = *(const bf16x8*)(wlo + (size_t)(cb * 16 + p) * 2048 + col); }
#pragma unroll
        for (int j = 0; j < NG; ++j) {
            const f32x4 h0 = (y0[j] - mean[j]) * rstd[j] * ga + ba, h1 = (y1[j] - mean[j]) * rstd[j] * gb + bb;
            u32x4 hi; hi.x = pk_bf16(h0[0], h0[1]); hi.y = pk_bf16(h0[2], h0[3]); hi.z = pk_bf16(h1[0], h1[1]); hi.w = pk_bf16(h1[2], h1[3]);
            { u32x2 w8; w8.x = pk_fp8x4(h0[0], h0[1], h0[2], h0[3]); w8.y = pk_fp8x4(h1[0], h1[1], h1[2], h1[3]); *(u32x2*)(HB8 + roff[j] + col) = w8; }
            u32x4 lo; lo.x = pk_bf16(h0[0] - bflo(hi.x), h0[1] - bfhi(hi.x)); lo.y = pk_bf16(h0[2] - bflo(hi.y), h0[3] - bfhi(hi.y));
            lo.z = pk_bf16(h1[0] - bflo(hi.z), h1[1] - bfhi(hi.z)); lo.w = pk_bf16(h1[2] - bflo(hi.w), h1[3] - bfhi(hi.w));
            const bf16x8 xh = __builtin_bit_cast(bf16x8, hi), xl = __builtin_bit_cast(bf16x8, lo);
#pragma unroll
            for (int cb = 0; cb < 3; ++cb) { acc[j][cb] = __builtin_amdgcn_mfma_f32_16x16x32_bf16(wh[cb], xh, acc[j][cb], 0, 0, 0);
                acc[j][cb] = __builtin_amdgcn_mfma_f32_16x16x32_bf16(wh[cb], xl, acc[j][cb], 0, 0, 0); acc[j][cb] = __builtin_amdgcn_mfma_f32_16x16x32_bf16(wl[cb], xh, acc[j][cb], 0, 0, 0); } }
    }
#pragma unroll
    for (int j = 0; j < NG; ++j) { LAS float* lgs = (LAS float*)(F.lds + (j0 + j) * 24576);
#pragma unroll
        for (int cb = 0; cb < 3; ++cb) *(LAS f32x4*)(lgs + (wave * 16 + p) * 48 + cb * 16 + kg * 4) = acc[j][cb]; }
}
template <bool DUMMY> __device__ __forceinline__ void phase_ln1_router(Frame& F, int l) {
    float* H = (float*)(F.ws + WS_H); float* Hout = DUMMY ? (float*)(F.ws + WS_R6) : H; unsigned char* HB8 = F.ws + (DUMMY ? WS_R3 : WS_HB8); const float* stats = (const float*)(F.ws + WS_STATS);
    int* tokinfo = (int*)(F.ws + (DUMMY ? WS_R45 + 4 * MiB : WS_TOKINFO)); int* elist = (int*)(F.ws + (DUMMY ? WS_R45 : WS_ELIST)); unsigned* count = (unsigned*)(F.ws + WS_CTL) + CW_COUNT + ((DUMMY ? 64 : 0) + l * 32) * CNT_STRIDE;
    const float* g1 = F.I(I_LN1G) + (size_t)l * D; const float* b1 = F.I(I_LN1B) + (size_t)l * D;
    const bf16* whi = (const bf16*)(F.ws + WS_WRT) + (size_t)(l * 2) * 48 * 2048; const bf16* wlo = whi + 48 * 2048;
    const float* bg = F.I(I_RGB) + l * 4; const float* be = F.I(I_REB) + l * 32;
    const int lane = F.lane, p = lane & 15, kg = lane >> 4, wave = F.wave;
    { LAS float* lv = (LAS float*)(F.lds + VEC_OFF); const int i4 = 4 * F.tid; *(LAS f32x4*)(lv + i4) = *(const f32x4*)(g1 + i4); *(LAS f32x4*)(lv + 2048 + i4) = *(const f32x4*)(b1 + i4); }
    __syncthreads();
    ln1_groups<4, DUMMY>(F, l, 0); if (F.vcu + 4 * F.G < NTOK / 16) ln1_groups<1, DUMMY>(F, l, 4);
    __syncthreads();
    LAS unsigned* lcnt = (LAS unsigned*)(F.lds + TBL_OFF + 512);
    if (F.tid < 64) lcnt[F.tid] = 0u;
    __syncthreads();
    int ea = 0, eb = 0, n = 0; unsigned la = 0u, lb = 0u; float w0 = 0.f, w1 = 0.f; bool have = false;
    { const int grp = F.vcu + wave * F.G;
        if (grp < NTOK / 16 && lane < 16) {
            const LAS float* lgs = (const LAS float*)(F.lds + wave * 24576);
            n = grp * 16 + lane; have = true; float lg[36];
            const f32x4 bgv = *(const f32x4*)bg; f32x4 bev[8];
#pragma unroll
            for (int i = 0; i < 8; ++i) bev[i] = *(const f32x4*)(be + 4 * i);
#pragma unroll
            for (int i = 0; i < 36; ++i) lg[i] = 0.f;
#pragma unroll 1
            for (int w = 0; w < 8; ++w) {
#pragma unroll
                for (int i4 = 0; i4 < 9; ++i4) { const f32x4 t = *(const LAS f32x4*)(lgs + (w * 16 + lane) * 48 + 4 * i4); lg[4 * i4] += t[0]; lg[4 * i4 + 1] += t[1]; lg[4 * i4 + 2] += t[2]; lg[4 * i4 + 3] += t[3]; } }
            float gl[4];
#pragma unroll
            for (int i = 0; i < 4; ++i) gl[i] = lg[i] + bgv[i];
            int g = 0; float gm = gl[0];
#pragma unroll
            for (int i = 1; i < 4; ++i) if (gl[i] > gm) { gm = gl[i]; g = i; }
            float gs = 0.f;
#pragma unroll
            for (int i = 0; i < 4; ++i) gs += fast_exp(gl[i] - gm);
            const float pg = 1.0f / gs;
            float el[8];
#pragma unroll
            for (int j = 0; j < 8; ++j) { const float x0 = lg[4 + j] + bev[j >> 2][j & 3], x1 = lg[12 + j] + bev[2 + (j >> 2)][j & 3], x2 = lg[20 + j] + bev[4 + (j >> 2)][j & 3], x3 = lg[28 + j] + bev[6 + (j >> 2)][j & 3]; el[j] = g == 0 ? x0 : g == 1 ? x1 : g == 2 ? x2 : x3; }
            int i0 = 0; float m0 = el[0];
#pragma unroll
            for (int j = 1; j < 8; ++j) if (el[j] > m0) { m0 = el[j]; i0 = j; }
            int i1 = -1; float m1 = -3.0e38f;
#pragma unroll
            for (int j = 0; j < 8; ++j) if (j != i0 && el[j] > m1) { m1 = el[j]; i1 = j; }
            const float e1 = fast_exp(m1 - m0); w0 = pg / (1.0f + e1); w1 = pg * e1 / (1.0f + e1);
            ea = g * 8 + i0; eb = g * 8 + i1;
            la = __hip_atomic_fetch_add(lcnt + ea, 1u, __ATOMIC_RELAXED, __HIP_MEMORY_SCOPE_WORKGROUP); lb = __hip_atomic_fetch_add(lcnt + eb, 1u, __ATOMIC_RELAXED, __HIP_MEMORY_SCOPE_WORKGROUP);
        }
    }
    __syncthreads();
    if (F.tid < 32) { const unsigned c = lcnt[F.tid]; lcnt[32 + F.tid] = c ? __hip_atomic_fetch_add(count + F.tid * CNT_STRIDE, c, RLX_AGENT) : 0u; }
    __syncthreads();
    if (have) { const unsigned ra = lcnt[32 + ea] + la, rb = lcnt[32 + eb] + lb;
        elist[(size_t)ea * NTOK + ra] = n; elist[(size_t)eb * NTOK + rb] = n;
        int* ti = tokinfo + (size_t)n * 8; ti[0] = ea; ti[1] = (int)ra; ti[2] = __float_as_int(w0); ti[3] = eb; ti[4] = (int)rb; ti[5] = __float_as_int(w1); }
    __syncthreads();
    const int gw = F.vcu * 8 + F.wave, NGW = F.G * 8;
    LAS float* scr = (LAS float*)(F.lds + F.wave * 16384);
    if (!DUMMY) {
        if (F.G == 256) {
            const int TW = (NTOK / 16 - 4 * 256) * 8;
            const int nr = F.vcu < 4 ? 20 : 24;
            for (int k = 0; k < nr; ++k) conv_expert_weights(F, l, k * NGW + gw, scr);
            const int w = gw - TW; if (w >= 0 && w < 4 * TW) conv_expert_weights(F, l, (20 + w / TW) * NGW + (w % TW), scr);
        } else for (int it = gw; it < 49152; it += NGW) conv_expert_weights(F, l, it, scr);
    }
}
__device__ __forceinline__ void moe_tables(Frame& F, int l) {
    LAS int* tb = (LAS int*)(F.lds + TBL_OFF);
    __syncthreads();
    if (F.tid < 64) { const unsigned* count = (const unsigned*)(F.ws + WS_CTL) + CW_COUNT + l * 32 * CNT_STRIDE; const int e = F.tid;
        const int cn = e < 32 ? (int)__hip_atomic_load(count + e * CNT_STRIDE, RLX_AGENT) : 0; const int tiles = (cn + 255) >> 8; int incl = tiles;
#pragma unroll
        for (int d = 1; d < 32; d <<= 1) { const int t = __shfl_up(incl, d); if (e >= d) incl += t; }
        if (e < 32) { tb[e] = incl - tiles; tb[40 + e] = cn; } if (e == 31) tb[32] = incl; }
    __syncthreads();
}
template <bool DUMMY> __device__ __forceinline__ void phase_final(Frame& F, int l) {
    float* H = (float*)(F.ws + WS_H); bf16* HB = (bf16*)(F.ws + (DUMMY ? WS_R45 : WS_HB)); float* Hout = DUMMY ? (float*)(F.ws + WS_R6) : H; unsigned char* H8 = F.ws + (DUMMY ? WS_R3 : WS_HB8); const unsigned char* yd = F.ws + WS_R1; const int* tokinfo = (const int*)(F.ws + WS_TOKINFO);
    const LAS int* tb = (const LAS int*)(F.lds + TBL_OFF);
    const float* g2 = F.I(I_LN2G) + (size_t)l * D; const float* b2 = F.I(I_LN2B) + (size_t)l * D; const float* g1 = F.I(I_LN1G) + (size_t)l * D; const float* b1 = F.I(I_LN1B) + (size_t)l * D; const float* stats = (const float*)(F.ws + WS_STATS);
    const int gw = F.vcu * 8 + F.wave, NGW = F.G * 8, lane = F.lane;
    LAS float* lv = (LAS float*)F.lds;
    { const int i4 = 4 * F.tid; *(LAS f32x4*)(lv + i4) = *(const f32x4*)(g1 + i4); *(LAS f32x4*)(lv + 2048 + i4) = *(const f32x4*)(b1 + i4); *(LAS f32x4*)(lv + 4096 + i4) = *(const f32x4*)(g2 + i4); *(LAS f32x4*)(lv + 6144 + i4) = *(const f32x4*)(b2 + i4); }
    __syncthreads();
    for (int n = gw; n < NTOK; n += NGW) {
        const int t = n % LSEQ, b = n / LSEQ;
        if (!DUMMY && l == DEPTH - 1 && t < NMETA) continue;
        const int* ti = tokinfo + (size_t)n * 8; const int ea = ti[0], ra = ti[1], eb = ti[3], rb = ti[4]; const float w0 = __int_as_float(ti[2]) * (1.0f / YD_SCALE), w1 = __int_as_float(ti[5]) * (1.0f / YD_SCALE);
        const unsigned char* ya = yd + ((size_t)tb[ea] * 256 + ra) * D; const unsigned char* yb = yd + ((size_t)tb[eb] * 256 + rb) * D;
        f32x4 v[8]; load_row_f32(H + (size_t)n * D, v, lane);
        { float s = 0.f, q = 0.f;
          if (lane < 16) { const f32x4 t = *(const f32x4*)(stats + (size_t)n * 64 + 4 * lane); s = t[0] + t[2]; q = t[1] + t[3]; }
          s = wave_sum(s); q = wave_sum(q);
          const float mean = s * (1.f / D), rstd = 1.f / sqrtf(fmaxf(q * (1.f / D) - mean * mean, 0.f) + LN_EPS);
#pragma unroll
          for (int j = 0; j < 8; ++j) { const f32x4 gg = *(const LAS f32x4*)(lv + 4 * lane + 256 * j), bb = *(const LAS f32x4*)(lv + 2048 + 4 * lane + 256 * j); v[j] = (v[j] - mean) * rstd * gg + bb; } }
#pragma unroll
        for (int j = 0; j < 8; ++j) { const unsigned a = *(const unsigned*)(ya + 4 * lane + 256 * j), c = *(const unsigned*)(yb + 4 * lane + 256 * j);
            const f32x2 a0 = __builtin_amdgcn_cvt_pk_f32_fp8((int)a, false), a1 = __builtin_amdgcn_cvt_pk_f32_fp8((int)a, true), c0 = __builtin_amdgcn_cvt_pk_f32_fp8((int)c, false), c1 = __builtin_amdgcn_cvt_pk_f32_fp8((int)c, true);
            v[j].x = v[j].x * ALPHA + w0 * a0.x + w1 * c0.x; v[j].y = v[j].y * ALPHA + w0 * a0.y + w1 * c0.y;
            v[j].z = v[j].z * ALPHA + w0 * a1.x + w1 * c1.x; v[j].w = v[j].w * ALPHA + w0 * a1.y + w1 * c1.y; }
        ln_regs_lds(v, lv + 4096, lv + 6144, lane);
        if (!DUMMY && l == DEPTH - 1) store_row_f32(F.out + ((size_t)b * SEQ + (t - NMETA)) * D, v, lane);
        else { store_row_f32(Hout + (size_t)n * D, v, lane); store_row_bf16(HB + (size_t)n * D, v, lane); store_row_fp8(H8 + (size_t)n * D, v, lane); }
    }
}

constexpr int NPHASE = 1 + DEPTH * 11;
#define IN(k) (lo <= (k) && (k) < hi)
#define SEAM(k) do { if (IN(k) && IN((k) + 1)) { XcdBarrier b_ = bar; asm volatile("" : "+s"(b_.bar), "+s"(b_.x)); xcd_barrier(b_); } } while (0)
#define PH_BEGIN() F.z = opaque_s(0); F.ws = args.ws + F.z; F.vcu = vcu0 + F.z; F.tid = opaque_v(tid0); F.lane = F.tid & 63; F.wave = __builtin_amdgcn_readfirstlane(F.tid >> 6); const int bx = bx0 + F.z; (void)bx
template <int L> __device__ __forceinline__ void run_layer(Frame& F, const Args& args, const XcdBarrier& bar, const int lo, const int hi, const int bx0, const int vcu0, const int tid0) {
    constexpr int l = L; constexpr int pb = 1 + L * 11;
#define wl (F.ws + WS_WSMALL + (size_t)l * WL_BYTES)
        if (IN(pb + 0)) PREP(1) { PH_BEGIN();
            { PolA_<false> p; p.K = D; p.lda = D; p.ldb = D; p.A = F.ws + WS_HB; p.Bt = wl + WL_WIN; p.out = (bf16*)(F.ws + WS_R2); p.outc = p.out; p.G = F.G; p.c = bx;
              pg8::gemm_phase(F.lds, p, F.tid, F.ws); }
            { PolA_<true> p; p.K = D; p.lda = D; p.ldb = D; p.A = F.ws + WS_HB8; p.Bt = wl + WL_WIN8; p.out = (bf16*)(F.ws + WS_R1); p.outc = (bf16*)(F.ws + WS_R2); p.G = F.G; p.c = (F.G == 256) ? ((bx + A_LIGHT) & 255) : bx;
              pg8::gemm_phase(F.lds, p, F.tid, F.ws); } }
        SEAM(pb + 0);
        if (IN(pb + 1)) PREP(2) { PH_BEGIN();
            { PolW p; p.K = 256; p.lda = 1024; p.ldb = 256; p.pt = (const bf16*)(wl + WL_PROJ); p.wsc = (const bf16*)(F.ws + WS_WSC) + (size_t)l * 4 * 65536; p.wct = (bf16*)(F.ws + WS_WCT) + (size_t)l * D * 1024; p.G = F.G; p.c = (F.vcu + (F.G >> 1)) % F.G;
              pg8::gemm_phase(F.lds, p, F.tid, F.ws); }
            phase_delta_conv(F, l); phase_attn(F, l); }
        SEAM(pb + 1);
        if (IN(pb + 2)) PREP(3) { PH_BEGIN();
            PolC p; p.K = 256; p.lda = 1024; p.ldb = 256; p.delta = (const bf16*)(F.ws + WS_R45); p.xc = p.delta + (size_t)MP * 1024; p.pool_t = (const bf16*)(wl + WL_POOL); p.lru_t = (const bf16*)(wl + WL_LRU);
            p.mix = (bf16*)(F.ws + WS_R3); p.Abuf = (bf16*)(F.ws + WS_R6); p.Bbuf = p.Abuf + (size_t)MP * 1024; p.pool_scale = F.I(I_POOLS) + (size_t)l * 1024; p.ba = F.I(I_BA) + (size_t)l * 1024; p.bx = F.I(I_BX) + (size_t)l * 1024;
            p.sp8 = (const float*)(F.ws + WS_SP8) + (size_t)l * 1024; p.G = F.G; p.c = bx;
            pg8::gemm_phase(F.lds, p, F.tid, F.ws); tail_lru(F, l); }
        SEAM(pb + 2);
        if (IN(pb + 3)) PREP(4) { PH_BEGIN(); phase_lru_summ(F); }
        SEAM(pb + 3);
        if (IN(pb + 4)) PREP(5) { PH_BEGIN(); phase_lru_final(F); }
        SEAM(pb + 4);
        if (IN(pb + 5)) PREP(6) { PH_BEGIN();
            PolE p; p.K = 1024; p.lda = 3072; p.ldb = 1024; p.mix = (const bf16*)(F.ws + WS_R3); p.proj_t = (const bf16*)(wl + WL_PROJ); p.wct = (const bf16*)(F.ws + WS_WCT) + (size_t)l * D * 1024; p.gates = F.ws + WS_R1; p.merged = (bf16*)(F.ws + WS_R45); p.G = F.G; p.c = bx;
            p.t0 = 0; p.t1 = 512; pg8::gemm_phase(F.lds, p, F.tid, F.ws); tail_merge(F, l); }
        SEAM(pb + 5);
        if (IN(pb + 6)) PREP(7) { PH_BEGIN();
            PolF p; p.K = D; p.lda = D; p.ldb = D; p.A = (const bf16*)(F.ws + WS_R45); p.Bt = (const bf16*)(wl + WL_WOUT); p.H = (float*)(F.ws + WS_H); p.stats = (float*)(F.ws + WS_STATS); p.G = F.G; p.c = bx;
            p.t0 = 0; p.t1 = 512; pg8::gemm_phase(F.lds, p, F.tid, F.ws); tail_wout(F, l); }
        SEAM(pb + 6);
        if (IN(pb + 7)) PREP(8) { PH_BEGIN(); if (PROBE_G2) phase_ln1_router<true>(F, l); phase_ln1_router<false>(F, l); }
        SEAM(pb + 7);
        if (IN(pb + 8)) PREP(9) { PH_BEGIN();
            moe_tables(F, l);
            PolI p; p.K = D; p.lda = D; p.ldb = D; p.X = F.ws + WS_HB8; p.gu = F.ws + WS_R2 + EXPW_GU; p.elist = (const int*)(F.ws + WS_ELIST); p.hdn = F.ws + WS_R3;
            p.T.t = (const LAS int*)(F.lds + TBL_OFF); p.G = F.G; p.c = bx;
            pg8::gemm_phase(F.lds, p, F.tid, F.ws); }
        SEAM(pb + 8);
        if (IN(pb + 9)) PREP(10) { PH_BEGIN();
            moe_tables(F, l);
            PolJ p; p.K = DE; p.lda = DE; p.ldb = DE; p.hdn = F.ws + WS_R3; p.wd = F.ws + WS_R2 + EXPW_WD; p.yd = F.ws + WS_R1; p.T.t = (const LAS int*)(F.lds + TBL_OFF); p.G = F.G; p.c = bx;
            pg8::gemm_phase(F.lds, p, F.tid, F.ws); }
        SEAM(pb + 9);
        if (IN(pb + 10)) PREP(11) { PH_BEGIN(); moe_tables(F, l); if (PROBE_K2) phase_final<true>(F, l); phase_final<false>(F, l); }
        SEAM(pb + 10);
    }
#undef wl
__global__ void __launch_bounds__(512, 2) fwd(Args args) {
    extern __shared__ __attribute__((aligned(16))) unsigned char lds_raw[];
    Frame F; F.lds = (LAS unsigned char*)lds_raw; F.inp = args.in; F.z = 0; F.out = args.out; F.ws = args.ws;
    F.tid = threadIdx.x; F.lane = F.tid & 63; F.wave = __builtin_amdgcn_readfirstlane(F.tid >> 6);
    F.G = gridDim.x; { const int bx = blockIdx.x; F.vcu = (F.G % 8 == 0) ? (bx % 8) * (F.G / 8) + bx / 8 : bx; }
    volatile LAS unsigned* MISC = (volatile LAS unsigned*)(F.lds + MISC_OFF);
    for (int u = F.tid; u < (LDS_BYTES - MISC_OFF) / 4; u += 512) ((LAS unsigned*)(F.lds + MISC_OFF))[u] = 0u;
    __syncthreads();
    unsigned* ctl = (unsigned*)(F.ws + WS_CTL);
    XcdBarrier bar; bar.bar = ctl + CW_BAR; bar.x = 0; bar.st = nullptr;
    if (MK_ONE_LAUNCH) bar = xcd_barrier_post(ctl + CW_BAR, MISC + 8);
    const int lo = args.ph_lo, hi = args.ph_hi;
    const int bx0 = (int)blockIdx.x, vcu0 = F.vcu, tid0 = F.tid;

    if (IN(0)) PREP(0) { PH_BEGIN(); p0_prologue(F); } SEAM(0);

    run_layer<0>(F, args, bar, lo, hi, bx0, vcu0, tid0);
    run_layer<1>(F, args, bar, lo, hi, bx0, vcu0, tid0);
#undef IN
#undef SEAM
}

extern "C" void kernel_launch(void* const* d_in, const int* in_sizes, int n_in, void* d_out, int out_size, void* d_ws, size_t ws_size, hipStream_t stream) {
    static int grid = 0;
    if (grid == 0) {
        if (n_in != 30 || out_size != NB * SEQ * D || ws_size < WS_END) { fprintf(stderr, "kernel_launch: unexpected shapes (n_in %d, out %d, ws %zu)\n", n_in, out_size, ws_size); grid = -1; return; }
        int dev = 0, cus = 0, per_cu = 0;
        if (hipGetDevice(&dev) != hipSuccess || hipDeviceGetAttribute(&cus, hipDeviceAttributeMultiprocessorCount, dev) != hipSuccess) { grid = -1; return; }
        if (hipFuncSetAttribute((const void*)fwd, hipFuncAttributeMaxDynamicSharedMemorySize, LDS_BYTES) != hipSuccess) { fprintf(stderr, "kernel_launch: hipFuncSetAttribute failed\n"); grid = -1; return; }
        if (hipOccupancyMaxActiveBlocksPerMultiprocessor(&per_cu, (const void*)fwd, 512, LDS_BYTES) != hipSuccess || per_cu < 1) fprintf(stderr, "kernel_launch: occupancy query says %d\n", per_cu);
        (void)hipGetLastError();
        grid = cus;
    }
    if (grid < 0) return;
    (void)hipMemsetAsync((char*)d_ws + WS_CTL, 0, CTL_ZERO_BYTES, stream);
    Args a{};
    for (int i = 0; i < 30; ++i) a.in[i] = (const float*)d_in[i];
    a.out = (float*)d_out; a.ws = (unsigned char*)d_ws;
#if MK_ONE_LAUNCH
    a.ph_lo = 0; a.ph_hi = NPHASE;
    hipLaunchKernelGGL(fwd, dim3(grid), dim3(512), LDS_BYTES, stream, a);
#else
    for (int k = 0; k < NPHASE; ++k) { a.ph_lo = k; a.ph_hi = k + 1; hipLaunchKernelGGL(fwd, dim3(grid), dim3(512), LDS_BYTES, stream, a); }
#endif
}
```

```cpp
#include <hip/hip_runtime.h>
#include <cstdio>
#include <cstdint>

#define PROBE_MASK 0
#define PROBE_K2 0
#define PROBE_G2 0
#define PREP(k) for (int rep_ = 0; rep_ < (((PROBE_MASK) >> (k)) & 1) + 1; ++rep_)
#ifndef MK_ONE_LAUNCH
#define MK_ONE_LAUNCH 1
#endif

#define LAS __attribute__((address_space(3)))
#define GAS __attribute__((address_space(1)))
typedef unsigned short bf16;
typedef short bf16x8 __attribute__((ext_vector_type(8)));
typedef float f32x4 __attribute__((ext_vector_type(4)));
typedef float f32x2 __attribute__((ext_vector_type(2)));
typedef unsigned u32x4 __attribute__((ext_vector_type(4)));
typedef unsigned u32x2 __attribute__((ext_vector_type(2)));
typedef __bf16 bf16x2_t __attribute__((ext_vector_type(2)));
typedef int i32x4 __attribute__((ext_vector_type(4)));
typedef int i32x8 __attribute__((ext_vector_type(8)));
typedef GAS unsigned gu32;
#define RLX_AGENT __ATOMIC_RELAXED, __HIP_MEMORY_SCOPE_AGENT
#define LDS_WAIT() asm volatile("s_waitcnt lgkmcnt(0)" ::: "memory")
#define VM_WAIT() asm volatile("s_waitcnt vmcnt(0)" ::: "memory")

constexpr int D = 2048, NB = 4, SEQ = 4096, NMETA = 16, LSEQ = SEQ + NMETA, NTOK = NB * LSEQ  , MP = 16640  , NPANEL = 65, DEPTH = 2;
constexpr int CW = 4608  , GW = 6144, INC = CW + GW;
#ifndef A8_MASK
#define A8_MASK 0x3FE0Fu
#endif
constexpr int C_POOL = 0, C_Q = 1024, C_K = 2048, C_V = 2304, C_LX = 2560, C_LY = 3584;
constexpr int NEXP = 32, DE = 512, CAPT = 161, CAP = CAPT * 256, NCHUNK = (NTOK + 63) / 64  ;
constexpr float LN_EPS = 1e-5f, ALPHA = 1.41421356237f;

constexpr size_t MiB = 1u << 20;
constexpr size_t WS_CTL = 0, CTL_ZERO_BYTES = 1 * MiB;
constexpr size_t WS_SP8 = 1 * MiB;
constexpr size_t WS_TOKINFO = 2 * MiB;
constexpr size_t WS_ELIST = 3 * MiB;
constexpr size_t WS_SUMM = 6 * MiB;
constexpr size_t WS_WSMALL = 9 * MiB;
constexpr size_t WL_WIN8 = (size_t)CW * 2048 * 2;
constexpr size_t WL_BYTES = 66584576, WL_WIN = 0, WL_PROJ = 44040192, WL_WOUT = 56623104, WL_POOL = 65011712, WL_LRU = 65536000;
constexpr size_t WS_H = 136 * MiB;
constexpr size_t WS_HB = 266 * MiB;
constexpr size_t WS_R1 = 331 * MiB;
constexpr size_t WS_R2 = 526 * MiB;
constexpr size_t WS_R6 = 673 * MiB;
constexpr size_t WS_R3 = 803 * MiB;
constexpr size_t WS_R45 = 901 * MiB;
constexpr size_t WS_STATS = 966 * MiB;
constexpr size_t WS_WRT = 972 * MiB;
constexpr size_t WS_HB8 = 974 * MiB;
constexpr size_t WS_WSC = 1008 * MiB;
constexpr size_t WS_WCT = 1010 * MiB;
constexpr size_t WS_END = 1018 * MiB;
constexpr size_t EXPW_GU = 0, EXPW_WD = 67108864;
constexpr float W8_SCALE = 64.0f, HDN_SCALE = 8.0f, YD_SCALE = 16.0f;
static_assert(WS_WSMALL + 2 * WL_BYTES <= WS_H && WS_R2 + 201326592 <= WS_R3 && WS_R6 + 2ull * MP * 1024 * 4 <= WS_R3 && WS_R3 + (size_t)MP * 3072 * 2 <= WS_R45 && WS_R45 + (size_t)MP * 2048 * 2 <= WS_END, "ws map");
static_assert(WS_R1 + (size_t)MP * GW * 2 <= WS_R2 && (size_t)CAP * 2048 * 2 <= (size_t)MP * GW * 2 && WS_R2 + (size_t)MP * CW * 2 <= WS_R6, "ws map 2");
constexpr int CW_BAR = 4096;
constexpr int CW_COUNT = 16384, CNT_STRIDE = 32;

constexpr int RING_BYTES = 131072, MISC_OFF = RING_BYTES, TBL_OFF = RING_BYTES + 1024, VEC_OFF = TBL_OFF + 2048  , LDS_BYTES = VEC_OFF + 16384;

__device__ __forceinline__ unsigned pk_bf16(float lo, float hi) { f32x2 v = {lo, hi}; bf16x2_t b = __builtin_convertvector(v, bf16x2_t); return __builtin_bit_cast(unsigned, b); }
__device__ __forceinline__ unsigned pk_fp8x4(float a, float b, float c, float d) { int w = 0; w = __builtin_amdgcn_cvt_pk_fp8_f32(a, b, w, false); w = __builtin_amdgcn_cvt_pk_fp8_f32(c, d, w, true); return (unsigned)w; }
__device__ __forceinline__ float bf2f(unsigned short b) { return __uint_as_float(((unsigned)b) << 16); }
__device__ __forceinline__ float bflo(unsigned w) { return __uint_as_float(w << 16); }
__device__ __forceinline__ float bfhi(unsigned w) { return __uint_as_float(w & 0xffff0000u); }
__device__ __forceinline__ float fast_exp(float x) { return __builtin_amdgcn_exp2f(x * 1.44269504089f); }
__device__ __forceinline__ float sigmoidf_(float x) { return __builtin_amdgcn_rcpf(1.0f + fast_exp(-x)); }
__device__ __forceinline__ unsigned pk_gate4(float a, float b, float c, float d) {
    unsigned r = __builtin_amdgcn_cvt_pk_u8_f32(a * 255.0f, 0u, 0u); r = __builtin_amdgcn_cvt_pk_u8_f32(b * 255.0f, 1u, r); r = __builtin_amdgcn_cvt_pk_u8_f32(c * 255.0f, 2u, r); return __builtin_amdgcn_cvt_pk_u8_f32(d * 255.0f, 3u, r); }
__device__ __forceinline__ float wave_sum(float v) {
#pragma unroll
    for (int o = 1; o < 64; o <<= 1) v += __shfl_xor(v, o);
    return v;
}
__device__ __forceinline__ float wave_max(float v) {
#pragma unroll
    for (int o = 1; o < 64; o <<= 1) v = fmaxf(v, __shfl_xor(v, o));
    return v;
}

namespace pg8 {
constexpr int BM = 256, BK = 64, HALF = 128, HTB = HALF * BK * 2, STAGE_BYTES = 8 * HTB;
__host__ __device__ __forceinline__ int lds_byte(int r, int c) { const int st = (r >> 4) * 2 + (c >> 5), rr = r & 15, cc = c & 31, ob = rr * 64 + cc * 2; return st * 1024 + (ob ^ (((ob >> 9) & 1) << 5)); }
__host__ __device__ __forceinline__ void stage_rc(int b, int& R, int& C) { const int st = b / 1024, sb = b % 1024, swz = sb ^ (((sb >> 9) & 1) << 5); R = (st >> 1) * 16 + swz / 64; C = (st & 1) * 32 + (swz % 64) / 2; }
__host__ __device__ __forceinline__ int perm32(int rho) { const int n = rho >> 4, i = rho & 15; return 8 * (i >> 2) + 4 * n + (i & 3); }
struct Unit { int pm, pn, z; };

template <class P, class = void> struct adj_trait { static constexpr bool v = false; };
template <class P> struct adj_trait<P, decltype((void)P::ADJ)> { static constexpr bool v = P::ADJ; };
template <class P> __host__ __device__ constexpr bool adj_b() { return adj_trait<P>::v; }
template <class P, bool TAIL = false>
__device__ __forceinline__ void gemm_phase(LAS unsigned char* lds, const P& p, const int tid, const unsigned char* wsbase) {
    const __amdgpu_buffer_rsrc_t rsrc = __builtin_amdgcn_make_buffer_rsrc((void*)wsbase, 0, 0xffffffffu, 0x00020000);
    const int wid = __builtin_amdgcn_readfirstlane(tid >> 6), lane = tid & 63, wr = wid >> 2, wc = wid & 3, fr = lane & 15, fq = lane >> 4;
    constexpr int ESZ = P::ESZ;
    const int K = p.K, nt = K * ESZ / 128, lda = p.lda, ldb = p.ldb;
    unsigned voffA[2], voffB[2]; int Rr[2], Cc[2];
#pragma unroll
    for (int i = 0; i < 2; ++i) { int R, C; stage_rc(tid * 16 + i * 8192, R, C); Rr[i] = R; Cc[i] = C; const int Rb = adj_b<P>() ? (64 * (R >> 5) + perm32(R & 31)) : (P::PERM ? ((R & ~31) + perm32(R & 31)) : R);
        voffA[i] = (unsigned)(R * lda * ESZ + C * 2); voffB[i] = (unsigned)(Rb * ldb * ESZ + C * 2); }
    const unsigned kstep = (unsigned)(BK * 2);
    const unsigned hstepA = (unsigned)(HALF * lda * ESZ), hstepB = (unsigned)((adj_b<P>() ? 32 : HALF) * ldb * ESZ);
    const unsigned ldsw0 = (unsigned)wid * 1024u; const unsigned ldsw = ldsw0;
    const int aoff = lds_byte(wr * 64 + fr, fq * 8), boff = lds_byte(wc * 32 + fr, fq * 8);
    auto opaque_tid = [&]() { int t_ = tid; asm volatile("" : "+v"(t_)); return t_; };
    unsigned vc[2][2];
#define PG8_SA(b, h) (((b) * 2 + (h)) * HTB)
#define PG8_SB(b, h) ((4 + (b) * 2 + (h)) * HTB)
#define PG8_GLDS(so, vo, ldsoff) __builtin_amdgcn_raw_ptr_buffer_load_lds(rsrc, (LAS void*)(lds + (ldsoff)), 16, (int)(vo), (int)(so), 0, 0)
#define PG8_STAGE_B(bufoff, gb) do { PG8_GLDS((gb), voffB[0], (bufoff) + ldsw); PG8_GLDS((gb), voffB[1], (bufoff) + ldsw + 8192); } while (0)
#define PG8_STAGE_A(bufoff, ga, h, NX) do { if constexpr (P::GATHER) { PG8_GLDS((ga), vc[h][0], (bufoff) + ldsw); PG8_GLDS((ga), vc[h][1], (bufoff) + ldsw + 8192); } \
        else { PG8_GLDS((ga) + (h) * hstepA, voffA[0], (bufoff) + ldsw); PG8_GLDS((ga) + (h) * hstepA, voffA[1], (bufoff) + ldsw + 8192); } } while (0)
#define PG8_LDA(dst, b, h) do { if constexpr (TAIL) { if ((h) == 1 || wr == 1) break; } _Pragma("unroll") for (int m = 0; m < 4; ++m) _Pragma("unroll") for (int k = 0; k < 2; ++k) dst[m][k] = *(const LAS bf16x8*)(lds + PG8_SA(b, h) + aoff + m * 2048 + k * 1024); } while (0)
#define PG8_LDB(dst, b, h) do { if constexpr (TAIL) { if (wr == 1) break; } _Pragma("unroll") for (int n = 0; n < 2; ++n) _Pragma("unroll") for (int k = 0; k < 2; ++k) dst[n][k] = *(const LAS bf16x8*)(lds + PG8_SB(b, h) + boff + n * 2048 + k * 1024); } while (0)
#define PG8_MMA(ai, bj, At, Bt) do { if constexpr (TAIL) { if ((ai) == 1 || wr == 1) break; } __builtin_amdgcn_s_setprio(1); _Pragma("unroll") for (int m = 0; m < 4; ++m) _Pragma("unroll") for (int n = 0; n < 2; ++n) { \
        if constexpr (ESZ == 2) { _Pragma("unroll") for (int k = 0; k < 2; ++k) acc[ai][bj][m][n] = __builtin_amdgcn_mfma_f32_16x16x32_bf16(Bt[n][k], At[m][k], acc[ai][bj][m][n], 0, 0, 0); } \
        else { const i32x8 b8_ = __builtin_shufflevector(__builtin_bit_cast(i32x4, Bt[n][0]), __builtin_bit_cast(i32x4, Bt[n][1]), 0, 1, 2, 3, 4, 5, 6, 7), a8_ = __builtin_shufflevector(__builtin_bit_cast(i32x4, At[m][0]), __builtin_bit_cast(i32x4, At[m][1]), 0, 1, 2, 3, 4, 5, 6, 7); \
               asm volatile("v_mfma_f32_16x16x128_f8f6f4 %0, %1, %2, %0" : "+v"(acc[ai][bj][m][n]) : "v"(b8_), "v"(a8_)); } } \
        __builtin_amdgcn_s_setprio(0); } while (0)
#define PG8_WAIT_V(n) asm volatile("s_waitcnt vmcnt(" #n ")" ::: "memory")
#define PG8_WAIT_L(n) asm volatile("s_waitcnt lgkmcnt(" #n ")" ::: "memory")
#define PG8_BAR __builtin_amdgcn_s_barrier()
#define PG8_SCHED __builtin_amdgcn_sched_barrier(0)
#define PG8_ROWOFFS(dst, u) do { _Pragma("unroll") for (int i_ = 0; i_ < 2; ++i_) { int R_, C_; stage_rc(opaque_tid() * 16 + i_ * 8192, R_, C_); _Pragma("unroll") for (int h_ = 0; h_ < 2; ++h_) dst[h_][i_] = (unsigned)(p.a_row(u, h_ * HALF + R_) * lda * ESZ + C_ * 2); } } while (0)
    Unit cur, nxt; int ui = 0;
    if (!p.next(0, cur)) return;
    f32x4 acc[2][2][4][2];
#pragma unroll
    for (int a = 0; a < 2; ++a)
#pragma unroll
        for (int b = 0; b < 2; ++b)
#pragma unroll
            for (int m = 0; m < 4; ++m)
#pragma unroll
                for (int n = 0; n < 2; ++n) acc[a][b][m][n] = (f32x4){0.f, 0.f, 0.f, 0.f};
    bf16x8 At[4][2], B0[2][2], B1[2][2];
    unsigned cA = (unsigned)((const unsigned char*)p.a_ptr(cur) - wsbase), cB = (unsigned)((const unsigned char*)p.b_ptr(cur) - wsbase);
    if constexpr (P::GATHER) { PG8_ROWOFFS(vc, cur); }
    PG8_STAGE_B(PG8_SB(0, 0), cB); PG8_STAGE_B(PG8_SB(0, 1), cB + hstepB); PG8_STAGE_A(PG8_SA(0, 0), cA, 0, false); PG8_STAGE_A(PG8_SA(0, 1), cA, 1, false);
    if (wr == 1) PG8_BAR;
    PG8_WAIT_V(2); PG8_BAR;
    PG8_STAGE_B(PG8_SB(1, 0), cB + kstep); PG8_STAGE_A(PG8_SA(1, 0), cA + kstep, 0, false); PG8_STAGE_B(PG8_SB(1, 1), cB + hstepB + kstep);
    PG8_WAIT_V(6); PG8_BAR;
    for (;;) {
        const bool has_next = p.next(ui + 1, nxt);
        const unsigned nA = has_next ? (unsigned)((const unsigned char*)p.a_ptr(nxt) - wsbase) : cA, nB = has_next ? (unsigned)((const unsigned char*)p.b_ptr(nxt) - wsbase) : cB;
        for (int t = 0; t < nt; t += 2) {
            const bool last = (t == nt - 2);
            unsigned ldsw = ldsw0; asm volatile("" : "+s"(ldsw));
            const unsigned a1 = cA + (unsigned)(t + 1) * kstep;
            const unsigned a2 = last ? nA : cA + (unsigned)(t + 2) * kstep, b2 = last ? nB : cB + (unsigned)(t + 2) * kstep;
            const unsigned a3 = a2 + kstep, b3 = b2 + kstep;
            unsigned vt[2][2];
            if constexpr (P::GATHER) { if (last && has_next) { PG8_ROWOFFS(vt, nxt); } }
            PG8_LDB(B0, 0, 0); PG8_LDB(B1, 0, 1); PG8_SCHED; PG8_LDA(At, 0, 0); PG8_STAGE_A(PG8_SA(1, 1), a1, 1, false);
            PG8_WAIT_V(8); PG8_WAIT_L(0); PG8_BAR; PG8_MMA(0, 0, At, B0); PG8_MMA(0, 1, At, B1); PG8_BAR; PG8_SCHED;
            if constexpr (P::GATHER) { if (last && has_next) {
#pragma unroll
                for (int h = 0; h < 2; ++h) { vc[h][0] = vt[h][0]; vc[h][1] = vt[h][1]; } } }
            PG8_LDA(At, 0, 1); PG8_STAGE_B(PG8_SB(0, 0), b2); PG8_STAGE_B(PG8_SB(0, 1), b2 + hstepB); PG8_STAGE_A(PG8_SA(0, 0), a2, 0, last);
            PG8_WAIT_V(8); PG8_WAIT_L(0); PG8_BAR; PG8_MMA(1, 0, At, B0); PG8_MMA(1, 1, At, B1); PG8_BAR; PG8_SCHED;
            PG8_LDB(B0, 1, 0); PG8_LDB(B1, 1, 1); PG8_SCHED; PG8_LDA(At, 1, 0); PG8_STAGE_A(PG8_SA(0, 1), a2, 1, last);
            PG8_WAIT_V(8); PG8_WAIT_L(0); PG8_BAR; PG8_MMA(0, 0, At, B0); PG8_MMA(0, 1, At, B1); PG8_BAR; PG8_SCHED;
            PG8_LDA(At, 1, 1); PG8_STAGE_B(PG8_SB(1, 0), b3); PG8_STAGE_B(PG8_SB(1, 1), b3 + hstepB); PG8_STAGE_A(PG8_SA(1, 0), a3, 0, last);
            PG8_WAIT_V(8); PG8_WAIT_L(0); PG8_BAR; PG8_MMA(1, 0, At, B0); PG8_MMA(1, 1, At, B1); PG8_BAR; PG8_SCHED;
        }
        if constexpr (ESZ == 1) asm volatile("s_nop 15\n\ts_nop 15" ::: "memory");
        if (wr == 0) PG8_BAR;
        bool zero;
        { int t2 = tid; asm volatile("" : "+v"(t2));
          const int l2 = t2 & 63, w2 = __builtin_amdgcn_readfirstlane(t2 >> 6); zero = p.template epi<TAIL>(acc, cur, w2 >> 2, w2 & 3, l2 & 15, l2 >> 4); }
        if (!has_next) break;
        if (zero) {
#pragma unroll
            for (int a = 0; a < 2; ++a)
#pragma unroll
                for (int b = 0; b < 2; ++b)
#pragma unroll
                    for (int m = 0; m < 4; ++m)
#pragma unroll
                        for (int n = 0; n < 2; ++n) acc[a][b][m][n] = (f32x4){0.f, 0.f, 0.f, 0.f};
        }
        cur = nxt; cA = nA; cB = nB; ++ui;
        if (wr == 1) PG8_BAR;
    }
    PG8_WAIT_V(0);
    PG8_BAR;
#undef PG8_SA
#undef PG8_SB
#undef PG8_GLDS
#undef PG8_STAGE_A
#undef PG8_STAGE_B
#undef PG8_LDA
#undef PG8_LDB
#undef PG8_MMA
#undef PG8_WAIT_V
#undef PG8_WAIT_L
#undef PG8_BAR
#undef PG8_SCHED
#undef PG8_ROWOFFS
}
}

#define XB_TMO      128
#define XB_XCNT(j)  (256  + 64 * (j))
#define XB_XSUB(j)  (1280 + 64 * (j))
#define XB_XGEN(j)  (2304 + 64 * (j))
#define XB_TOP      3328
#define XB_TOPGEN   3392
#define XCD_BAR_WORDS 3456
#define XB_SPIN_CAP (1u << 18)
__device__ __forceinline__ unsigned xb_ld(unsigned* p)              { return __hip_atomic_load(p, __ATOMIC_RELAXED, __HIP_MEMORY_SCOPE_AGENT); }
__device__ __forceinline__ unsigned xb_add(unsigned* p, unsigned v) { return __hip_atomic_fetch_add(p, v, __ATOMIC_RELAXED, __HIP_MEMORY_SCOPE_AGENT); }
__device__ __forceinline__ unsigned xb_xcc_id() { return (unsigned)__builtin_amdgcn_s_getreg((3 << 11) | 20) & 0xFu; }
#define XB_SPIN(cond, bar) do { unsigned _sp = 0; while (cond) { __builtin_amdgcn_s_sleep(1); \
    if ((++_sp & 255u) == 0u) { if (xb_ld(&(bar)[XB_TMO])) break; if (_sp > XB_SPIN_CAP) { atomicAdd(&(bar)[XB_TMO], 1u); break; } } } } while (0)
struct XcdBarrier { unsigned* bar; unsigned x; volatile LAS unsigned* st; };
__device__ __forceinline__ XcdBarrier xcd_barrier_post(unsigned* bar, volatile LAS unsigned* st) {
    XcdBarrier b; b.bar = bar; b.x = xb_xcc_id(); b.st = st;
    if (threadIdx.x == 0) (void)xb_add(&bar[XB_XCNT(b.x)], 1u);
    return b;
}
__device__ __forceinline__ void xcd_barrier_complete(unsigned* bar, unsigned x, unsigned& nloc, unsigned& nx) {
    const unsigned G = gridDim.x * gridDim.y * gridDim.z;
    unsigned sum, cnt, mine, sp = 0u;
    for (;;) {
        sum = 0u; cnt = 0u; mine = 0u;
#pragma unroll
        for (unsigned j = 0; j < 16; ++j) { const unsigned c = xb_ld(&bar[XB_XCNT(j)]); sum += c; cnt += (c > 0u) ? 1u : 0u; mine = (j == x) ? c : mine; }
        if (sum == G) break;
        __builtin_amdgcn_s_sleep(1);
        if ((++sp & 255u) == 0u) { if (xb_ld(&bar[XB_TMO])) break; if (sp > XB_SPIN_CAP) { atomicAdd(&bar[XB_TMO], 1u); break; } }
    }
    nloc = mine > 0u ? mine : 1u; nx = cnt > 0u ? cnt : 1u;
}
__device__ __forceinline__ void xcd_barrier(const XcdBarrier& b) {
    asm volatile("s_waitcnt vmcnt(0)" ::: "memory");
    __syncthreads();
    if (threadIdx.x == 0) {
        unsigned* bar = b.bar;
        __builtin_amdgcn_s_waitcnt(0);
        unsigned nloc = b.st[0], nx = b.st[1];
        if (nloc == 0u) { xcd_barrier_complete(bar, b.x, nloc, nx); b.st[0] = nloc; b.st[1] = nx; }
        const unsigned old = xb_add(&bar[XB_XSUB(b.x)], 1u);
        const unsigned gen = old / nloc;
        if (old + 1u == (gen + 1u) * nloc) {
            __builtin_amdgcn_fence(__ATOMIC_RELEASE, "agent");
            asm volatile("s_waitcnt vmcnt(0)" ::: "memory");
            const unsigned og = xb_add(&bar[XB_TOP], 1u);
            const unsigned tg = og / nx;
            if (og + 1u == (tg + 1u) * nx) xb_add(&bar[XB_TOPGEN], 1u);
            else XB_SPIN(xb_ld(&bar[XB_TOPGEN]) == tg, bar);
            __builtin_amdgcn_fence(__ATOMIC_ACQUIRE, "agent");
            xb_add(&bar[XB_XGEN(b.x)], 1u);
            asm volatile("s_waitcnt vmcnt(0)" ::: "memory");
        } else {
            XB_SPIN(xb_ld(&bar[XB_XGEN(b.x)]) == gen, bar);
            __builtin_amdgcn_fence(__ATOMIC_ACQUIRE, "agent");
            asm volatile("s_waitcnt vmcnt(0)" ::: "memory");
        }
    }
    __syncthreads();
}

struct Args { const float* in[30]; float* out; unsigned char* ws; int ph_lo, ph_hi; };
enum { I_X = 0, I_META, I_LNE_G, I_LNE_B, I_WIN, I_POOLW, I_POOLS, I_SINK, I_CONVW, I_CONVB, I_WA, I_BA, I_WX, I_BX, I_LAM, I_PPOOL, I_PATTN, I_PLRU, I_WOUT,
       I_LN1G, I_LN1B, I_RGW, I_RGB, I_REW, I_REB, I_EG, I_EU, I_ED, I_LN2G, I_LN2B };

struct Frame {
    LAS unsigned char* lds;
    const float* const* inp; float* out; unsigned char* ws;
    int tid, lane, wave, vcu, G, z;
    __device__ __forceinline__ const float* I(int k) const { return inp[k + z]; }
};
__device__ __forceinline__ int opaque_s(int x) { asm volatile("" : "+s"(x)); return x; }
__device__ __forceinline__ int opaque_v(int x) { asm volatile("" : "+v"(x)); return x; }

__device__ __forceinline__ void transpose_item(const float* W, int ldw, int k0, int n0, bf16* WT, int ldt, int drow0, LAS float* scr, int lane) {
    f32x4 v[8]; const int kr = lane >> 3, nq = (lane & 7) * 4;
#pragma unroll
    for (int i = 0; i < 8; ++i) v[i] = __builtin_nontemporal_load((const f32x4*)(W + (size_t)(k0 + 8 * i + kr) * ldw + n0 + nq));
#pragma unroll
    for (int i = 0; i < 8; ++i) { LAS float* d = scr + (8 * i + kr) * 33 + nq; d[0] = v[i][0]; d[1] = v[i][1]; d[2] = v[i][2]; d[3] = v[i][3]; }
    LDS_WAIT();
    const int c = lane & 7;
#pragma unroll
    for (int j = 0; j < 4; ++j) { const int n = (lane >> 3) + 8 * j; const LAS float* s = scr + (8 * c) * 33 + n;
        u32x4 o; o.x = pk_bf16(s[0 * 33], s[1 * 33]); o.y = pk_bf16(s[2 * 33], s[3 * 33]); o.z = pk_bf16(s[4 * 33], s[5 * 33]); o.w = pk_bf16(s[6 * 33], s[7 * 33]);
        *(u32x4*)(WT + (size_t)(drow0 + n) * ldt + k0 + 8 * c) = o; }
    LDS_WAIT();
}

__device__ __forceinline__ void transpose_item8(const float* W, int ldw, int k0, int n0, unsigned char* WT, int ldt, int drow0, float scale, LAS float* scr, int lane) {
    f32x4 v[8]; const int kr = lane >> 3, nq = (lane & 7) * 4;
#pragma unroll
    for (int i = 0; i < 8; ++i) v[i] = __builtin_nontemporal_load((const f32x4*)(W + (size_t)(k0 + 8 * i + kr) * ldw + n0 + nq));
#pragma unroll
    for (int i = 0; i < 8; ++i) { LAS float* d = scr + (8 * i + kr) * 33 + nq; d[0] = v[i][0]; d[1] = v[i][1]; d[2] = v[i][2]; d[3] = v[i][3]; }
    LDS_WAIT();
    const int c = lane & 3;
#pragma unroll
    for (int j = 0; j < 2; ++j) { const int n = (lane >> 2) + 16 * j; const LAS float* s = scr + (16 * c) * 33 + n;
        u32x4 o; o.x = pk_fp8x4(s[0 * 33] * scale, s[1 * 33] * scale, s[2 * 33] * scale, s[3 * 33] * scale); o.y = pk_fp8x4(s[4 * 33] * scale, s[5 * 33] * scale, s[6 * 33] * scale, s[7 * 33] * scale);
        o.z = pk_fp8x4(s[8 * 33] * scale, s[9 * 33] * scale, s[10 * 33] * scale, s[11 * 33] * scale); o.w = pk_fp8x4(s[12 * 33] * scale, s[13 * 33] * scale, s[14 * 33] * scale, s[15 * 33] * scale);
        *(u32x4*)(WT + (size_t)(drow0 + n) * ldt + k0 + 16 * c) = o; }
    LDS_WAIT();
}

__device__ __forceinline__ void ln_regs(f32x4 (&v)[8], const float* g, const float* b, int lane) {
    float s = 0.f;
#pragma unroll
    for (int j = 0; j < 8; ++j) s += (v[j].x + v[j].y) + (v[j].z + v[j].w);
    const float mean = wave_sum(s) * (1.f / D); float s2 = 0.f;
#pragma unroll
    for (int j = 0; j < 8; ++j) { v[j] = v[j] - mean; s2 += (v[j].x * v[j].x + v[j].y * v[j].y) + (v[j].z * v[j].z + v[j].w * v[j].w); }
    const float rstd = 1.f / sqrtf(wave_sum(s2) * (1.f / D) + LN_EPS);
#pragma unroll
    for (int j = 0; j < 8; ++j) { const f32x4 gg = *(const f32x4*)(g + 4 * lane + 256 * j), bb = *(const f32x4*)(b + 4 * lane + 256 * j); v[j] = v[j] * rstd * gg + bb; }
}
__device__ __forceinline__ void ln_regs_lds(f32x4 (&v)[8], const LAS float* g, const LAS float* b, int lane) {
    float s = 0.f;
#pragma unroll
    for (int j = 0; j < 8; ++j) s += (v[j].x + v[j].y) + (v[j].z + v[j].w);
    const float mean = wave_sum(s) * (1.f / D); float s2 = 0.f;
#pragma unroll
    for (int j = 0; j < 8; ++j) { v[j] = v[j] - mean; s2 += (v[j].x * v[j].x + v[j].y * v[j].y) + (v[j].z * v[j].z + v[j].w * v[j].w); }
    const float rstd = 1.f / sqrtf(wave_sum(s2) * (1.f / D) + LN_EPS);
#pragma unroll
    for (int j = 0; j < 8; ++j) { const f32x4 gg = *(const LAS f32x4*)(g + 4 * lane + 256 * j), bb = *(const LAS f32x4*)(b + 4 * lane + 256 * j); v[j] = v[j] * rstd * gg + bb; }
}
__device__ __forceinline__ void store_row_bf16(bf16* orow, const f32x4 (&v)[8], int lane) {
#pragma unroll
    for (int j = 0; j < 8; ++j) { u32x2 w; w.x = pk_bf16(v[j].x, v[j].y); w.y = pk_bf16(v[j].z, v[j].w); *(u32x2*)(orow + 4 * lane + 256 * j) = w; }
}
__device__ __forceinline__ void store_row_fp8(unsigned char* orow, const f32x4 (&v)[8], int lane) {
#pragma unroll
    for (int j = 0; j < 8; ++j) *(unsigned*)(orow + 4 * lane + 256 * j) = pk_fp8x4(v[j].x, v[j].y, v[j].z, v[j].w);
}
__device__ __forceinline__ void store_row_f32(float* orow, const f32x4 (&v)[8], int lane) {
#pragma unroll
    for (int j = 0; j < 8; ++j) *(f32x4*)(orow + 4 * lane + 256 * j) = v[j];
}
__device__ __forceinline__ void load_row_f32(const float* row, f32x4 (&v)[8], int lane) {
#pragma unroll
    for (int j = 0; j < 8; ++j) v[j] = *(const f32x4*)(row + 4 * lane + 256 * j);
}

__device__ __forceinline__ void conv_small_weights(Frame& F, int l, int it, LAS float* scr) {
    bf16* wl = (bf16*)(F.ws + WS_WSMALL + (size_t)l * WL_BYTES);
    int r = it;
    if (r < 10752) { const int kb = r / 336, nb = r % 336;
        if (nb < CW / 32) { const int t = nb >> 3;
            if (!((A8_MASK >> t) & 1u)) transpose_item(F.I(I_WIN) + (size_t)l * D * INC, INC, 64 * kb, 32 * nb, (bf16*)((char*)wl + WL_WIN), D, __builtin_popcount(~A8_MASK & ((1u << t) - 1u)) * 256 + (nb & 7) * 32, scr, F.lane);
            else { const int ct = __builtin_popcount(A8_MASK & ((1u << t) - 1u)); transpose_item8(F.I(I_WIN) + (size_t)l * D * INC, INC, 64 * kb, 32 * nb, (unsigned char*)wl + WL_WIN8, D, GW + ct * 256 + (nb & 7) * 32, W8_SCALE, scr, F.lane); } }
        else transpose_item8(F.I(I_WIN) + (size_t)l * D * INC, INC, 64 * kb, 32 * nb, (unsigned char*)wl + WL_WIN8, D, 32 * nb - CW, W8_SCALE, scr, F.lane);
        return; } r -= 10752;
    if (r < 3072) { const int pi = r / 1024, q = r % 1024, kb = q / 64, nb = q % 64;
        transpose_item(F.I(I_PPOOL + pi) + (size_t)l * 1024 * D, D, 64 * kb, 32 * nb, (bf16*)((char*)wl + WL_PROJ) + (size_t)pi * D * 1024, 1024, 32 * nb, scr, F.lane); return; } r -= 3072;
    if (r < 2048) { const int kb = r / 64, nb = r % 64; transpose_item(F.I(I_WOUT) + (size_t)l * D * D, D, 64 * kb, 32 * nb, (bf16*)((char*)wl + WL_WOUT), D, 32 * nb, scr, F.lane); return; } r -= 2048;
    if (r < 128) { const int g = r / 32, q = r % 32, kb = q / 8, nb = q % 8;
        transpose_item(F.I(I_POOLW) + ((size_t)l * 4 + g) * 65536, 256, 64 * kb, 32 * nb, (bf16*)((char*)wl + WL_POOL) + (size_t)g * 65536, 256, 32 * nb, scr, F.lane); return; } r -= 128;
    { const int which = r / 128, q0 = r % 128, blk = q0 / 32, q = q0 % 32, kb = q / 8, nb = q % 8, n0 = 32 * nb;
        const int drow0 = (blk * 2 + (n0 >> 7)) * 256 + 64 * ((n0 & 127) >> 5) + 32 * which;
        transpose_item(F.I(which ? I_WX : I_WA) + ((size_t)l * 4 + blk) * 65536, 256, 64 * kb, n0, (bf16*)((char*)wl + WL_LRU), 256, drow0, scr, F.lane); }
}
__device__ __forceinline__ void conv_expert_weights(Frame& F, int l, int it, LAS float* scr) {
    unsigned char* gu = F.ws + WS_R2 + EXPW_GU; unsigned char* wd = F.ws + WS_R2 + EXPW_WD;
    const int e = it / 1536, r = it % 1536;
    if (r < 1024) { const int which = r / 512, q = r % 512, kb = q / 16, nb = q % 16, n0 = 32 * nb;
        const int drow0 = (e * 4 + (n0 >> 7)) * 256 + which * 128 + (n0 & 127);
        transpose_item8(F.I(which ? I_EU : I_EG) + ((size_t)l * NEXP + e) * D * DE, DE, 64 * kb, n0, gu, D, drow0, W8_SCALE, scr, F.lane); }
    else { const int q = r - 1024, kb = q / 64, nb = q % 64;
        transpose_item8(F.I(I_ED) + ((size_t)l * NEXP + e) * DE * D, D, 64 * kb, 32 * nb, wd, DE, e * D + 32 * nb, W8_SCALE, scr, F.lane); }
}
__device__ __forceinline__ void p0_prologue(Frame& F) {
    LAS float* scr = (LAS float*)(F.lds + F.wave * 16384);
    const int gw = F.vcu * 8 + F.wave, NGW = F.G * 8;
    LAS float* lv = (LAS float*)(F.lds + VEC_OFF);
    { const int i4 = 4 * F.tid; *(LAS f32x4*)(lv + i4) = *(const f32x4*)(F.I(I_LNE_G) + i4); *(LAS f32x4*)(lv + 2048 + i4) = *(const f32x4*)(F.I(I_LNE_B) + i4); }
    __syncthreads();
    for (int it = gw; it < 2 * 16256; it += NGW) conv_small_weights(F, it / 16256, it % 16256, scr);
    float* H = (float*)(F.ws + WS_H); bf16* HB = (bf16*)(F.ws + WS_HB);
    for (int n = gw; n < MP; n += NGW) {
        if (n < NTOK) { const int b = n / LSEQ, t = n % LSEQ; const float* src = t < NMETA ? F.I(I_META) + (size_t)t * D : F.I(I_X) + ((size_t)b * SEQ + (t - NMETA)) * D;
            f32x4 v[8]; load_row_f32(src, v, F.lane); ln_regs_lds(v, lv, lv + 2048, F.lane);
            store_row_f32(H + (size_t)n * D, v, F.lane); store_row_bf16(HB + (size_t)n * D, v, F.lane); store_row_fp8(F.ws + WS_HB8 + (size_t)n * D, v, F.lane); }
        else { f32x4 v[8];
#pragma unroll
            for (int j = 0; j < 8; ++j) v[j] = (f32x4){0.f, 0.f, 0.f, 0.f};
            store_row_f32(H + (size_t)n * D, v, F.lane); store_row_bf16(HB + (size_t)n * D, v, F.lane); store_row_fp8(F.ws + WS_HB8 + (size_t)n * D, v, F.lane); }
    }
    { bf16* wrt = (bf16*)(F.ws + WS_WRT);
      for (int i = F.vcu * 512 + F.tid; i < 2 * 48 * 2048; i += F.G * 512) { const int l = i / (48 * 2048), c = (i / 2048) % 48, k = i % 2048;
          const float w = c < 4 ? F.I(I_RGW)[((size_t)l * D + k) * 4 + c] : c < 36 ? F.I(I_REW)[((size_t)l * D + k) * 32 + (c - 4)] : 0.f;
          const unsigned hi = pk_bf16(w, 0.f) & 0xffffu; const float rem = w - __uint_as_float(hi << 16);
          wrt[((size_t)(l * 2 + 0) * 48 + c) * 2048 + k] = (bf16)hi; wrt[((size_t)(l * 2 + 1) * 48 + c) * 2048 + k] = (bf16)(pk_bf16(rem, 0.f) & 0xffffu); } }
    { bf16* wsc = (bf16*)(F.ws + WS_WSC);
      for (int i = F.vcu * 512 + F.tid; i < 2 * 4 * 65536; i += F.G * 512) { const int e = i & 255, lg = i >> 16;
          wsc[i] = (bf16)(pk_bf16(F.I(I_POOLW)[i] * F.I(I_POOLS)[(size_t)lg * 256 + e], 0.f) & 0xffffu); } }
    float* sp8 = (float*)(F.ws + WS_SP8);
    for (int i = F.vcu * 512 + F.tid; i < 2 * 1024; i += F.G * 512) { const float lam = F.I(I_LAM)[i]; sp8[i] = 8.0f * log1pf(expf(-lam)); }
}

using pg8::Unit;
__device__ __forceinline__ int xcd_order(int i, int G, int c, int NT) { if (G % (8 * NT)) return i * G + c; const int P = G / (8 * NT), x = c & 7, s = c >> 3; return i * G + (x * P + s / NT) * NT + (s % NT); }
constexpr int A8_NCT = __builtin_popcount(A8_MASK), A8_NN = 24 + A8_NCT, ABF_NN = 18 - A8_NCT;
constexpr int A_H = (NPANEL * ABF_NN) % 256, A_LIGHT = 256 - A_H, A_NF = NPANEL * A8_NN, A_X = (A_NF + 2 * A_H + 255) / 256;
__device__ __forceinline__ int nth_bit(unsigned m, int n) { for (int i = 0; i < n; ++i) m &= m - 1; return __builtin_ctz(m); }
template <bool GATE> struct PolA_ {
    static constexpr bool PERM = true, GATHER = false, ADJ = true; static constexpr int ESZ = GATE ? 1 : 2, NN = GATE ? A8_NN : ABF_NN;
    int K, lda, ldb; const unsigned char* A; const unsigned char* Bt; bf16* out; bf16* outc; int G, c;
    __device__ __forceinline__ bool next(int i, Unit& u) const { int L;
        if (GATE && G == 256) {
            if (i < A_X - 2) L = i * 256 + c; else if (i < A_X) { if (c >= A_LIGHT) return false; L = (A_X - 2) * 256 + (i - (A_X - 2)) * A_LIGHT + c; if (L >= A_NF) return false; } else return false;
        } else { L = i * G + c; if (L >= NPANEL * NN) return false; }
        const int nwg = NPANEL * NN, q = nwg / 8, r = nwg % 8, xcd = L % 8, off = L / 8; const int w = (xcd < r ? xcd * (q + 1) : r * (q + 1) + (xcd - r) * q) + off;
        const int nig = 8 * NN, gid = w / nig, fm = gid * 8, gsz = (NPANEL - fm) < 8 ? (NPANEL - fm) : 8;
        u.pm = fm + ((w % nig) % gsz); u.pn = (w % nig) / gsz; u.z = 0; return true; }
    __device__ __forceinline__ const char* a_ptr(const Unit& u) const { return (const char*)(A + (size_t)u.pm * 256 * lda * ESZ); }
    __device__ __forceinline__ const char* b_ptr(const Unit& u) const { return (const char*)(Bt + (size_t)u.pn * 256 * ldb * ESZ); }
    __device__ __forceinline__ int a_row(const Unit&, int) const { return 0; }
    template <bool T1> __device__ __forceinline__ bool epi(f32x4 (&acc)[2][2][4][2], const Unit& u, int wr, int wc, int fr, int fq) const {
        const int row0 = u.pm * 256 + wr * 64 + fr;
        if constexpr (!GATE) {
            const int tile = nth_bit(~A8_MASK & 0x3FFFFu, u.pn); const float sc = (tile >= 4 && tile < 8) ? 0.125f : 1.0f;
            bf16* base = out + (size_t)row0 * CW + tile * 256 + wc * 64 + 8 * fq;
#pragma unroll
            for (int ai = 0; ai < 2; ++ai)
#pragma unroll
                for (int m = 0; m < 4; ++m)
#pragma unroll
                    for (int bj = 0; bj < 2; ++bj) { const f32x4 v0 = acc[ai][bj][m][0] * sc, v1 = acc[ai][bj][m][1] * sc;
                        u32x4 w; w.x = pk_bf16(v0[0], v0[1]); w.y = pk_bf16(v0[2], v0[3]); w.z = pk_bf16(v1[0], v1[1]); w.w = pk_bf16(v1[2], v1[3]);
                        *(u32x4*)(base + (size_t)(ai * 128 + m * 16) * CW + bj * 32) = w; }
        } else if (u.pn < 24) {
            unsigned char* base = (unsigned char*)out + (size_t)row0 * GW + u.pn * 256 + wc * 64 + 8 * fq;
#pragma unroll
            for (int ai = 0; ai < 2; ++ai)
#pragma unroll
                for (int m = 0; m < 4; ++m)
#pragma unroll
                    for (int bj = 0; bj < 2; ++bj) { const f32x4 a0 = acc[ai][bj][m][0] * (1.0f / W8_SCALE), a1 = acc[ai][bj][m][1] * (1.0f / W8_SCALE);
                        u32x2 w; w.x = pk_gate4(sigmoidf_(a0[0]), sigmoidf_(a0[1]), sigmoidf_(a0[2]), sigmoidf_(a0[3])); w.y = pk_gate4(sigmoidf_(a1[0]), sigmoidf_(a1[1]), sigmoidf_(a1[2]), sigmoidf_(a1[3]));
                        *(u32x2*)(base + (size_t)(ai * 128 + m * 16) * GW + bj * 32) = w; }
        } else {
            const int tile = nth_bit(A8_MASK, u.pn - 24); const float sc = ((tile >= 4 && tile < 8) ? 0.125f : 1.0f) * (1.0f / W8_SCALE);
            bf16* base = outc + (size_t)row0 * CW + tile * 256 + wc * 64 + 8 * fq;
#pragma unroll
            for (int ai = 0; ai < 2; ++ai)
#pragma unroll
                for (int m = 0; m < 4; ++m)
#pragma unroll
                    for (int bj = 0; bj < 2; ++bj) { const f32x4 v0 = acc[ai][bj][m][0] * sc, v1 = acc[ai][bj][m][1] * sc;
                        u32x4 w; w.x = pk_bf16(v0[0], v0[1]); w.y = pk_bf16(v0[2], v0[3]); w.z = pk_bf16(v1[0], v1[1]); w.w = pk_bf16(v1[2], v1[3]);
                        *(u32x4*)(base + (size_t)(ai * 128 + m * 16) * CW + bj * 32) = w; }
        }
        return true;
    }
};
__device__ __forceinline__ void unpack8(const u32x4 v, float (&f)[8]);
struct PolW {
    static constexpr bool PERM = true, GATHER = false, ADJ = true; static constexpr int ESZ = 2;
    int K, lda, ldb; const bf16* pt; const bf16* wsc; bf16* wct; int G, c;
    __device__ __forceinline__ bool next(int i, Unit& u) const { const int L = i * G + c; if (L >= 32) return false; u.pm = L >> 2; u.pn = L & 3; u.z = 0; return true; }
    __device__ __forceinline__ const char* a_ptr(const Unit& u) const { return (const char*)(pt + (size_t)u.pm * 256 * 1024 + u.pn * 256); }
    __device__ __forceinline__ const char* b_ptr(const Unit& u) const { return (const char*)(wsc + (size_t)u.pn * 65536); }
    __device__ __forceinline__ int a_row(const Unit&, int) const { return 0; }
    template <bool T1> __device__ __forceinline__ bool epi(f32x4 (&acc)[2][2][4][2], const Unit& u, int wr, int wc, int fr, int fq) const {
        bf16* base = wct + (size_t)(u.pm * 256 + wr * 64 + fr) * 1024 + u.pn * 256 + wc * 64 + 8 * fq;
#pragma unroll
        for (int ai = 0; ai < 2; ++ai)
#pragma unroll
            for (int m = 0; m < 4; ++m)
#pragma unroll
                for (int bj = 0; bj < 2; ++bj) { const f32x4 v0 = acc[ai][bj][m][0], v1 = acc[ai][bj][m][1];
                    u32x4 w; w.x = pk_bf16(v0[0], v0[1]); w.y = pk_bf16(v0[2], v0[3]); w.z = pk_bf16(v1[0], v1[1]); w.w = pk_bf16(v1[2], v1[3]);
                    *(u32x4*)(base + (size_t)(ai * 128 + m * 16) * 1024 + bj * 32) = w; }
        return true;
    }
};
struct PolC {
    static constexpr bool PERM = true, GATHER = false, ADJ = true; static constexpr int ESZ = 2;
    int K, lda, ldb; const bf16* delta; const bf16* xc; const bf16* pool_t; const bf16* lru_t; bf16* mix; bf16* Abuf; bf16* Bbuf;
    const float* pool_scale; const float* ba; const float* bx; const float* sp8; int G, c;
    __device__ __forceinline__ bool next(int i, Unit& u) const { const int L = i * G + c; if (L >= 64 * 8) return false; u.pm = L >> 3; u.pn = 4 + (L & 7); u.z = 0; return true; }
    __device__ __forceinline__ const char* a_ptr(const Unit& u) const { return u.pn < 4 ? (const char*)(delta + (size_t)u.pm * 256 * 1024 + u.pn * 256) : (const char*)(xc + (size_t)u.pm * 256 * 1024 + ((u.pn - 4) >> 1) * 256); }
    __device__ __forceinline__ const char* b_ptr(const Unit& u) const { return u.pn < 4 ? (const char*)(pool_t + (size_t)u.pn * 65536) : (const char*)(lru_t + (size_t)(u.pn - 4) * 65536); }
    __device__ __forceinline__ int a_row(const Unit&, int) const { return 0; }
    __device__ __forceinline__ int rows(const Unit& u) const { return NTOK - u.pm * 256; }
    template <bool T1> __device__ __forceinline__ bool epi(f32x4 (&acc)[2][2][4][2], const Unit& u, int wr, int wc, int fr, int fq) const {
        const int row0 = u.pm * 256 + wr * 64 + fr;
        if (u.pn < 4) {
#pragma unroll
            for (int bj = 0; bj < 2; ++bj) { const int col = u.pn * 256 + wc * 64 + bj * 32 + 8 * fq; const f32x4 p0 = *(const f32x4*)(pool_scale + col), p1 = *(const f32x4*)(pool_scale + col + 4);
#pragma unroll
                for (int ai = 0; ai < 2; ++ai)
#pragma unroll
                    for (int m = 0; m < 4; ++m) { const f32x4 v0 = acc[ai][bj][m][0] * p0, v1 = acc[ai][bj][m][1] * p1; u32x4 w; w.x = pk_bf16(v0[0], v0[1]); w.y = pk_bf16(v0[2], v0[3]); w.z = pk_bf16(v1[0], v1[1]); w.w = pk_bf16(v1[2], v1[3]);
                        *(u32x4*)(mix + (size_t)(row0 + ai * 128 + m * 16) * 3072 + col) = w; } }
        } else {
            const int q = u.pn - 4, ch = (q >> 1) * 256 + (q & 1) * 128 + wc * 32 + 8 * fq;
            float vba[8], vbx[8], vsp[8];
            { const f32x4 t0 = *(const f32x4*)(ba + ch), t1 = *(const f32x4*)(ba + ch + 4), t2 = *(const f32x4*)(bx + ch), t3 = *(const f32x4*)(bx + ch + 4), t4 = *(const f32x4*)(sp8 + ch), t5 = *(const f32x4*)(sp8 + ch + 4);
#pragma unroll
              for (int j = 0; j < 4; ++j) { vba[j] = t0[j]; vba[4 + j] = t1[j]; vbx[j] = t2[j]; vbx[4 + j] = t3[j]; vsp[j] = t4[j]; vsp[4 + j] = t5[j]; } }
#pragma unroll
            for (int ai = 0; ai < 2; ++ai) { u32x4 xw[4];
#pragma unroll
                for (int m = 0; m < 4; ++m) xw[m] = *(const u32x4*)(xc + (size_t)(row0 + ai * 128 + m * 16) * 1024 + ch);
#pragma unroll
                for (int m = 0; m < 4; ++m) { const int row = row0 + ai * 128 + m * 16; float xv[8]; unpack8(xw[m], xv);
                    const bool t0 = (row % LSEQ) == 0; float av[8], bv[8];
#pragma unroll
                    for (int j = 0; j < 8; ++j) { const float ga = sigmoidf_(acc[ai][0][m][j >> 2][j & 3] + vba[j]), gx = sigmoidf_(acc[ai][1][m][j >> 2][j & 3] + vbx[j]);
                        const float a = fast_exp(-vsp[j] * ga); bv[j] = sqrtf(fmaxf(1.0f - a * a, 0.f)) * gx * xv[j]; av[j] = t0 ? 1.0f : 1.0f - a; }
                    u32x4 wa, wb; wa.x = pk_bf16(av[0], av[1]); wa.y = pk_bf16(av[2], av[3]); wa.z = pk_bf16(av[4], av[5]); wa.w = pk_bf16(av[6], av[7]);
                    wb.x = pk_bf16(bv[0], bv[1]); wb.y = pk_bf16(bv[2], bv[3]); wb.z = pk_bf16(bv[4], bv[5]); wb.w = pk_bf16(bv[6], bv[7]);
                    *(u32x4*)(Abuf + (size_t)row * 1024 + ch) = wa; *(u32x4*)(Bbuf + (size_t)row * 1024 + ch) = wb; } }
        }
        return true;
    }
};
struct PolE {
    static constexpr bool PERM = true, GATHER = false, ADJ = true; static constexpr int ESZ = 2;
    int K, lda, ldb; const bf16* mix; const bf16* proj_t; const bf16* wct; const unsigned char* gates; bf16* merged; int G, c;
    int t0, t1;
    __device__ __forceinline__ bool next(int i, Unit& u) const { const int ti = t0 + xcd_order(i / 3, G, c, 8); if (ti >= t1) return false; u.pm = ti >> 3; u.pn = ti & 7; u.z = i % 3; return true; }
    __device__ __forceinline__ const char* a_ptr(const Unit& u) const { return (const char*)(mix + (size_t)u.pm * 256 * 3072 + u.z * 1024); }
    __device__ __forceinline__ const char* b_ptr(const Unit& u) const { return u.z == 0 ? (const char*)(wct + (size_t)u.pn * 256 * 1024) : (const char*)(proj_t + (size_t)u.z * D * 1024 + (size_t)u.pn * 256 * 1024); }
    __device__ __forceinline__ int a_row(const Unit&, int) const { return 0; }
    static __device__ __forceinline__ void unpack_gate(const u32x2 w, float (&f)[8]) { f[0] = (float)(w.x & 255u); f[1] = (float)((w.x >> 8) & 255u); f[2] = (float)((w.x >> 16) & 255u); f[3] = (float)(w.x >> 24);
        f[4] = (float)(w.y & 255u); f[5] = (float)((w.y >> 8) & 255u); f[6] = (float)((w.y >> 16) & 255u); f[7] = (float)(w.y >> 24); }
    template <bool T1> __device__ __forceinline__ bool epi(f32x4 (&acc)[2][2][4][2], const Unit& u, int wr, int wc, int fr, int fq) const {
        const int row0 = u.pm * 256 + wr * 64 + fr, col0 = u.pn * 256 + wc * 64 + 8 * fq;
        const unsigned char* gbase = gates + (size_t)row0 * GW + u.z * D + col0; const bool fin = (u.z == 2); const int dofs = fin ? 0 : D;
        const u32x2 ones = (u32x2){0xffffffffu, 0xffffffffu};
#pragma unroll
        for (int ai = 0; ai < (T1 ? 1 : 2); ++ai)
#pragma unroll
            for (int mh = 0; mh < 2; ++mh) { u32x2 ga[2][2], gb[2][2];
#pragma unroll
                for (int mm = 0; mm < 2; ++mm)
#pragma unroll
                    for (int bj = 0; bj < 2; ++bj) { const unsigned char* gp = gbase + (size_t)(ai * 128 + (2 * mh + mm) * 16) * GW + bj * 32; ga[mm][bj] = *(const u32x2*)gp; gb[mm][bj] = *(const u32x2*)(gp + dofs); }
#pragma unroll
                for (int mm = 0; mm < 2; ++mm)
#pragma unroll
                    for (int bj = 0; bj < 2; ++bj) { const int m = 2 * mh + mm; float f[8], h[8]; unpack_gate(ga[mm][bj], f); const u32x2 gsel = fin ? ones : gb[mm][bj]; unpack_gate(gsel, h);
#pragma unroll
                        for (int j = 0; j < 8; ++j) f[j] = fmaxf(f[j], 1e-20f) * __builtin_amdgcn_rcpf(fmaxf(h[j], 1e-20f));
                        f32x4 v0 = acc[ai][bj][m][0], v1 = acc[ai][bj][m][1];
                        v0[0] *= f[0]; v0[1] *= f[1]; v0[2] *= f[2]; v0[3] *= f[3]; v1[0] *= f[4]; v1[1] *= f[5]; v1[2] *= f[6]; v1[3] *= f[7];
                        acc[ai][bj][m][0] = v0; acc[ai][bj][m][1] = v1; }
                if (fin) {
#pragma unroll
                    for (int mm = 0; mm < 2; ++mm)
#pragma unroll
                        for (int bj = 0; bj < 2; ++bj) { const int m = 2 * mh + mm; const f32x4 a0 = acc[ai][bj][m][0], a1 = acc[ai][bj][m][1];
                            u32x4 w; w.x = pk_bf16(a0[0], a0[1]); w.y = pk_bf16(a0[2], a0[3]); w.z = pk_bf16(a1[0], a1[1]); w.w = pk_bf16(a1[2], a1[3]);
                            *(u32x4*)(merged + (size_t)(row0 + ai * 128 + m * 16) * D + col0 + bj * 32) = w; } }
                __builtin_amdgcn_sched_barrier(0); }
        return fin;
    }
};
struct PolF {
    static constexpr bool PERM = false, GATHER = false; static constexpr int ESZ = 2;
    int K, lda, ldb; const bf16* A; const bf16* Bt; float* H; float* stats; int G, c;
    int t0, t1;
    __device__ __forceinline__ bool next(int i, Unit& u) const { const int ti = t0 + xcd_order(i, G, c, 8); if (ti >= t1) return false; u.pm = ti >> 3; u.pn = ti & 7; u.z = 0; return true; }
    __device__ __forceinline__ const char* a_ptr(const Unit& u) const { return (const char*)(A + (size_t)u.pm * 256 * lda); }
    __device__ __forceinline__ const char* b_ptr(const Unit& u) const { return (const char*)(Bt + (size_t)u.pn * 256 * ldb); }
    __device__ __forceinline__ int a_row(const Unit&, int) const { return 0; }
    template <bool T1> __device__ __forceinline__ bool epi(f32x4 (&acc)[2][2][4][2], const Unit& u, int wr, int wc, int fr, int fq) const {
        const int row0 = u.pm * 256 + wr * 64 + fr, col0 = u.pn * 256 + wc * 32 + 4 * fq;
#pragma unroll
        for (int ai = 0; ai < (T1 ? 1 : 2); ++ai)
#pragma unroll
            for (int m = 0; m < 4; ++m) { const int row = row0 + ai * 128 + m * 16; float* rp = H + (size_t)row * D + col0; float s = 0.f, q = 0.f;
#pragma unroll
                for (int bj = 0; bj < 2; ++bj)
#pragma unroll
                    for (int n = 0; n < 2; ++n) { const f32x4 h = *(const f32x4*)(rp + bj * 128 + n * 16); const f32x4 y = h * ALPHA + acc[ai][bj][m][n]; *(f32x4*)(rp + bj * 128 + n * 16) = y;
                        s += (y[0] + y[1]) + (y[2] + y[3]); q += (y[0] * y[0] + y[1] * y[1]) + (y[2] * y[2] + y[3] * y[3]); }
                s += __shfl_xor(s, 16); s += __shfl_xor(s, 32); q += __shfl_xor(q, 16); q += __shfl_xor(q, 32);
                if (fq == 0) *(f32x2*)(stats + (size_t)row * 64 + (u.pn * 4 + wc) * 2) = (f32x2){s, q}; }
        return true;
    }
};
struct MoeTbl { const LAS int* t; __device__ __forceinline__ int ct(int e) const { return __builtin_amdgcn_readfirstlane(t[e]); } __device__ __forceinline__ int cnt(int e) const { return __builtin_amdgcn_readfirstlane(t[40 + e]); } };
__device__ __forceinline__ int moe_find(const MoeTbl& T, int mt) { int e = 0;
#pragma unroll 1
    while (e < 31 && T.ct(e + 1) <= mt) ++e;
    return e; }
struct PolI {
    static constexpr bool PERM = true, GATHER = true; static constexpr int ESZ = 1;
    int K, lda, ldb; const unsigned char* X; const unsigned char* gu; const int* elist; unsigned char* hdn; MoeTbl T; int G, c;
    __device__ __forceinline__ bool next(int i, Unit& u) const { const int L = xcd_order(i, G, c, 4), tot = T.ct(32); if (L >= tot * 4) return false; u.pm = L >> 2; u.pn = L & 3; u.z = moe_find(T, u.pm); return true; }
    __device__ __forceinline__ const char* a_ptr(const Unit&) const { return (const char*)X; }
    __device__ __forceinline__ const char* b_ptr(const Unit& u) const { return (const char*)(gu + (size_t)(u.z * 4 + u.pn) * 256 * D); }
    __device__ __forceinline__ int a_row(const Unit& u, int r) const { const int j = (u.pm - T.ct(u.z)) * 256 + r; return j < T.cnt(u.z) ? elist[(size_t)u.z * NTOK + j] : 0; }
    template <bool T1> __device__ __forceinline__ bool epi(f32x4 (&acc)[2][2][4][2], const Unit& u, int wr, int wc, int fr, int fq) const {
        const int row0 = u.pm * 256 + wr * 64 + fr, col0 = u.pn * 128 + wc * 32 + 8 * fq;
#pragma unroll
        for (int ai = 0; ai < 2; ++ai)
#pragma unroll
            for (int m = 0; m < 4; ++m) { float o[8];
#pragma unroll
                for (int n = 0; n < 2; ++n)
#pragma unroll
                    for (int j = 0; j < 4; ++j) { const float g = acc[ai][0][m][n][j] * (1.0f / W8_SCALE), up = acc[ai][1][m][n][j] * (HDN_SCALE / W8_SCALE); o[4 * n + j] = fminf(fmaxf(g * sigmoidf_(g) * up, -440.f), 440.f); }
                u32x2 w; w.x = pk_fp8x4(o[0], o[1], o[2], o[3]); w.y = pk_fp8x4(o[4], o[5], o[6], o[7]);
                *(u32x2*)(hdn + (size_t)(row0 + ai * 128 + m * 16) * DE + col0) = w; }
        return true;
    }
};
struct PolJ {
    static constexpr bool PERM = true, GATHER = false, ADJ = true; static constexpr int ESZ = 1;
    int K, lda, ldb; const unsigned char* hdn; const unsigned char* wd; unsigned char* yd; MoeTbl T; int G, c;
    __device__ __forceinline__ bool next(int i, Unit& u) const { const int L = xcd_order(i, G, c, 8), tot = T.ct(32); if (L >= tot * 8) return false; u.pm = L >> 3; u.pn = L & 7; u.z = moe_find(T, u.pm); return true; }
    __device__ __forceinline__ const char* a_ptr(const Unit& u) const { return (const char*)(hdn + (size_t)u.pm * 256 * DE); }
    __device__ __forceinline__ const char* b_ptr(const Unit& u) const { return (const char*)(wd + ((size_t)u.z * D + (size_t)u.pn * 256) * DE); }
    __device__ __forceinline__ int a_row(const Unit&, int) const { return 0; }
    template <bool T1> __device__ __forceinline__ bool epi(f32x4 (&acc)[2][2][4][2], const Unit& u, int wr, int wc, int fr, int fq) const {
        const int row0 = u.pm * 256 + wr * 64 + fr, col0 = u.pn * 256 + wc * 64 + 8 * fq;
#pragma unroll
        for (int ai = 0; ai < 2; ++ai)
#pragma unroll
            for (int m = 0; m < 4; ++m)
#pragma unroll
                for (int bj = 0; bj < 2; ++bj) { const f32x4 v0 = acc[ai][bj][m][0] * (YD_SCALE / (W8_SCALE * HDN_SCALE)), v1 = acc[ai][bj][m][1] * (YD_SCALE / (W8_SCALE * HDN_SCALE));
#define YCL(x) __builtin_amdgcn_fmed3f((x), -448.0f, 448.0f)
                    u32x2 w; w.x = pk_fp8x4(YCL(v0[0]), YCL(v0[1]), YCL(v0[2]), YCL(v0[3])); w.y = pk_fp8x4(YCL(v1[0]), YCL(v1[1]), YCL(v1[2]), YCL(v1[3]));
#undef YCL
                    *(u32x2*)(yd + (size_t)(row0 + ai * 128 + m * 16) * D + col0 + bj * 32) = w; }
        return true;
    }
};

template <int NCB> __device__ __forceinline__ void skinny_mma(f32x4 (&acc)[4][NCB], const bf16* A, int lda, const bf16* Bt, int ldb, int k0, int k1, int lane) {
    const int fr = lane & 15, fq = lane >> 4;
#pragma unroll 2
    for (int k = k0; k < k1; k += 32) { bf16x8 a[4], b[NCB];
#pragma unroll
        for (int rb = 0; rb < 4; ++rb) a[rb] = *(const bf16x8*)(A + (size_t)(16 * rb + fr) * lda + k + 8 * fq);
#pragma unroll
        for (int cb = 0; cb < NCB; ++cb) b[cb] = *(const bf16x8*)(Bt + (size_t)(16 * cb + fr) * ldb + k + 8 * fq);
#pragma unroll
        for (int rb = 0; rb < 4; ++rb)
#pragma unroll
            for (int cb = 0; cb < NCB; ++cb) acc[rb][cb] = __builtin_amdgcn_mfma_f32_16x16x32_bf16(b[cb], a[rb], acc[rb][cb], 0, 0, 0); }
}
__device__ __forceinline__ void tail_merge(Frame& F, int l) {
    if (F.vcu >= 128) return;
    const bf16* mix = (const bf16*)(F.ws + WS_R3) + (size_t)16384 * 3072; const bf16* proj_t = (const bf16*)(F.ws + WS_WSMALL + (size_t)l * WL_BYTES + WL_PROJ); const bf16* wct = (const bf16*)(F.ws + WS_WCT) + (size_t)l * D * 1024;
    const unsigned char* gates = F.ws + WS_R1 + (size_t)16384 * GW; bf16* merged = (bf16*)(F.ws + WS_R45) + (size_t)16384 * D;
    const int c0 = F.vcu * 16, lane = F.lane, wave = F.wave, fr = lane & 15, fq = lane >> 4;
    LAS float* part = (LAS float*)F.lds;
#pragma unroll
    for (int seg = 0; seg < 3; ++seg) { f32x4 acc[4][1];
#pragma unroll
        for (int rb = 0; rb < 4; ++rb) acc[rb][0] = (f32x4){0.f, 0.f, 0.f, 0.f};
        skinny_mma<1>(acc, mix + seg * 1024, 3072, (seg == 0 ? wct : proj_t + (size_t)seg * D * 1024) + (size_t)c0 * 1024, 1024, wave * 128, wave * 128 + 128, lane);
#pragma unroll
        for (int rb = 0; rb < 4; ++rb) *(LAS f32x4*)(part + ((wave * 3 + seg) * 64 + 16 * rb + fr) * 16 + 4 * fq) = acc[rb][0]; }
    __syncthreads();
#pragma unroll
    for (int e2 = 0; e2 < 2; ++e2) { const int e = F.tid + 512 * e2, row = e >> 4, col = e & 15; float m = 0.f;
#pragma unroll
        for (int seg = 0; seg < 3; ++seg) { float s = 0.f;
#pragma unroll
            for (int w = 0; w < 8; ++w) s += part[((w * 3 + seg) * 64 + row) * 16 + col];
            m += (float)gates[(size_t)row * GW + seg * D + c0 + col] * (1.0f / 255.0f) * s; }
        merged[(size_t)row * D + c0 + col] = (bf16)(pk_bf16(m, 0.f) & 0xffffu); }
    __syncthreads();
}
__device__ __forceinline__ void tail_lru(Frame& F, int l) {
    if (F.vcu >= 64) return;
    const bf16* xc = (const bf16*)(F.ws + WS_R45) + (size_t)MP * 1024 + (size_t)16384 * 1024; const bf16* lru_t = (const bf16*)(F.ws + WS_WSMALL + (size_t)l * WL_BYTES + WL_LRU);
    bf16* Abuf = (bf16*)(F.ws + WS_R6) + (size_t)16384 * 1024; bf16* Bbuf = (bf16*)(F.ws + WS_R6) + (size_t)MP * 1024 + (size_t)16384 * 1024;
    const float* ba = F.I(I_BA) + (size_t)l * 1024; const float* bx = F.I(I_BX) + (size_t)l * 1024; const float* sp8 = (const float*)(F.ws + WS_SP8) + (size_t)l * 1024;
    const int ch0 = F.vcu * 16, blk = ch0 >> 8, cib = ch0 & 255, lane = F.lane, wave = F.wave, fr = lane & 15, fq = lane >> 4;
    const bf16* wrow = lru_t + (size_t)((blk * 2 + (cib >> 7)) * 256 + 64 * ((cib & 127) >> 5) + (cib & 31)) * 256;
    LAS float* part = (LAS float*)F.lds;
    { f32x4 acc[4][2];
#pragma unroll
      for (int rb = 0; rb < 4; ++rb) { acc[rb][0] = (f32x4){0.f, 0.f, 0.f, 0.f}; acc[rb][1] = acc[rb][0]; }
      const int k = wave * 32 + 8 * fq; bf16x8 a[4], b[2];
#pragma unroll
      for (int rb = 0; rb < 4; ++rb) a[rb] = *(const bf16x8*)(xc + (size_t)(16 * rb + fr) * 1024 + blk * 256 + k);
      b[0] = *(const bf16x8*)(wrow + (size_t)fr * 256 + k); b[1] = *(const bf16x8*)(wrow + (size_t)(32 + fr) * 256 + k);
#pragma unroll
      for (int rb = 0; rb < 4; ++rb)
#pragma unroll
          for (int cb = 0; cb < 2; ++cb) acc[rb][cb] = __builtin_amdgcn_mfma_f32_16x16x32_bf16(b[cb], a[rb], acc[rb][cb], 0, 0, 0);
#pragma unroll
      for (int rb = 0; rb < 4; ++rb)
#pragma unroll
          for (int cb = 0; cb < 2; ++cb) *(LAS f32x4*)(part + (wave * 64 + 16 * rb + fr) * 32 + 16 * cb + 4 * fq) = acc[rb][cb]; }
    __syncthreads();
#pragma unroll
    for (int e2 = 0; e2 < 2; ++e2) { const int e = F.tid + 512 * e2, row = e >> 4, cc = e & 15, ch = ch0 + cc; float ga = 0.f, gx = 0.f;
#pragma unroll
        for (int w = 0; w < 8; ++w) { ga += part[(w * 64 + row) * 32 + cc]; gx += part[(w * 64 + row) * 32 + 16 + cc]; }
        const float sa = sigmoidf_(ga + ba[ch]), sx = sigmoidf_(gx + bx[ch]), a = fast_exp(-sp8[ch] * sa), xv = bf2f(xc[(size_t)row * 1024 + ch]);
        const bool t0 = ((16384 + row) % LSEQ) == 0;
        Abuf[(size_t)row * 1024 + ch] = (bf16)(pk_bf16(t0 ? 1.0f : 1.0f - a, 0.f) & 0xffffu); Bbuf[(size_t)row * 1024 + ch] = (bf16)(pk_bf16(sqrtf(fmaxf(1.0f - a * a, 0.f)) * sx * xv, 0.f) & 0xffffu); }
    __syncthreads();
}
__device__ __forceinline__ void tail_wout(Frame& F, int l) {
    if (F.vcu >= 32) return;
    const bf16* merged = (const bf16*)(F.ws + WS_R45) + (size_t)16384 * D; const bf16* wo = (const bf16*)(F.ws + WS_WSMALL + (size_t)l * WL_BYTES + WL_WOUT);
    float* H = (float*)(F.ws + WS_H) + (size_t)16384 * D; float* stats = (float*)(F.ws + WS_STATS) + (size_t)16384 * 64;
    const int c0 = F.vcu * 64, lane = F.lane, wave = F.wave, fr = lane & 15, fq = lane >> 4;
    LAS float* part = (LAS float*)F.lds;
    { f32x4 acc[4][4];
#pragma unroll
      for (int rb = 0; rb < 4; ++rb)
#pragma unroll
          for (int cb = 0; cb < 4; ++cb) acc[rb][cb] = (f32x4){0.f, 0.f, 0.f, 0.f};
      skinny_mma<4>(acc, merged, D, wo + (size_t)c0 * D, D, wave * 256, wave * 256 + 256, lane);
#pragma unroll
      for (int rb = 0; rb < 4; ++rb)
#pragma unroll
          for (int cb = 0; cb < 4; ++cb) *(LAS f32x4*)(part + (wave * 64 + 16 * rb + fr) * 64 + 16 * cb + 4 * fq) = acc[rb][cb]; }
    __syncthreads();
    { const int row = F.tid >> 3, cs = (F.tid & 7) * 8; float s = 0.f, q = 0.f;
#pragma unroll
      for (int h4 = 0; h4 < 2; ++h4) { f32x4 a = (f32x4){0.f, 0.f, 0.f, 0.f};
#pragma unroll
          for (int w = 0; w < 8; ++w) a += *(const LAS f32x4*)(part + (w * 64 + row) * 64 + cs + 4 * h4);
          float* hp = H + (size_t)row * D + c0 + cs + 4 * h4; const f32x4 y = *(const f32x4*)hp * ALPHA + a; *(f32x4*)hp = y;
          s += (y[0] + y[1]) + (y[2] + y[3]); q += (y[0] * y[0] + y[1] * y[1]) + (y[2] * y[2] + y[3] * y[3]); }
      s += __shfl_xor(s, 1); s += __shfl_xor(s, 2); s += __shfl_xor(s, 4); q += __shfl_xor(q, 1); q += __shfl_xor(q, 2); q += __shfl_xor(q, 4);
      if ((F.tid & 7) == 0) *(f32x2*)(stats + (size_t)row * 64 + F.vcu * 2) = (f32x2){s, q}; }
    __syncthreads();
}

__device__ __forceinline__ void unpack8(const u32x4 v, float (&f)[8]) { f[0] = bflo(v.x); f[1] = bfhi(v.x); f[2] = bflo(v.y); f[3] = bfhi(v.y); f[4] = bflo(v.z); f[5] = bfhi(v.z); f[6] = bflo(v.w); f[7] = bfhi(v.w); }
template <int W> __device__ __forceinline__ void delta_conv_item(const bf16* cols, bf16* delta, bf16* xc, const float* cw, const float* cb, int n0, int t0, int c8) {
    u32x4 R[W + 7], X[11];
#pragma unroll
    for (int j = 0; j < W + 7; ++j) { const int dt = j - (W - 1); R[j] = (t0 + dt >= 0) ? *(const u32x4*)(cols + (size_t)(n0 + dt) * CW + C_POOL + c8) : (u32x4){0u, 0u, 0u, 0u}; }
#pragma unroll
    for (int j = 0; j < 11; ++j) { const int dt = j - 3; X[j] = (t0 + dt >= 0) ? *(const u32x4*)(cols + (size_t)(n0 + dt) * CW + C_LX + c8) : (u32x4){0u, 0u, 0u, 0u}; }
    float s[8];
#pragma unroll
    for (int q = 0; q < 8; ++q) s[q] = 0.f;
#pragma unroll
    for (int j = 0; j < W - 1; ++j) { float f[8]; unpack8(R[j], f);
#pragma unroll
        for (int q = 0; q < 8; ++q) s[q] += f[q]; }
#pragma unroll
    for (int i = 0; i < 8; ++i) { float fn[8]; unpack8(R[i + W - 1], fn);
#pragma unroll
        for (int q = 0; q < 8; ++q) s[q] += fn[q];
        const int t = t0 + i; const float inv = 1.0f / (float)((t + 1) < W ? (t + 1) : W); u32x4 o;
        o.x = pk_bf16(s[0] * inv - fn[0], s[1] * inv - fn[1]); o.y = pk_bf16(s[2] * inv - fn[2], s[3] * inv - fn[3]); o.z = pk_bf16(s[4] * inv - fn[4], s[5] * inv - fn[5]); o.w = pk_bf16(s[6] * inv - fn[6], s[7] * inv - fn[7]);
        *(u32x4*)(delta + (size_t)(n0 + i) * 3072 + c8) = o;
        float fo[8]; unpack8(R[i], fo);
#pragma unroll
        for (int q = 0; q < 8; ++q) s[q] -= fo[q]; }
    float w0[8], w1[8], w2[8], w3[8], bb[8];
#pragma unroll
    for (int q = 0; q < 8; ++q) { w0[q] = cw[c8 + q]; w1[q] = cw[1024 + c8 + q]; w2[q] = cw[2048 + c8 + q]; w3[q] = cw[3072 + c8 + q]; bb[q] = cb[c8 + q]; }
#pragma unroll
    for (int i = 0; i < 8; ++i) { float a[8], b[8], c[8], d[8]; unpack8(X[i], a); unpack8(X[i + 1], b); unpack8(X[i + 2], c); unpack8(X[i + 3], d); float r[8];
#pragma unroll
        for (int q = 0; q < 8; ++q) r[q] = bb[q] + a[q] * w0[q] + b[q] * w1[q] + c[q] * w2[q] + d[q] * w3[q];
        u32x4 o; o.x = pk_bf16(r[0], r[1]); o.y = pk_bf16(r[2], r[3]); o.z = pk_bf16(r[4], r[5]); o.w = pk_bf16(r[6], r[7]);
        *(u32x4*)(xc + (size_t)(n0 + i) * 1024 + c8) = o; }
}
__device__ __forceinline__ void phase_delta_conv(Frame& F, int l) {
    const bf16* cols = (const bf16*)(F.ws + WS_R2); bf16* delta = (bf16*)(F.ws + WS_R3); bf16* xc = (bf16*)(F.ws + WS_R45) + (size_t)MP * 1024;
    const float* cw = F.I(I_CONVW) + (size_t)l * 4 * 1024; const float* cb = F.I(I_CONVB) + (size_t)l * 1024;
    const int gw = F.vcu * 8 + F.wave, NGW = F.G * 8, lane = F.lane;
    const int total = (NTOK / 16) * 4, full = total / NGW;
    for (int k = 0; k <= full; ++k) { const int it = k * NGW + (k == full ? NGW - 1 - gw : gw); if (it >= total) break;
        const int g = it & 3, tp = it >> 2, n0 = (tp * 2 + (lane >> 5)) * 8, t0 = n0 % LSEQ, c8 = g * 256 + (lane & 31) * 8;
        if (g == 0) delta_conv_item<2>(cols, delta, xc, cw, cb, n0, t0, c8);
        else if (g == 1) delta_conv_item<4>(cols, delta, xc, cw, cb, n0, t0, c8);
        else if (g == 2) delta_conv_item<8>(cols, delta, xc, cw, cb, n0, t0, c8);
        else delta_conv_item<16>(cols, delta, xc, cw, cb, n0, t0, c8);
    }
}
typedef float f32x16 __attribute__((ext_vector_type(16)));
__device__ __forceinline__ void phase_attn(Frame& F, int l) {
    const bf16* cols = (const bf16*)(F.ws + WS_R2); bf16* mix = (bf16*)(F.ws + WS_R3);
    constexpr int KS_BYTES = 27648, BUF_BYTES = 27648 + 25088;
    const int tid = F.tid, lane = F.lane, wave = F.wave, r = lane & 31, h = lane >> 5, g = wave >> 1, qh = wave & 1;
    const int NU = NB * 4 * 65;
    u32x4 kreg[3], vreg[3];
#define ATT_FETCH(u_) do { const int qb_ = (u_) % 65, bk_ = (u_) / 65, kvh_ = bk_ & 3, b_ = bk_ >> 2, t0_ = qb_ * 64; const size_t nb_ = (size_t)b_ * LSEQ; \
        _Pragma("unroll") for (int i = 0; i < 3; ++i) { const int c = tid + 512 * i, key = c >> 3, dc = c & 7; int tc = t0_ - 128 + key; tc = tc < 0 ? 0 : (tc > LSEQ - 1 ? LSEQ - 1 : tc); \
            const bf16* src = cols + (nb_ + tc) * CW + kvh_ * 64 + dc * 8; kreg[i] = *(const u32x4*)(src + C_K); vreg[i] = *(const u32x4*)(src + C_V); } } while (0)
    int u = F.vcu, buf = 0;
    if (u < NU) ATT_FETCH(u);
    for (; u < NU; u += F.G, buf ^= 1) {
        LAS unsigned char* Ks = F.lds + buf * BUF_BYTES; LAS unsigned char* Vt = Ks + KS_BYTES;
        const int qb = u % 65, bk = u / 65, kvh = bk & 3, b = bk >> 2, t0 = qb * 64; const size_t nb = (size_t)b * LSEQ;
#pragma unroll
        for (int i = 0; i < 3; ++i) { const int c = tid + 512 * i, key = c >> 3, dc = c & 7; const u32x4 vv = vreg[i];
            *(LAS u32x4*)(Ks + key * 144 + dc * 16) = kreg[i];
            LAS unsigned short* vp = (LAS unsigned short*)(Vt + (8 * dc) * 392 + key * 2);
            vp[0 * 196] = (unsigned short)(vv.x & 0xffffu); vp[1 * 196] = (unsigned short)(vv.x >> 16); vp[2 * 196] = (unsigned short)(vv.y & 0xffffu); vp[3 * 196] = (unsigned short)(vv.y >> 16);
            vp[4 * 196] = (unsigned short)(vv.z & 0xffffu); vp[5 * 196] = (unsigned short)(vv.z >> 16); vp[6 * 196] = (unsigned short)(vv.w & 0xffffu); vp[7 * 196] = (unsigned short)(vv.w >> 16); }
        const int head = kvh * 4 + g, tq = t0 + 32 * qh + r, tqc = tq > LSEQ - 1 ? LSEQ - 1 : tq;
        bf16x8 qf[4];
        { const bf16* qp = cols + (nb + tqc) * CW + C_Q + head * 64 + 8 * h;
#pragma unroll
          for (int ks = 0; ks < 4; ++ks) qf[ks] = *(const bf16x8*)(qp + 16 * ks); }
        if (u + F.G < NU) ATT_FETCH(u + F.G);
        const float slope2 = exp2f(-0.5f * (float)(head + 1)) * 1.44269504089f, sink2 = F.I(I_SINK)[l * 16 + head] * 1.44269504089f;
        __syncthreads();
        f32x16 st[5];
#pragma unroll
        for (int jj = 0; jj < 5; ++jj) { f32x16 a;
#pragma unroll
            for (int i = 0; i < 16; ++i) a[i] = 0.f;
#pragma unroll
            for (int ks = 0; ks < 4; ++ks) { const bf16x8 kf = *(const LAS bf16x8*)(Ks + (32 * (qh + jj) + r) * 144 + (16 * ks + 8 * h) * 2); a = __builtin_amdgcn_mfma_f32_32x32x16_bf16(kf, qf[ks], a, 0, 0, 0); }
            st[jj] = a; }
        float m = sink2;
#pragma unroll
        for (int jj = 0; jj < 5; ++jj) { const int tsb = t0 - 128 + 32 * (qh + jj) + 4 * h, db = 128 - 32 * jj + r - 4 * h; const float dl = slope2 * (float)db; const bool edge = (jj == 0) || (jj == 4) || (t0 - 128 + 32 * (qh + jj) < 0);
            if (!edge) {
#pragma unroll
                for (int i = 0; i < 16; ++i) { const float v = __builtin_fmaf(st[jj][i], 1.44269504089f, __builtin_fmaf(slope2, (float)((i & 3) + 8 * (i >> 2)), -dl)); st[jj][i] = v; m = fmaxf(m, v); }
            } else {
#pragma unroll
                for (int i = 0; i < 16; ++i) { const int cr = (i & 3) + 8 * (i >> 2), dist = db - cr; const bool ok = dist >= 0 && dist < 128 && (tsb + cr) >= 0;
                    const float v = ok ? __builtin_fmaf(st[jj][i], 1.44269504089f, __builtin_fmaf(slope2, (float)cr, -dl)) : -1e30f; st[jj][i] = v; m = fmaxf(m, v); }
            } }
        m = fmaxf(m, __shfl_xor(m, 32));
        float sum = 0.f;
#pragma unroll
        for (int jj = 0; jj < 5; ++jj)
#pragma unroll
            for (int i = 0; i < 16; ++i) { const float pv = __builtin_amdgcn_exp2f(st[jj][i] - m); st[jj][i] = pv; sum += pv; }
        sum += __shfl_xor(sum, 32);
        const float inv = 1.0f / (sum + __builtin_amdgcn_exp2f(sink2 - m));
        f32x16 o[2];
#pragma unroll
        for (int i = 0; i < 16; ++i) { o[0][i] = 0.f; o[1][i] = 0.f; }
#pragma unroll
        for (int jj = 0; jj < 5; ++jj)
#pragma unroll
            for (int s = 0; s < 2; ++s) { u32x4 pw; pw.x = pk_bf16(st[jj][8 * s], st[jj][8 * s + 1]); pw.y = pk_bf16(st[jj][8 * s + 2], st[jj][8 * s + 3]); pw.z = pk_bf16(st[jj][8 * s + 4], st[jj][8 * s + 5]); pw.w = pk_bf16(st[jj][8 * s + 6], st[jj][8 * s + 7]);
                const bf16x8 pf = __builtin_bit_cast(bf16x8, pw);
#pragma unroll
                for (int db2 = 0; db2 < 2; ++db2) { const LAS unsigned char* vb = Vt + (32 * db2 + r) * 392 + (32 * (qh + jj) + 16 * s + 4 * h) * 2;
                    const u32x2 lo = *(const LAS u32x2*)vb, hi = *(const LAS u32x2*)(vb + 16); u32x4 vw; vw.x = lo.x; vw.y = lo.y; vw.z = hi.x; vw.w = hi.y;
                    o[db2] = __builtin_amdgcn_mfma_f32_32x32x16_bf16(__builtin_bit_cast(bf16x8, vw), pf, o[db2], 0, 0, 0); } }
        if (tq < LSEQ) { bf16* op = mix + (nb + tq) * 3072 + 1024 + head * 64 + 4 * h;
#pragma unroll
            for (int db2 = 0; db2 < 2; ++db2)
#pragma unroll
                for (int g4 = 0; g4 < 4; ++g4) { u32x2 w; w.x = pk_bf16(o[db2][4 * g4] * inv, o[db2][4 * g4 + 1] * inv); w.y = pk_bf16(o[db2][4 * g4 + 2] * inv, o[db2][4 * g4 + 3] * inv);
                    *(u32x2*)(op + 32 * db2 + 8 * g4) = w; } }
    }
#undef ATT_FETCH
    __syncthreads();
}
__device__ __forceinline__ void phase_lru_summ(Frame& F) {
    const bf16* Ab = (const bf16*)(F.ws + WS_R6); const bf16* Bb = Ab + (size_t)MP * 1024; float* summ = (float*)(F.ws + WS_SUMM);
    const int gt = ((F.tid >> 8) * F.G + F.vcu) * 256 + (F.tid & 255), NT = F.G * 512;
    for (int it = gt; it < NCHUNK * 256; it += NT) { const int ck = it >> 8, c = (it & 255) * 4, r0 = ck * 64, nr = (r0 + 64) <= NTOK ? 64 : NTOK - r0;
        f32x4 A = (f32x4){1.f, 1.f, 1.f, 1.f}, Bv = (f32x4){0.f, 0.f, 0.f, 0.f};
        const bf16* ap = Ab + (size_t)r0 * 1024 + c; const bf16* bp = Bb + (size_t)r0 * 1024 + c;
        for (int r = 0; r < nr; r += 16) { u32x2 aw[16], bw[16];
#pragma unroll
            for (int i = 0; i < 16; ++i) { aw[i] = *(const u32x2*)(ap + (size_t)(r + i) * 1024); bw[i] = *(const u32x2*)(bp + (size_t)(r + i) * 1024); }
#pragma unroll
            for (int i = 0; i < 16; ++i) { const f32x4 a = (f32x4){1.f - bflo(aw[i].x), 1.f - bfhi(aw[i].x), 1.f - bflo(aw[i].y), 1.f - bfhi(aw[i].y)}, b = (f32x4){bflo(bw[i].x), bfhi(bw[i].x), bflo(bw[i].y), bfhi(bw[i].y)};
                Bv = a * Bv + b; A = A * a; } }
        *(f32x4*)(summ + ((size_t)ck * 1024 + c) * 2) = A; *(f32x4*)(summ + ((size_t)ck * 1024 + c) * 2 + 4) = Bv; }
}
__device__ __forceinline__ void phase_lru_final(Frame& F) {
    const bf16* Ab = (const bf16*)(F.ws + WS_R6); const bf16* Bb = Ab + (size_t)MP * 1024; const float* summ = (const float*)(F.ws + WS_SUMM);
    const bf16* cols = (const bf16*)(F.ws + WS_R2); bf16* mix = (bf16*)(F.ws + WS_R3);
    const int gt = ((F.tid >> 8) * F.G + F.vcu) * 256 + (F.tid & 255), NT = F.G * 512;
    for (int it = gt; it < NCHUNK * 256; it += NT) { const int ck = it >> 8, c = (it & 255) * 4, r0 = ck * 64, nr = (r0 + 64) <= NTOK ? 64 : NTOK - r0;
        const int c0 = ((r0 / LSEQ) * LSEQ) / 64; f32x4 h = (f32x4){0.f, 0.f, 0.f, 0.f};
        int cc = c0;
        for (; cc + 16 <= ck; cc += 16) { f32x4 sa[16], sb[16];
#pragma unroll
            for (int i = 0; i < 16; ++i) { const float* sp = summ + ((size_t)(cc + i) * 1024 + c) * 2; sa[i] = *(const f32x4*)sp; sb[i] = *(const f32x4*)(sp + 4); }
#pragma unroll
            for (int i = 0; i < 16; ++i) h = sa[i] * h + sb[i]; }
        for (; cc + 4 <= ck; cc += 4) { f32x4 sa[4], sb[4];
#pragma unroll
            for (int i = 0; i < 4; ++i) { const float* sp = summ + ((size_t)(cc + i) * 1024 + c) * 2; sa[i] = *(const f32x4*)sp; sb[i] = *(const f32x4*)(sp + 4); }
#pragma unroll
            for (int i = 0; i < 4; ++i) h = sa[i] * h + sb[i]; }
        for (; cc < ck; ++cc) { const float* sp = summ + ((size_t)cc * 1024 + c) * 2; h = *(const f32x4*)sp * h + *(const f32x4*)(sp + 4); }
        const bf16* ap = Ab + (size_t)r0 * 1024 + c; const bf16* bp = Bb + (size_t)r0 * 1024 + c;
        for (int r = 0; r < nr; r += 16) { u32x2 aw[16], bw[16]; u32x2 yw[16];
#pragma unroll
            for (int i = 0; i < 16; ++i) { aw[i] = *(const u32x2*)(ap + (size_t)(r + i) * 1024); bw[i] = *(const u32x2*)(bp + (size_t)(r + i) * 1024); yw[i] = *(const u32x2*)(cols + (size_t)(r0 + r + i) * CW + C_LY + c); }
#pragma unroll
            for (int i = 0; i < 16; ++i) { const f32x4 a = (f32x4){1.f - bflo(aw[i].x), 1.f - bfhi(aw[i].x), 1.f - bflo(aw[i].y), 1.f - bfhi(aw[i].y)}, b = (f32x4){bflo(bw[i].x), bfhi(bw[i].x), bflo(bw[i].y), bfhi(bw[i].y)};
                h = a * h + b;
                const float y[4] = {bflo(yw[i].x), bfhi(yw[i].x), bflo(yw[i].y), bfhi(yw[i].y)}; float o[4];
#pragma unroll
                for (int j = 0; j < 4; ++j) o[j] = h[j] * y[j] * sigmoidf_(1.5957691216f * (y[j] + 0.044715f * y[j] * y[j] * y[j]));
                u32x2 w; w.x = pk_bf16(o[0], o[1]); w.y = pk_bf16(o[2], o[3]); *(u32x2*)(mix + (size_t)(r0 + r + i) * 3072 + 2048 + c) = w; } } }
}
template <int NG, bool DUMMY> __device__ __forceinline__ void ln1_groups(Frame& F, int l, int j0) {
    float* H = (float*)(F.ws + WS_H); float* Hout = DUMMY ? (float*)(F.ws + WS_R6) : H; unsigned char* HB8 = F.ws + (DUMMY ? WS_R3 : WS_HB8); const float* stats = (const float*)(F.ws + WS_STATS);
    const float* g1 = F.I(I_LN1G) + (size_t)l * D; const float* b1 = F.I(I_LN1B) + (size_t)l * D;
    const bf16* whi = (const bf16*)(F.ws + WS_WRT) + (size_t)(l * 2) * 48 * 2048; const bf16* wlo = whi + 48 * 2048;
    const int lane = F.lane, p = lane & 15, kg = lane >> 4, wave = F.wave;
    float mean[NG], rstd[NG]; size_t roff[NG]; f32x4 acc[NG][3];
#pragma unroll
    for (int j = 0; j < NG; ++j) { const int row = (F.vcu + (j0 + j) * F.G) * 16 + p; roff[j] = (size_t)row * D;
        float s = 0.f, q = 0.f; const f32x4* sp = (const f32x4*)(stats + (size_t)row * 64 + kg * 16);
#pragma unroll
        for (int i = 0; i < 4; ++i) { const f32x4 t = sp[i]; s += t[0] + t[2]; q += t[1] + t[3]; }
        s += __shfl_xor(s, 16); s += __shfl_xor(s, 32); q += __shfl_xor(q, 16); q += __shfl_xor(q, 32);
        mean[j] = s * (1.f / D); rstd[j] = 1.f / sqrtf(fmaxf(q * (1.f / D) - mean[j] * mean[j], 0.f) + LN_EPS);
#pragma unroll
        for (int cb = 0; cb < 3; ++cb) acc[j][cb] = (f32x4){0.f, 0.f, 0.f, 0.f}; }
#pragma unroll 2
    for (int ks = 0; ks < 8; ++ks) {
        const int col = wave * 256 + ks * 32 + kg * 8;
        f32x4 y0[NG], y1[NG];
#pragma unroll
        for (int j = 0; j < NG; ++j) { y0[j] = *(const f32x4*)(H + roff[j] + col); y1[j] = *(const f32x4*)(H + roff[j] + col + 4); }
        const LAS float* lv = (const LAS float*)(F.lds + VEC_OFF);
        const f32x4 ga = *(const LAS f32x4*)(lv + col), gb = *(const LAS f32x4*)(lv + col + 4), ba = *(const LAS f32x4*)(lv + 2048 + col), bb = *(const LAS f32x4*)(lv + 2048 + col + 4);
        bf16x8 wh[3], wl[3];
#pragma unroll
        for (int cb = 0; cb < 3; ++cb) { wh[cb] = *(const bf16x8*)(whi + (size_t)(cb * 16 + p) * 2048 + col); wl[cb] = *(const bf16x8*)(wlo + (size_t)(cb * 16 + p) * 2048 + col); }
#pragma unroll
        for (int j = 0; j < NG; ++j) {
            const f32x4 h0 = (y0[j] - mean[j]) * rstd[j] * ga + ba, h1 = (y1[j] - mean[j]) * rstd[j] * gb + bb;
            u32x4 hi; hi.x = pk_bf16(h0[0], h0[1]); hi.y = pk_bf16(h0[2], h0[3]); hi.z = pk_bf16(h1[0], h1[1]); hi.w = pk_bf16(h1[2], h1[3]);
            { u32x2 w8; w8.x = pk_fp8x4(h0[0], h0[1], h0[2], h0[3]); w8.y = pk_fp8x4(h1[0], h1[1], h1[2], h1[3]); *(u32x2*)(HB8 + roff[j] + col) = w8; }
            u32x4 lo; lo.x = pk_bf16(h0[0] - bflo(hi.x), h0[1] - bfhi(hi.x)); lo.y = pk_bf16(h0[2] - bflo(hi.y), h0[3] - bfhi(hi.y));
            lo.z = pk_bf16(h1[0] - bflo(hi.z), h1[1] - bfhi(hi.z)); lo.w = pk_bf16(h1[2] - bflo(hi.w), h1[3] - bfhi(hi.w));
            const bf16x8 xh = __builtin_bit_cast(bf16x8, hi), xl = __builtin_bit_cast(bf16x8, lo);
#pragma unroll
            for (int cb = 0; cb < 3; ++cb) { acc[j][cb] = __builtin_amdgcn_mfma_f32_16x16x32_bf16(wh[cb], xh, acc[j][cb], 0, 0, 0);
                acc[j][cb] = __builtin_amdgcn_mfma_f32_16x16x32_bf16(wh[cb], xl, acc[j][cb], 0, 0, 0); acc[j][cb] = __builtin_amdgcn_mfma_f32_16x16x32_bf16(wl[cb], xh, acc[j][cb], 0, 0, 0); } }
    }
#pragma unroll
    for (int j = 0; j < NG; ++j) { LAS float* lgs = (LAS float*)(F.lds + (j0 + j) * 24576);
#pragma unroll
        for (int cb = 0; cb < 3; ++cb) *(LAS f32x4*)(lgs + (wave * 16 + p) * 48 + cb * 16 + kg * 4) = acc[j][cb]; }
}
template <bool DUMMY> __device__ __forceinline__ void phase_ln1_router(Frame& F, int l) {
    float* H = (float*)(F.ws + WS_H); float* Hout = DUMMY ? (float*)(F.ws + WS_R6) : H; unsigned char* HB8 = F.ws + (DUMMY ? WS_R3 : WS_HB8); const float* stats = (const float*)(F.ws + WS_STATS);
    int* tokinfo = (int*)(F.ws + (DUMMY ? WS_R45 + 4 * MiB : WS_TOKINFO)); int* elist = (int*)(F.ws + (DUMMY ? WS_R45 : WS_ELIST)); unsigned* count = (unsigned*)(F.ws + WS_CTL) + CW_COUNT + ((DUMMY ? 64 : 0) + l * 32) * CNT_STRIDE;
    const float* g1 = F.I(I_LN1G) + (size_t)l * D; const float* b1 = F.I(I_LN1B) + (size_t)l * D;
    const bf16* whi = (const bf16*)(F.ws + WS_WRT) + (size_t)(l * 2) * 48 * 2048; const bf16* wlo = whi + 48 * 2048;
    const float* bg = F.I(I_RGB) + l * 4; const float* be = F.I(I_REB) + l * 32;
    const int lane = F.lane, p = lane & 15, kg = lane >> 4, wave = F.wave;
    { LAS float* lv = (LAS float*)(F.lds + VEC_OFF); const int i4 = 4 * F.tid; *(LAS f32x4*)(lv + i4) = *(const f32x4*)(g1 + i4); *(LAS f32x4*)(lv + 2048 + i4) = *(const f32x4*)(b1 + i4); }
    __syncthreads();
    ln1_groups<4, DUMMY>(F, l, 0); if (F.vcu + 4 * F.G < NTOK / 16) ln1_groups<1, DUMMY>(F, l, 4);
    __syncthreads();
    LAS unsigned* lcnt = (LAS unsigned*)(F.lds + TBL_OFF + 512);
    if (F.tid < 64) lcnt[F.tid] = 0u;
    __syncthreads();
    int ea = 0, eb = 0, n = 0; unsigned la = 0u, lb = 0u; float w0 = 0.f, w1 = 0.f; bool have = false;
    { const int grp = F.vcu + wave * F.G;
        if (grp < NTOK / 16 && lane < 16) {
            const LAS float* lgs = (const LAS float*)(F.lds + wave * 24576);
            n = grp * 16 + lane; have = true; float lg[36];
            const f32x4 bgv = *(const f32x4*)bg; f32x4 bev[8];
#pragma unroll
            for (int i = 0; i < 8; ++i) bev[i] = *(const f32x4*)(be + 4 * i);
#pragma unroll
            for (int i = 0; i < 36; ++i) lg[i] = 0.f;
#pragma unroll 1
            for (int w = 0; w < 8; ++w) {
#pragma unroll
                for (int i4 = 0; i4 < 9; ++i4) { const f32x4 t = *(const LAS f32x4*)(lgs + (w * 16 + lane) * 48 + 4 * i4); lg[4 * i4] += t[0]; lg[4 * i4 + 1] += t[1]; lg[4 * i4 + 2] += t[2]; lg[4 * i4 + 3] += t[3]; } }
            float gl[4];
#pragma unroll
            for (int i = 0; i < 4; ++i) gl[i] = lg[i] + bgv[i];
            int g = 0; float gm = gl[0];
#pragma unroll
            for (int i = 1; i < 4; ++i) if (gl[i] > gm) { gm = gl[i]; g = i; }
            float gs = 0.f;
#pragma unroll
            for (int i = 0; i < 4; ++i) gs += fast_exp(gl[i] - gm);
            const float pg = 1.0f / gs;
            float el[8];
#pragma unroll
            for (int j = 0; j < 8; ++j) { const float x0 = lg[4 + j] + bev[j >> 2][j & 3], x1 = lg[12 + j] + bev[2 + (j >> 2)][j & 3], x2 = lg[20 + j] + bev[4 + (j >> 2)][j & 3], x3 = lg[28 + j] + bev[6 + (j >> 2)][j & 3]; el[j] = g == 0 ? x0 : g == 1 ? x1 : g == 2 ? x2 : x3; }
            int i0 = 0; float m0 = el[0];
#pragma unroll
            for (int j = 1; j < 8; ++j) if (el[j] > m0) { m0 = el[j]; i0 = j; }
            int i1 = -1; float m1 = -3.0e38f;
#pragma unroll
            for (int j = 0; j < 8; ++j) if (j != i0 && el[j] > m1) { m1 = el[j]; i1 = j; }
            const float e1 = fast_exp(m1 - m0); w0 = pg / (1.0f + e1); w1 = pg * e1 / (1.0f + e1);
            ea = g * 8 + i0; eb = g * 8 + i1;
            la = __hip_atomic_fetch_add(lcnt + ea, 1u, __ATOMIC_RELAXED, __HIP_MEMORY_SCOPE_WORKGROUP); lb = __hip_atomic_fetch_add(lcnt + eb, 1u, __ATOMIC_RELAXED, __HIP_MEMORY_SCOPE_WORKGROUP);
        }
    }
    __syncthreads();
    if (F.tid < 32) { const unsigned c = lcnt[F.tid]; lcnt[32 + F.tid] = c ? __hip_atomic_fetch_add(count + F.tid * CNT_STRIDE, c, RLX_AGENT) : 0u; }
    __syncthreads();
    if (have) { const unsigned ra = lcnt[32 + ea] + la, rb = lcnt[32 + eb] + lb;
        elist[(size_t)ea * NTOK + ra] = n; elist[(size_t)eb * NTOK + rb] = n;
        int* ti = tokinfo + (size_t)n * 8; ti[0] = ea; ti[1] = (int)ra; ti[2] = __float_as_int(w0); ti[3] = eb; ti[4] = (int)rb; ti[5] = __float_as_int(w1); }
    __syncthreads();
    const int gw = F.vcu * 8 + F.wave, NGW = F.G * 8;
    LAS float* scr = (LAS float*)(F.lds + F.wave * 16384);
    if (!DUMMY) {
        if (F.G == 256) {
            const int TW = (NTOK / 16 - 4 * 256) * 8;
            const int nr = F.vcu < 4 ? 20 : 24;
            for (int k = 0; k < nr; ++k) conv_expert_weights(F, l, k * NGW + gw, scr);
            const int w = gw - TW; if (w >= 0 && w < 4 * TW) conv_expert_weights(F, l, (20 + w / TW) * NGW + (w % TW), scr);
        } else for (int it = gw; it < 49152; it += NGW) conv_expert_weights(F, l, it, scr);
    }
}
__device__ __forceinline__ void moe_tables(Frame& F, int l) {
    LAS int* tb = (LAS int*)(F.lds + TBL_OFF);
    __syncthreads();
    if (F.tid < 64) { const unsigned* count = (const unsigned*)(F.ws + WS_CTL) + CW_COUNT + l * 32 * CNT_STRIDE; const int e = F.tid;
        const int cn = e < 32 ? (int)__hip_atomic_load(count + e * CNT_STRIDE, RLX_AGENT) : 0; const int tiles = (cn + 255) >> 8; int incl = tiles;
#pragma unroll
        for (int d = 1; d < 32; d <<= 1) { const int t = __shfl_up(incl, d); if (e >= d) incl += t; }
        if (e < 32) { tb[e] = incl - tiles; tb[40 + e] = cn; } if (e == 31) tb[32] = incl; }
    __syncthreads();
}
template <bool DUMMY> __device__ __forceinline__ void phase_final(Frame& F, int l) {
    float* H = (float*)(F.ws + WS_H); bf16* HB = (bf16*)(F.ws + (DUMMY ? WS_R45 : WS_HB)); float* Hout = DUMMY ? (float*)(F.ws + WS_R6) : H; unsigned char* H8 = F.ws + (DUMMY ? WS_R3 : WS_HB8); const unsigned char* yd = F.ws + WS_R1; const int* tokinfo = (const int*)(F.ws + WS_TOKINFO);
    const LAS int* tb = (const LAS int*)(F.lds + TBL_OFF);
    const float* g2 = F.I(I_LN2G) + (size_t)l * D; const float* b2 = F.I(I_LN2B) + (size_t)l * D; const float* g1 = F.I(I_LN1G) + (size_t)l * D; const float* b1 = F.I(I_LN1B) + (size_t)l * D; const float* stats = (const float*)(F.ws + WS_STATS);
    const int gw = F.vcu * 8 + F.wave, NGW = F.G * 8, lane = F.lane;
    LAS float* lv = (LAS float*)F.lds;
    { const int i4 = 4 * F.tid; *(LAS f32x4*)(lv + i4) = *(const f32x4*)(g1 + i4); *(LAS f32x4*)(lv + 2048 + i4) = *(const f32x4*)(b1 + i4); *(LAS f32x4*)(lv + 4096 + i4) = *(const f32x4*)(g2 + i4); *(LAS f32x4*)(lv + 6144 + i4) = *(const f32x4*)(b2 + i4); }
    __syncthreads();
    for (int n = gw; n < NTOK; n += NGW) {
        const int t = n % LSEQ, b = n / LSEQ;
        if (!DUMMY && l == DEPTH - 1 && t < NMETA) continue;
        const int* ti = tokinfo + (size_t)n * 8; const int ea = ti[0], ra = ti[1], eb = ti[3], rb = ti[4]; const float w0 = __int_as_float(ti[2]) * (1.0f / YD_SCALE), w1 = __int_as_float(ti[5]) * (1.0f / YD_SCALE);
        const unsigned char* ya = yd + ((size_t)tb[ea] * 256 + ra) * D; const unsigned char* yb = yd + ((size_t)tb[eb] * 256 + rb) * D;
        f32x4 v[8]; load_row_f32(H + (size_t)n * D, v, lane);
        { float s = 0.f, q = 0.f;
          if (lane < 16) { const f32x4 t = *(const f32x4*)(stats + (size_t)n * 64 + 4 * lane); s = t[0] + t[2]; q = t[1] + t[3]; }
          s = wave_sum(s); q = wave_sum(q);
          const float mean = s * (1.f / D), rstd = 1.f / sqrtf(fmaxf(q * (1.f / D) - mean * mean, 0.f) + LN_EPS);
#pragma unroll
          for (int j = 0; j < 8; ++j) { const f32x4 gg = *(const LAS f32x4*)(lv + 4 * lane + 256 * j), bb = *(const LAS f32x4*)(lv + 2048 + 4 * lane + 256 * j); v[j] = (v[j] - mean) * rstd * gg + bb; } }
#pragma unroll
        for (int j = 0; j < 8; ++j) { const unsigned a = *(const unsigned*)(ya + 4 * lane + 256 * j), c = *(const unsigned*)(yb + 4 * lane + 256 * j);
            const f32x2 a0 = __builtin_amdgcn_cvt_pk_f32_fp8((int)a, false), a1 = __builtin_amdgcn_cvt_pk_f32_fp8((int)a, true), c0 = __builtin_amdgcn_cvt_pk_f32_fp8((int)c, false), c1 = __builtin_amdgcn_cvt_pk_f32_fp8((int)c, true);
            v[j].x = v[j].x * ALPHA + w0 * a0.x + w1 * c0.x; v[j].y = v[j].y * ALPHA + w0 * a0.y + w1 * c0.y;
            v[j].z = v[j].z * ALPHA + w0 * a1.x + w1 * c1.x; v[j].w = v[j].w * ALPHA + w0 * a1.y + w1 * c1.y; }
        ln_regs_lds(v, lv + 4096, lv + 6144, lane);
        if (!DUMMY && l == DEPTH - 1) store_row_f32(F.out + ((size_t)b * SEQ + (t - NMETA)) * D, v, lane);
        else { store_row_f32(Hout + (size_t)n * D, v, lane); store_row_bf16(HB + (size_t)n * D, v, lane); store_row_fp8(H8 + (size_t)n * D, v, lane); }
    }
}

constexpr int NPHASE = 1 + DEPTH * 11;
#define IN(k) (lo <= (k) && (k) < hi)
#define SEAM(k) do { if (IN(k) && IN((k) + 1)) { XcdBarrier b_ = bar; asm volatile("" : "+s"(b_.bar), "+s"(b_.x)); xcd_barrier(b_); } } while (0)
#define PH_BEGIN() F.z = opaque_s(0); F.ws = args.ws + F.z; F.vcu = vcu0 + F.z; F.tid = opaque_v(tid0); F.lane = F.tid & 63; F.wave = __builtin_amdgcn_readfirstlane(F.tid >> 6); const int bx = bx0 + F.z; (void)bx
template <int L> __device__ __forceinline__ void run_layer(Frame& F, const Args& args, const XcdBarrier& bar, const int lo, const int hi, const int bx0, const int vcu0, const int tid0) {
    constexpr int l = L; constexpr int pb = 1 + L * 11;
#define wl (F.ws + WS_WSMALL + (size_t)l * WL_BYTES)
        if (IN(pb + 0)) PREP(1) { PH_BEGIN();
            { PolA_<false> p; p.K = D; p.lda = D; p.ldb = D; p.A = F.ws + WS_HB; p.Bt = wl + WL_WIN; p.out = (bf16*)(F.ws + WS_R2); p.outc = p.out; p.G = F.G; p.c = bx;
              pg8::gemm_phase(F.lds, p, F.tid, F.ws); }
            { PolA_<true> p; p.K = D; p.lda = D; p.ldb = D; p.A = F.ws + WS_HB8; p.Bt = wl + WL_WIN8; p.out = (bf16*)(F.ws + WS_R1); p.outc = (bf16*)(F.ws + WS_R2); p.G = F.G; p.c = (F.G == 256) ? ((bx + A_LIGHT) & 255) : bx;
              pg8::gemm_phase(F.lds, p, F.tid, F.ws); } }
        SEAM(pb + 0);
        if (IN(pb + 1)) PREP(2) { PH_BEGIN();
            { PolW p; p.K = 256; p.lda = 1024; p.ldb = 256; p.pt = (const bf16*)(wl + WL_PROJ); p.wsc = (const bf16*)(F.ws + WS_WSC) + (size_t)l * 4 * 65536; p.wct = (bf16*)(F.ws + WS_WCT) + (size_t)l * D * 1024; p.G = F.G; p.c = (F.vcu + (F.G >> 1)) % F.G;
              pg8::gemm_phase(F.lds, p, F.tid, F.ws); }
            phase_delta_conv(F, l); phase_attn(F, l); }
        SEAM(pb + 1);
        if (IN(pb + 2)) PREP(3) { PH_BEGIN();
            PolC p; p.K = 256; p.lda = 1024; p.ldb = 256; p.delta = (const bf16*)(F.ws + WS_R45); p.xc = p.delta + (size_t)MP * 1024; p.pool_t = (const bf16*)(wl + WL_POOL); p.lru_t = (const bf16*)(wl + WL_LRU);
            p.mix = (bf16*)(F.ws + WS_R3); p.Abuf = (bf16*)(F.ws + WS_R6); p.Bbuf = p.Abuf + (size_t)MP * 1024; p.pool_scale = F.I(I_POOLS) + (size_t)l * 1024; p.ba = F.I(I_BA) + (size_t)l * 1024; p.bx = F.I(I_BX) + (size_t)l * 1024;
            p.sp8 = (const float*)(F.ws + WS_SP8) + (size_t)l * 1024; p.G = F.G; p.c = bx;
            pg8::gemm_phase(F.lds, p, F.tid, F.ws); tail_lru(F, l); }
        SEAM(pb + 2);
        if (IN(pb + 3)) PREP(4) { PH_BEGIN(); phase_lru_summ(F); }
        SEAM(pb + 3);
        if (IN(pb + 4)) PREP(5) { PH_BEGIN(); phase_lru_final(F); }
        SEAM(pb + 4);
        if (IN(pb + 5)) PREP(6) { PH_BEGIN();
            PolE p; p.K = 1024; p.lda = 3072; p.ldb = 1024; p.mix = (const bf16*)(F.ws + WS_R3); p.proj_t = (const bf16*)(wl + WL_PROJ); p.wct = (const bf16*)(F.ws + WS_WCT) + (size_t)l * D * 1024; p.gates = F.ws + WS_R1; p.merged = (bf16*)(F.ws + WS_R45); p.G = F.G; p.c = bx;
            p.t0 = 0; p.t1 = 512; pg8::gemm_phase(F.lds, p, F.tid, F.ws); tail_merge(F, l); }
        SEAM(pb + 5);
        if (IN(pb + 6)) PREP(7) { PH_BEGIN();
            PolF p; p.K = D; p.lda = D; p.ldb = D; p.A = (const bf16*)(F.ws + WS_R45); p.Bt = (const bf16*)(wl + WL_WOUT); p.H = (float*)(F.ws + WS_H); p.stats = (float*)(F.ws + WS_STATS); p.G = F.G; p.c = bx;
            p.t0 = 0; p.t1 = 512; pg8::gemm_phase(F.lds, p, F.tid, F.ws); tail_wout(F, l); }
        SEAM(pb + 6);
        if (IN(pb + 7)) PREP(8) { PH_BEGIN(); if (PROBE_G2) phase_ln1_router<true>(F, l); phase_ln1_router<false>(F, l); }
        SEAM(pb + 7);
        if (IN(pb + 8)) PREP(9) { PH_BEGIN();
            moe_tables(F, l);
            PolI p; p.K = D; p.lda = D; p.ldb = D; p.X = F.ws + WS_HB8; p.gu = F.ws + WS_R2 + EXPW_GU; p.elist = (const int*)(F.ws + WS_ELIST); p.hdn = F.ws + WS_R3;
            p.T.t = (const LAS int*)(F.lds + TBL_OFF); p.G = F.G; p.c = bx;
            pg8::gemm_phase(F.lds, p, F.tid, F.ws); }
        SEAM(pb + 8);
        if (IN(pb + 9)) PREP(10) { PH_BEGIN();
            moe_tables(F, l);
            PolJ p; p.K = DE; p.lda = DE; p.ldb = DE; p.hdn = F.ws + WS_R3; p.wd = F.ws + WS_R2 + EXPW_WD; p.yd = F.ws + WS_R1; p.T.t = (const LAS int*)(F.lds + TBL_OFF); p.G = F.G; p.c = bx;
            pg8::gemm_phase(F.lds, p, F.tid, F.ws); }
        SEAM(pb + 9);
        if (IN(pb + 10)) PREP(11) { PH_BEGIN(); moe_tables(F, l); if (PROBE_K2) phase_final<true>(F, l); phase_final<false>(F, l); }
        SEAM(pb + 10);
    }
#undef wl
__global__ void __launch_bounds__(512, 2) fwd(Args args) {
    extern __shared__ __attribute__((aligned(16))) unsigned char lds_raw[];
    Frame F; F.lds = (LAS unsigned char*)lds_raw; F.inp = args.in; F.z = 0; F.out = args.out; F.ws = args.ws;
    F.tid = threadIdx.x; F.lane = F.tid & 63; F.wave = __builtin_amdgcn_readfirstlane(F.tid >> 6);
    F.G = gridDim.x; { const int bx = blockIdx.x; F.vcu = (F.G % 8 == 0) ? (bx % 8) * (F.G / 8) + bx / 8 : bx; }
    volatile LAS unsigned* MISC = (volatile LAS unsigned*)(F.lds + MISC_OFF);
    for (int u = F.tid; u < (LDS_BYTES - MISC_OFF) / 4; u += 512) ((LAS unsigned*)(F.lds + MISC_OFF))[u] = 0u;
    __syncthreads();
    unsigned* ctl = (unsigned*)(F.ws + WS_CTL);
    XcdBarrier bar; bar.bar = ctl + CW_BAR; bar.x = 0; bar.st = nullptr;
    if (MK_ONE_LAUNCH) bar = xcd_barrier_post(ctl + CW_BAR, MISC + 8);
    const int lo = args.ph_lo, hi = args.ph_hi;
    const int bx0 = (int)blockIdx.x, vcu0 = F.vcu, tid0 = F.tid;

    if (IN(0)) PREP(0) { PH_BEGIN(); p0_prologue(F); } SEAM(0);

    run_layer<0>(F, args, bar, lo, hi, bx0, vcu0, tid0);
    run_layer<1>(F, args, bar, lo, hi, bx0, vcu0, tid0);
#undef IN
#undef SEAM
}

extern "C" void kernel_launch(void* const* d_in, const int* in_sizes, int n_in, void* d_out, int out_size, void* d_ws, size_t ws_size, hipStream_t stream) {
    static int grid = 0;
    if (grid == 0) {
        if (n_in != 30 || out_size != NB * SEQ * D || ws_size < WS_END) { fprintf(stderr, "kernel_launch: unexpected shapes (n_in %d, out %d, ws %zu)\n", n_in, out_size, ws_size); grid = -1; return; }
        int dev = 0, cus = 0, per_cu = 0;
        if (hipGetDevice(&dev) != hipSuccess || hipDeviceGetAttribute(&cus, hipDeviceAttributeMultiprocessorCount, dev) != hipSuccess) { grid = -1; return; }
        if (hipFuncSetAttribute((const void*)fwd, hipFuncAttributeMaxDynamicSharedMemorySize, LDS_BYTES) != hipSuccess) { fprintf(stderr, "kernel_launch: hipFuncSetAttribute failed\n"); grid = -1; return; }
        if (hipOccupancyMaxActiveBlocksPerMultiprocessor(&per_cu, (const void*)fwd, 512, LDS_BYTES) != hipSuccess || per_cu < 1) fprintf(stderr, "kernel_launch: occupancy query says %d\n", per_cu);
        (void)hipGetLastError();
        grid = cus;
    }
    if (grid < 0) return;
    (void)hipMemsetAsync((char*)d_ws + WS_CTL, 0, CTL_ZERO_BYTES, stream);
    Args a{};
    for (int i = 0; i < 30; ++i) a.in[i] = (const float*)d_in[i];
    a.out = (float*)d_out; a.ws = (unsigned char*)d_ws;
#if MK_ONE_LAUNCH
    a.ph_lo = 0; a.ph_hi = NPHASE;
    hipLaunchKernelGGL(fwd, dim3(grid), dim3(512), LDS_BYTES, stream, a);
#else
    for (int k = 0; k < NPHASE; ++k) { a.ph_lo = k; a.ph_hi = k + 1; hipLaunchKernelGGL(fwd, dim3(grid), dim3(512), LDS_BYTES, stream, a); }
#endif
}
```
